# Optimizing an MI355X kernel written in HIP

```python
import jax, jax.numpy as jnp
from jax import lax
import numpy as np

D_MODEL = 4096
BATCH = 4
SEQ = 4096
DEPTH = 1

HEAD_DIM = 128
N_Q_HEADS = D_MODEL // 256
N_KV_HEADS = N_Q_HEADS // 4
Q_PER_KV = N_Q_HEADS // N_KV_HEADS
ATTN_WIDTH = N_Q_HEADS * HEAD_DIM
KV_WIDTH = N_KV_HEADS * HEAD_DIM
WINDOW = 128
BLOCK = 128
ROT_DIM = HEAD_DIM // 4
ROPE_THETA = 500000.0

SGU_CHUNK = 128
SGU_GROUPS = D_MODEL // 256
SGU_GROUP_WIDTH = 128
SGU_WIDTH = SGU_GROUPS * SGU_GROUP_WIDTH

FFN_HIDDEN = -(-(8 * D_MODEL) // (3 * 256)) * 256

IN_WIDTH = ATTN_WIDTH + 2 * KV_WIDTH + 2 * SGU_WIDTH + 2 * D_MODEL
N_MOD = 6
RMS_EPS = 1e-6
LN_EPS = 1e-5

kernel_name = "hybrid_sgu_swa_sink_adaln_block"


def _rms_norm(x, g):
    xf = x.astype(jnp.float32)
    y = xf * lax.rsqrt(jnp.mean(xf * xf, axis=-1, keepdims=True) + RMS_EPS)
    return (y * g.astype(jnp.float32)).astype(x.dtype)


def _layer_norm(x, g, b):
    xf = x.astype(jnp.float32)
    mu = jnp.mean(xf, axis=-1, keepdims=True)
    xc = xf - mu
    y = xc * lax.rsqrt(jnp.mean(xc * xc, axis=-1, keepdims=True) + LN_EPS)
    return (y * g.astype(jnp.float32) + b.astype(jnp.float32)).astype(x.dtype)


def _modulate(h, shift, scale):
    return h * (1 + scale[:, None, :]) + shift[:, None, :]


def _rope_tables(positions, dtype):
    inv_freq = ROPE_THETA ** (-jnp.arange(0, ROT_DIM, 2, dtype=jnp.float32) / ROT_DIM)
    ang = positions.astype(jnp.float32)[..., None] * inv_freq
    return jnp.cos(ang)[:, :, None, :].astype(dtype), jnp.sin(ang)[:, :, None, :].astype(dtype)


def _partial_rope(t, cos, sin):
    half = ROT_DIM // 2
    x1, x2, rest = t[..., :half], t[..., half:ROT_DIM], t[..., ROT_DIM:]
    return jnp.concatenate([x1 * cos - x2 * sin, x2 * cos + x1 * sin, rest], axis=-1)


def _sliding_window_attention(q, k, v, sinks):
    B, S = q.shape[0], q.shape[1]
    nb = S // BLOCK
    qb = q.reshape(B, nb, BLOCK, N_KV_HEADS, Q_PER_KV, HEAD_DIM)

    def with_prev(t):
        tb = t.reshape(B, nb, BLOCK, N_KV_HEADS, HEAD_DIM)
        prev = jnp.pad(tb[:, :-1], ((0, 0), (1, 0), (0, 0), (0, 0), (0, 0)))
        return jnp.concatenate([prev, tb], axis=2)

    kk, vv = with_prev(k), with_prev(v)
    s = jnp.einsum('bnqhgd,bnkhd->bnhgqk', qb, kk,
                   preferred_element_type=jnp.float32) * (HEAD_DIM ** -0.5)
    blk = jnp.arange(nb)[:, None, None]
    qi = jnp.arange(BLOCK)[None, :, None]
    ki = jnp.arange(2 * BLOCK)[None, None, :]
    diff = qi + BLOCK - ki
    kpos = (blk - 1) * BLOCK + ki
    valid = (diff >= 0) & (diff < WINDOW) & (kpos >= 0)
    s = jnp.where(valid[:, None, None, :, :], s, -jnp.inf)
    sink = sinks.astype(jnp.float32).reshape(1, 1, N_KV_HEADS, Q_PER_KV, 1, 1)
    m = jnp.maximum(jnp.max(s, axis=-1, keepdims=True), sink)
    p = jnp.exp(s - m)
    denom = jnp.sum(p, axis=-1, keepdims=True) + jnp.exp(sink - m)
    o = jnp.einsum('bnhgqk,bnkhd->bnqhgd', (p / denom).astype(vv.dtype), vv)
    return o.reshape(B, S, ATTN_WIDTH)


def _spatial_gating(u, v, ln_g, ln_b, w_s, b_s):
    B, S = u.shape[0], u.shape[1]
    nc = S // SGU_CHUNK
    vn = _layer_norm(v, ln_g, ln_b).reshape(B, nc, SGU_CHUNK, SGU_GROUPS, SGU_GROUP_WIDTH)
    causal = jnp.tril(jnp.ones((SGU_CHUNK, SGU_CHUNK), dtype=bool))
    w = jnp.where(causal[None], w_s, jnp.zeros_like(w_s))
    mixed = jnp.einsum('gts,bnsgc->bntgc', w, vn) + b_s.T[:, :, None]
    return u * mixed.reshape(B, S, SGU_WIDTH)


def setup_inputs(seed: int = 0) -> dict:
    key = jax.random.key(seed)
    ks = jax.random.split(key, 24)
    f32 = jnp.float32

    def w(k, shape, fan_in, mult=1.0):
        return jax.random.normal(k, shape, f32) * (mult * fan_in ** -0.5)

    def gain(k, shape):
        return 1.0 + 0.02 * jax.random.normal(k, shape, f32)

    L, D = DEPTH, D_MODEL
    return {
        "x": jax.random.normal(ks[0], (BATCH, SEQ, D), f32),
        "c": jax.random.normal(ks[1], (BATCH, D), f32),
        "positions": jnp.broadcast_to(jnp.arange(SEQ, dtype=jnp.int32)[None, :], (BATCH, SEQ)),
        "w_ada": w(ks[2], (L, D, N_MOD * D), D, 0.5),
        "b_ada": 0.02 * jax.random.normal(ks[3], (L, N_MOD * D), f32),
        "g_pre_mix": gain(ks[4], (L, D)),
        "w_in": w(ks[5], (L, D, IN_WIDTH), D),
        "attn_sinks": 0.5 * jax.random.normal(ks[6], (L, N_Q_HEADS), f32),
        "sgu_ln_g": gain(ks[7], (L, SGU_WIDTH)),
        "sgu_ln_b": 0.02 * jax.random.normal(ks[8], (L, SGU_WIDTH), f32),
        "sgu_w": w(ks[9], (L, SGU_GROUPS, SGU_CHUNK, SGU_CHUNK), SGU_CHUNK),
        "sgu_b": 1.0 + 0.02 * jax.random.normal(ks[10], (L, SGU_GROUPS, SGU_CHUNK), f32),
        "w_proj_sgu": w(ks[11], (L, SGU_WIDTH, D), SGU_WIDTH),
        "w_proj_attn": w(ks[12], (L, ATTN_WIDTH, D), ATTN_WIDTH),
        "w_out": w(ks[13], (L, D, D), D),
        "g_post_mix": gain(ks[14], (L, D)),
        "g_pre_ffn": gain(ks[15], (L, D)),
        "w_gate": w(ks[16], (L, D, FFN_HIDDEN), D),
        "w_up": w(ks[17], (L, D, FFN_HIDDEN), D),
        "w_down": w(ks[18], (L, FFN_HIDDEN, D), FFN_HIDDEN),
        "g_post_ffn": gain(ks[19], (L, D)),
    }


def reference(x, c, positions, w_ada, b_ada, g_pre_mix, w_in, attn_sinks, sgu_ln_g, sgu_ln_b,
              sgu_w, sgu_b, w_proj_sgu, w_proj_attn, w_out, g_post_mix, g_pre_ffn,
              w_gate, w_up, w_down, g_post_ffn):
    B, S = x.shape[0], x.shape[1]
    cos, sin = _rope_tables(positions, x.dtype)
    c_act = jax.nn.silu(c)
    o1 = ATTN_WIDTH
    o2 = o1 + KV_WIDTH
    o3 = o2 + KV_WIDTH
    o4 = o3 + SGU_WIDTH
    o5 = o4 + SGU_WIDTH
    o6 = o5 + D_MODEL
    for l in range(DEPTH):
        mod = c_act @ w_ada[l] + b_ada[l]
        sh1, sc1, gt1, sh2, sc2, gt2 = jnp.split(mod, N_MOD, axis=-1)

        h = _modulate(_rms_norm(x, g_pre_mix[l]), sh1, sc1)
        z = h @ w_in[l]
        q, k, v, su, sv, ga, gb = jnp.split(z, [o1, o2, o3, o4, o5, o6], axis=-1)

        q = _partial_rope(q.reshape(B, S, N_Q_HEADS, HEAD_DIM), cos, sin)
        k = _partial_rope(k.reshape(B, S, N_KV_HEADS, HEAD_DIM), cos, sin)
        v = v.reshape(B, S, N_KV_HEADS, HEAD_DIM)
        attn_out = _sliding_window_attention(q, k, v, attn_sinks[l]) @ w_proj_attn[l]

        su = jax.nn.gelu(su, approximate=False)
        sv = jax.nn.gelu(sv, approximate=False)
        sgu_out = _spatial_gating(su, sv, sgu_ln_g[l], sgu_ln_b[l], sgu_w[l], sgu_b[l]) @ w_proj_sgu[l]

        merged = jax.nn.sigmoid(ga) * sgu_out + jax.nn.sigmoid(gb) * attn_out
        y = _rms_norm(merged @ w_out[l], g_post_mix[l])
        x = x + gt1[:, None, :] * y

        h = _modulate(_rms_norm(x, g_pre_ffn[l]), sh2, sc2)
        f = (jax.nn.silu(h @ w_gate[l]) * (h @ w_up[l])) @ w_down[l]
        x = x + gt2[:, None, :] * _rms_norm(f, g_post_ffn[l])
    return x
```

```cpp
#include <hip/hip_runtime.h>
#include <cstdio>
#include <cstdint>
namespace pg8 {
#define PG8_LAS __attribute__((address_space(3)))
typedef unsigned short bf16_t;
typedef short bf16x8 __attribute__((ext_vector_type(8)));
typedef float f32x4 __attribute__((ext_vector_type(4)));
typedef unsigned u32x4 __attribute__((ext_vector_type(4)));
constexpr int BM = 256, BK = 64, HALF = 128, HTB = HALF * BK * 2  , STAGE_BYTES = 8 * HTB, NXCD = 8, WGM = 8;

__host__ __device__ __forceinline__ int lds_byte(int r, int c) { const int st = (r >> 4) * 2 + (c >> 5), rr = r & 15, cc = c & 31, ob = rr * 64 + cc * 2; return st * 1024 + (ob ^ (((ob >> 9) & 1) << 5)); }
__host__ __device__ __forceinline__ void stage_rc(int b, int& R, int& C) { const int st = b / 1024, sb = b % 1024, swz = sb ^ (((sb >> 9) & 1) << 5); R = (st >> 1) * 16 + swz / 64; C = (st & 1) * 32 + (swz % 64) / 2; }
__host__ __device__ __forceinline__ int perm32(int rho) { const int n = rho >> 4, i = rho & 15; return 8 * (i >> 2) + 4 * n + (i & 3); }

struct Unit { int pm, pn; };
struct Gemm { const bf16_t* A; const bf16_t* Bt; int M, N, K; };

struct StaticOrder {
    int nM, nN, nwg, G, c;
    __host__ __device__ void init(int M, int N, int G_, int c_) { nM = M / BM; nN = N / BM; nwg = nM * nN; G = G_; c = c_; }
    __host__ __device__ bool next(int i, Unit& u) const {
        const long L = (long)i * G + c; if (L >= nwg) return false;
        int wgid = (int)L; { const int q = nwg / NXCD, r = nwg % NXCD, xcd = wgid % NXCD, off = wgid / NXCD; wgid = (xcd < r ? xcd * (q + 1) : r * (q + 1) + (xcd - r) * q) + off; }
        const int nig = WGM * nN, gid = wgid / nig, fm = gid * WGM, gsz = (nM - fm) < WGM ? (nM - fm) : WGM;
        u.pm = fm + ((wgid % nig) % gsz); u.pn = (wgid % nig) / gsz; return true;
    }
    __device__ __forceinline__ void a_ready(const Unit&) const {}
    __device__ __forceinline__ void done(const Unit&) const {}
};

__device__ __forceinline__ unsigned cvt_pk_bf16(float lo, float hi) { unsigned r; asm volatile("v_cvt_pk_bf16_f32 %0, %1, %2" : "=v"(r) : "v"(lo), "v"(hi)); return r; }
typedef float f32x2 __attribute__((ext_vector_type(2)));
__device__ __forceinline__ f32x2 gelu_pk(f32x2 v) {
    const f32x2 av = __builtin_elementwise_abs(v), d = av * 0.2316418882f + 1.0f;
    f32x2 t; t.x = __builtin_amdgcn_rcpf(d.x); t.y = __builtin_amdgcn_rcpf(d.y);
    f32x2 q = t * 0.5307027145f + (-0.7265760135f); q = q * t + 0.7107068705f; q = q * t + (-0.142248368f); q = q * t + 0.127414796f; q = q * t;
    const f32x2 s = (v * v) * (-0.72134752044f);
    f32x2 e; e.x = __builtin_amdgcn_exp2f(s.x); e.y = __builtin_amdgcn_exp2f(s.y);
    const f32x2 m = v * (q * e), r = v - m;
    f32x2 o; o.x = v.x < 0.f ? m.x : r.x; o.y = v.y < 0.f ? m.y : r.y; return o;
}

typedef float f32x2t __attribute__((ext_vector_type(2)));
typedef __bf16 bf16x2t __attribute__((ext_vector_type(2)));
__device__ __forceinline__ unsigned pk_bf16(float lo, float hi) { f32x2t v = {lo, hi}; bf16x2t b = __builtin_convertvector(v, bf16x2t); return __builtin_bit_cast(unsigned, b); }
__device__ __forceinline__ float bf_lo(unsigned w) { return __builtin_bit_cast(float, w << 16); }
__device__ __forceinline__ float bf_hi(unsigned w) { return __builtin_bit_cast(float, w & 0xffff0000u); }
__device__ __forceinline__ float sigmoid_f(float x) { return __builtin_amdgcn_rcpf(1.0f + __builtin_amdgcn_exp2f(-1.4426950408889634f * x)); }
__device__ __forceinline__ u32x4 pack8(const f32x4& a, const f32x4& b) { u32x4 w; w.x = pk_bf16(a[0], a[1]); w.y = pk_bf16(a[2], a[3]); w.z = pk_bf16(b[0], b[1]); w.w = pk_bf16(b[2], b[3]); return w; }
__device__ __forceinline__ void unpack8(const u32x4& w, f32x4& a, f32x4& b) { a = (f32x4){bf_lo(w.x), bf_hi(w.x), bf_lo(w.y), bf_hi(w.y)}; b = (f32x4){bf_lo(w.z), bf_hi(w.z), bf_lo(w.w), bf_hi(w.w)}; }

constexpr int Z_LD = 15360, ZO_Q = 0, ZO_K = 2048, ZO_V = 2560, ZO_SU = 3072, ZO_SV = 5120, ZO_GA = 7168, ZO_GB = 11264;

struct EpiZ {
    static constexpr bool PERM = true, AFTER_DRAIN = false;
    bf16_t* Z; const float* ropeC; const float* ropeS; float* svstat;
    __device__ __forceinline__ void operator()(const f32x4 (&acc)[2][2][4][2], const Unit& u, int wr, int wc, int fr, int fq) const {
        const int pn = u.pn;
        const int mode = pn < 10 ? 0 : (pn < 12 ? 1 : (pn < 20 ? 2 : (pn < 28 ? 3 : 4)));
        const int row0 = u.pm * BM + wr * 64 + fr, col0 = pn * BM + wc * 32 + 8 * fq;
        const bool rot = (mode == 0) && (wc == 0);
        const float sgn = fq < 2 ? -1.0f : 1.0f;
#pragma unroll
        for (int ai = 0; ai < 2; ++ai)
#pragma unroll
            for (int m = 0; m < 4; ++m) {
                const int row = row0 + ai * HALF + m * 16;
                bf16_t* rowp = Z + (size_t)row * Z_LD + col0;
                f32x4 c0 = {1.f, 1.f, 1.f, 1.f}, c1 = c0, s0 = {0.f, 0.f, 0.f, 0.f}, s1 = s0;
                if (rot) { const float* cp = ropeC + (size_t)row * 16 + 8 * (fq & 1); const float* sp = ropeS + (size_t)row * 16 + 8 * (fq & 1);
                    c0 = *(const f32x4*)cp; c1 = *(const f32x4*)(cp + 4); s0 = *(const f32x4*)sp; s1 = *(const f32x4*)(sp + 4); }
                float t1 = 0.f, t2 = 0.f;
#pragma unroll
                for (int bj = 0; bj < 2; ++bj) {
                    f32x4 v0 = acc[ai][bj][m][0], v1 = acc[ai][bj][m][1];
                    if (rot) {
                        f32x4 o0, o1;
#pragma unroll
                        for (int j = 0; j < 4; ++j) { o0[j] = __shfl_xor(v0[j], 32); o1[j] = __shfl_xor(v1[j], 32); }
                        v0 = v0 * c0 + (o0 * s0) * sgn; v1 = v1 * c1 + (o1 * s1) * sgn;
                    } else if (mode == 2 || mode == 3) {
                        f32x2 a = gelu_pk((f32x2){v0[0], v0[1]}), b = gelu_pk((f32x2){v0[2], v0[3]}), c = gelu_pk((f32x2){v1[0], v1[1]}), d = gelu_pk((f32x2){v1[2], v1[3]});
                        v0 = (f32x4){a.x, a.y, b.x, b.y}; v1 = (f32x4){c.x, c.y, d.x, d.y};
                        if (mode == 3) {
#pragma unroll
                            for (int j = 0; j < 4; ++j) { t1 += v0[j] + v1[j]; t2 += v0[j] * v0[j] + v1[j] * v1[j]; } }
                    } else if (mode == 4) {
#pragma unroll
                        for (int j = 0; j < 4; ++j) { v0[j] = sigmoid_f(v0[j]); v1[j] = sigmoid_f(v1[j]); }
                    }
                    *(u32x4*)(rowp + bj * HALF) = pack8(v0, v1);
                }
                if (mode == 3) {
                    t1 += __shfl_xor(t1, 16); t1 += __shfl_xor(t1, 32); t2 += __shfl_xor(t2, 16); t2 += __shfl_xor(t2, 32);
                    if (fq == 0) *(f32x2*)(svstat + ((size_t)row * 32 + (pn - 20) * 4 + wc) * 2) = (f32x2){t1, t2};
                }
            }
    }
};
struct EpiMergeA {
    static constexpr bool PERM = true, AFTER_DRAIN = false;
    bf16_t* T; const bf16_t* Z;
    __device__ __forceinline__ void operator()(const f32x4 (&acc)[2][2][4][2], const Unit& u, int wr, int wc, int fr, int fq) const {
        const int row0 = u.pm * BM + wr * 64 + fr, col0 = u.pn * BM + wc * 32 + 8 * fq;
#pragma unroll
        for (int ai = 0; ai < 2; ++ai)
#pragma unroll
            for (int m = 0; m < 4; ++m) { const int row = row0 + ai * HALF + m * 16;
#pragma unroll
                for (int bj = 0; bj < 2; ++bj) {
                    const u32x4 gw = *(const u32x4*)(Z + (size_t)row * Z_LD + ZO_GA + col0 + bj * HALF); f32x4 g0, g1; unpack8(gw, g0, g1);
                    *(u32x4*)(T + (size_t)row * 4096 + col0 + bj * HALF) = pack8(acc[ai][bj][m][0] * g0, acc[ai][bj][m][1] * g1); } }
    }
};
struct EpiMergeB {
    static constexpr bool PERM = true, AFTER_DRAIN = false;
    bf16_t* T; const bf16_t* Z;
    __device__ __forceinline__ void operator()(const f32x4 (&acc)[2][2][4][2], const Unit& u, int wr, int wc, int fr, int fq) const {
        const int row0 = u.pm * BM + wr * 64 + fr, col0 = u.pn * BM + wc * 32 + 8 * fq;
#pragma unroll
        for (int ai = 0; ai < 2; ++ai)
#pragma unroll
            for (int m = 0; m < 4; ++m) { const int row = row0 + ai * HALF + m * 16;
#pragma unroll
                for (int bj = 0; bj < 2; ++bj) {
                    const u32x4 gw = *(const u32x4*)(Z + (size_t)row * Z_LD + ZO_GB + col0 + bj * HALF); f32x4 g0, g1; unpack8(gw, g0, g1);
                    bf16_t* tp = T + (size_t)row * 4096 + col0 + bj * HALF;
                    const u32x4 tw = *(const u32x4*)tp; f32x4 t0, t1; unpack8(tw, t0, t1);
                    *(u32x4*)tp = pack8(t0 + acc[ai][bj][m][0] * g0, t1 + acc[ai][bj][m][1] * g1); } }
    }
};
struct EpiStats {
    static constexpr bool PERM = true, AFTER_DRAIN = false;
    bf16_t* Y; float* ssq;
    __device__ __forceinline__ void operator()(const f32x4 (&acc)[2][2][4][2], const Unit& u, int wr, int wc, int fr, int fq) const {
        const int row0 = u.pm * BM + wr * 64 + fr, col0 = u.pn * BM + wc * 32 + 8 * fq;
#pragma unroll
        for (int ai = 0; ai < 2; ++ai)
#pragma unroll
            for (int m = 0; m < 4; ++m) { const int row = row0 + ai * HALF + m * 16; float t2 = 0.f;
#pragma unroll
                for (int bj = 0; bj < 2; ++bj) { const f32x4 v0 = acc[ai][bj][m][0], v1 = acc[ai][bj][m][1];
#pragma unroll
                    for (int j = 0; j < 4; ++j) t2 += v0[j] * v0[j] + v1[j] * v1[j];
                    *(u32x4*)(Y + (size_t)row * 4096 + col0 + bj * HALF) = pack8(v0, v1); }
                t2 += __shfl_xor(t2, 16); t2 += __shfl_xor(t2, 32);
                if (fq == 0) ssq[(size_t)row * 64 + u.pn * 4 + wc] = t2; }
    }
};
struct EpiSwiGLU {
    static constexpr bool PERM = true, AFTER_DRAIN = false;
    bf16_t* H;
    __device__ __forceinline__ void operator()(const f32x4 (&acc)[2][2][4][2], const Unit& u, int wr, int wc, int fr, int fq) const {
        const int row0 = u.pm * BM + wr * 64 + fr, col0 = u.pn * HALF + wc * 32 + 8 * fq;
#pragma unroll
        for (int ai = 0; ai < 2; ++ai)
#pragma unroll
            for (int m = 0; m < 4; ++m) { const int row = row0 + ai * HALF + m * 16;
                f32x4 h0, h1;
#pragma unroll
                for (int j = 0; j < 4; ++j) { const float g0 = acc[ai][0][m][0][j], g1 = acc[ai][0][m][1][j];
                    h0[j] = g0 * sigmoid_f(g0) * acc[ai][1][m][0][j]; h1[j] = g1 * sigmoid_f(g1) * acc[ai][1][m][1][j]; }
                *(u32x4*)(H + (size_t)row * 11008 + col0) = pack8(h0, h1); }
    }
};
template <class Epi, class Sched, bool ALIGN_EPI = false, bool SP2 = false>
__device__ __forceinline__ void gemm_phase(PG8_LAS unsigned char* lds, const Gemm g, const Sched& S, const Epi& E) {
    const int tid = threadIdx.x, wid = __builtin_amdgcn_readfirstlane(tid >> 6), lane = tid & 63, wr = wid >> 2, wc = wid & 3, fr = lane & 15, fq = lane >> 4;
    const int K = g.K, nt = K / BK;
    unsigned voffA[2], voffB[2];
#pragma unroll
    for (int i = 0; i < 2; ++i) { int R, C; stage_rc(tid * 16 + i * 8192, R, C); const int Rb = Epi::PERM ? ((R & ~31) + perm32(R & 31)) : R;
        voffA[i] = (unsigned)(R * K + C) * 2u; voffB[i] = (unsigned)(Rb * K + C) * 2u; }
    const size_t kstep = (size_t)(BK * 2);
    const size_t hstep = (size_t)HALF * K * 2;
    const size_t tstep = 2 * hstep;
    const unsigned ldsw = (unsigned)wid * 1024u;
    const int aoff = lds_byte(wr * 64 + fr, fq * 8), boff = lds_byte(wc * 32 + fr, fq * 8);
#define PG8_SA(b, h) (((b) * 2 + (h)) * HTB)
#define PG8_SB(b, h) ((4 + (b) * 2 + (h)) * HTB)
#define PG8_STAGE(bufoff, gbase, voff) do { _Pragma("unroll") for (int _i = 0; _i < 2; ++_i) \
        __builtin_amdgcn_global_load_lds((const unsigned*)((const char*)(gbase) + (voff)[_i]), (PG8_LAS unsigned*)(lds + (bufoff) + ldsw + _i * 8192), 16, 0, 0); } while (0)
#define PG8_LDA(dst, b, h) do { _Pragma("unroll") for (int m = 0; m < 4; ++m) _Pragma("unroll") for (int k = 0; k < 2; ++k) dst[m][k] = *(const PG8_LAS bf16x8*)(lds + PG8_SA(b, h) + aoff + m * 2048 + k * 1024); } while (0)
#define PG8_LDB(dst, b, h) do { _Pragma("unroll") for (int n = 0; n < 2; ++n) _Pragma("unroll") for (int k = 0; k < 2; ++k) dst[n][k] = *(const PG8_LAS bf16x8*)(lds + PG8_SB(b, h) + boff + n * 2048 + k * 1024); } while (0)
#define PG8_MMA(ai, bj, At, Bt) do { __builtin_amdgcn_s_setprio(1); _Pragma("unroll") for (int m = 0; m < 4; ++m) _Pragma("unroll") for (int n = 0; n < 2; ++n) _Pragma("unroll") for (int k = 0; k < 2; ++k) \
        acc[ai][bj][m][n] = __builtin_amdgcn_mfma_f32_16x16x32_bf16(Bt[n][k], At[m][k], acc[ai][bj][m][n], 0, 0, 0); __builtin_amdgcn_s_setprio(0); } while (0)
#define PG8_WAIT_V(n) asm volatile("s_waitcnt vmcnt(" #n ")" ::: "memory")
#define PG8_WAIT_L(n) asm volatile("s_waitcnt lgkmcnt(" #n ")" ::: "memory")
#define PG8_BAR __builtin_amdgcn_s_barrier()
#define PG8_SCHED __builtin_amdgcn_sched_barrier(0)
    Unit cur, nxt; int ui = 0;
    if (!S.next(0, cur)) return;
    f32x4 acc[2][2][4][2];
#pragma unroll
    for (int a = 0; a < 2; ++a)
#pragma unroll
        for (int b = 0; b < 2; ++b)
#pragma unroll
            for (int m = 0; m < 4; ++m)
#pragma unroll
                for (int n = 0; n < 2; ++n) acc[a][b][m][n] = (f32x4){0.f, 0.f, 0.f, 0.f};
    bf16x8 At[4][2], B0[2][2], B1[2][2];
    const char* cA = (const char*)g.A + (size_t)cur.pm * tstep; const char* cB = (const char*)g.Bt + (size_t)cur.pn * tstep;
    S.a_ready(cur);
    if constexpr (SP2) {
        PG8_STAGE(PG8_SB(0, 0), cB, voffB); PG8_STAGE(PG8_SB(0, 1), cB + hstep, voffB); PG8_STAGE(PG8_SA(0, 0), cA, voffA); PG8_STAGE(PG8_SA(0, 1), cA + hstep, voffA);
        if (wr == 1) PG8_BAR;
        PG8_WAIT_V(2); PG8_BAR;
        PG8_STAGE(PG8_SB(1, 0), cB + kstep, voffB); PG8_STAGE(PG8_SA(1, 0), cA + kstep, voffA); PG8_STAGE(PG8_SB(1, 1), cB + hstep + kstep, voffB);
        PG8_WAIT_V(6); PG8_BAR;
    } else {
        PG8_STAGE(PG8_SB(0, 0), cB, voffB); PG8_STAGE(PG8_SA(0, 0), cA, voffA); PG8_STAGE(PG8_SB(0, 1), cB + hstep, voffB); PG8_STAGE(PG8_SA(0, 1), cA + hstep, voffA);
        if (wr == 1) PG8_BAR;
        PG8_WAIT_V(4); PG8_BAR;
        PG8_STAGE(PG8_SB(1, 0), cB + kstep, voffB); PG8_STAGE(PG8_SA(1, 0), cA + kstep, voffA); PG8_STAGE(PG8_SB(1, 1), cB + hstep + kstep, voffB);
        PG8_WAIT_V(6); PG8_BAR;
    }
    for (;;) {
        const bool has_next = S.next(ui + 1, nxt);
        const char* nA = has_next ? (const char*)g.A + (size_t)nxt.pm * tstep : cA; const char* nB = has_next ? (const char*)g.Bt + (size_t)nxt.pn * tstep : cB;
        for (int t = 0; t < nt; t += 2) {
            const bool last = (t == nt - 2);
            const char* a1 = cA + (size_t)(t + 1) * kstep;
            const char* a2 = last ? nA : cA + (size_t)(t + 2) * kstep; const char* b2 = last ? nB : cB + (size_t)(t + 2) * kstep;
            const char* a3 = a2 + kstep; const char* b3 = b2 + kstep;
            if (last && has_next) S.a_ready(nxt);
            if constexpr (SP2) {
            PG8_LDB(B0, 0, 0); PG8_LDB(B1, 0, 1); PG8_SCHED; PG8_LDA(At, 0, 0); PG8_STAGE(PG8_SA(1, 1), a1 + hstep, voffA);
            PG8_WAIT_V(8); PG8_WAIT_L(0); PG8_BAR; PG8_MMA(0, 0, At, B0); PG8_MMA(0, 1, At, B1); PG8_BAR; PG8_SCHED;
            PG8_LDA(At, 0, 1); PG8_STAGE(PG8_SB(0, 0), b2, voffB); PG8_STAGE(PG8_SB(0, 1), b2 + hstep, voffB); PG8_STAGE(PG8_SA(0, 0), a2, voffA);
            PG8_WAIT_V(8); PG8_WAIT_L(0); PG8_BAR; PG8_MMA(1, 0, At, B0); PG8_MMA(1, 1, At, B1); PG8_BAR; PG8_SCHED;
            PG8_LDB(B0, 1, 0); PG8_LDB(B1, 1, 1); PG8_SCHED; PG8_LDA(At, 1, 0); PG8_STAGE(PG8_SA(0, 1), a2 + hstep, voffA);
            PG8_WAIT_V(8); PG8_WAIT_L(0); PG8_BAR; PG8_MMA(0, 0, At, B0); PG8_MMA(0, 1, At, B1); PG8_BAR; PG8_SCHED;
            PG8_LDA(At, 1, 1); PG8_STAGE(PG8_SB(1, 0), b3, voffB); PG8_STAGE(PG8_SB(1, 1), b3 + hstep, voffB); PG8_STAGE(PG8_SA(1, 0), a3, voffA);
            PG8_WAIT_V(8); PG8_WAIT_L(0); PG8_BAR; PG8_MMA(1, 0, At, B0); PG8_MMA(1, 1, At, B1); PG8_BAR; PG8_SCHED;
            } else {
            PG8_LDB(B0, 0, 0); PG8_SCHED; PG8_LDA(At, 0, 0); PG8_STAGE(PG8_SA(1, 1), a1 + hstep, voffA);
            PG8_WAIT_L(8); PG8_BAR; PG8_WAIT_L(0); PG8_MMA(0, 0, At, B0); PG8_BAR; PG8_SCHED;
            PG8_LDB(B1, 0, 1); PG8_STAGE(PG8_SB(0, 0), b2, voffB);
            PG8_BAR; PG8_WAIT_L(0); PG8_MMA(0, 1, At, B1); PG8_BAR;
            PG8_LDA(At, 0, 1); PG8_STAGE(PG8_SA(0, 0), a2, voffA);
            PG8_BAR; PG8_WAIT_L(0); PG8_MMA(1, 0, At, B0); PG8_BAR; PG8_SCHED;
            PG8_STAGE(PG8_SB(0, 1), b2 + hstep, voffB);
            PG8_WAIT_V(6); PG8_BAR; PG8_MMA(1, 1, At, B1); PG8_BAR;
            PG8_LDB(B0, 1, 0); PG8_SCHED; PG8_LDA(At, 1, 0); PG8_STAGE(PG8_SA(0, 1), a2 + hstep, voffA);
            PG8_WAIT_L(8); PG8_BAR; PG8_WAIT_L(0); PG8_MMA(0, 0, At, B0); PG8_BAR; PG8_SCHED;
            PG8_LDB(B1, 1, 1); PG8_STAGE(PG8_SB(1, 0), b3, voffB);
            PG8_BAR; PG8_WAIT_L(0); PG8_MMA(0, 1, At, B1); PG8_BAR;
            PG8_LDA(At, 1, 1); PG8_STAGE(PG8_SA(1, 0), a3, voffA);
            PG8_BAR; PG8_WAIT_L(0); PG8_MMA(1, 0, At, B0); PG8_BAR; PG8_SCHED;
            PG8_STAGE(PG8_SB(1, 1), b3 + hstep, voffB);
            PG8_WAIT_V(6); PG8_BAR; PG8_MMA(1, 1, At, B1); PG8_BAR;
            }
        }
        if constexpr (ALIGN_EPI) { if (wr == 0) PG8_BAR; }
        if constexpr (!Epi::AFTER_DRAIN) { E(acc, cur, wr, wc, fr, fq); S.done(cur); }
        if (!has_next) break;
#pragma unroll
        for (int a = 0; a < 2; ++a)
#pragma unroll
            for (int b = 0; b < 2; ++b)
#pragma unroll
                for (int m = 0; m < 4; ++m)
#pragma unroll
                    for (int n = 0; n < 2; ++n) acc[a][b][m][n] = (f32x4){0.f, 0.f, 0.f, 0.f};
        cur = nxt; cA = nA; cB = nB; ++ui;
        if constexpr (ALIGN_EPI) { if (wr == 1) PG8_BAR; }
    }
    PG8_WAIT_V(0);
    if constexpr (!ALIGN_EPI) { if (wr == 0) PG8_BAR; }
    PG8_BAR;
    if constexpr (Epi::AFTER_DRAIN) { E.fused(acc, cur, wr, wc, fr, fq, lds, wid, lane); S.done(cur); }
#undef PG8_SA
#undef PG8_SB
#undef PG8_STAGE
#undef PG8_LDA
#undef PG8_LDB
#undef PG8_MMA
#undef PG8_WAIT_V
#undef PG8_WAIT_L
#undef PG8_BAR
#undef PG8_SCHED
}
}

constexpr int NWAVES = 8;
constexpr int NB = 4, SEQ = 4096, DM = 4096, M = NB * SEQ;
constexpr int INW = 15360, FF = 11008, NGU = 2 * FF, NMOD = 6 * DM;
constexpr float RMS_EPS = 1e-6f, LN_EPS = 1e-5f;

constexpr size_t MiB = 1u << 20;
constexpr size_t WS_CTL = 0, CTL_ZERO_BYTES = 1 * MiB;
constexpr size_t WS_MODP = 1 * MiB;
constexpr size_t WS_MOD = 25 * MiB;
constexpr size_t WS_ROPEC = 26 * MiB, WS_ROPES = 27 * MiB;
constexpr size_t WS_SGUW = 28 * MiB;
constexpr size_t WS_SVSTAT = 29 * MiB;
constexpr size_t WS_SSQ = 33 * MiB;
constexpr size_t WS_WIN = 64 * MiB, WS_WPS = 184 * MiB, WS_WPA = 200 * MiB, WS_WOUT = 216 * MiB, WS_WGU = 248 * MiB, WS_WDN = 420 * MiB;
constexpr size_t WS_Z = 512 * MiB;
constexpr size_t WS_A = 992 * MiB;
constexpr size_t WS_B = 1120 * MiB;
constexpr size_t WS_END = 1248 * MiB;
static_assert(WS_WIN + (size_t)INW * DM * 2 <= WS_WPS && WS_WPS + (size_t)DM * 2048 * 2 <= WS_WPA && WS_WPA + (size_t)DM * 2048 * 2 <= WS_WOUT && WS_WOUT + (size_t)DM * DM * 2 <= WS_WGU &&
              WS_WGU + (size_t)NGU * DM * 2 <= WS_WDN && WS_WDN + (size_t)DM * FF * 2 <= WS_Z && WS_Z + (size_t)M * INW * 2 <= WS_A && WS_A + (size_t)M * DM * 2 <= WS_B && WS_B + (size_t)M * DM * 2 <= WS_END, "d_ws map");
static_assert(WS_MODP + (size_t)64 * 4 * NMOD * 4 <= WS_MOD && WS_SVSTAT + (size_t)M * 64 * 4 <= WS_SSQ && WS_SSQ + (size_t)M * 64 * 4 <= WS_WIN, "d_ws map (small)");
constexpr int CW_BAR = 4096;

constexpr int LDS_BYTES = 147456;
constexpr int LDSCTL_OFF = LDS_BYTES - 256;

#define GAS __attribute__((address_space(1)))
#define LAS __attribute__((address_space(3)))
typedef unsigned short bf16;
typedef unsigned v4u __attribute__((ext_vector_type(4)));
typedef unsigned v2u __attribute__((ext_vector_type(2)));
typedef float f32x4 __attribute__((ext_vector_type(4)));
typedef float f32x2 __attribute__((ext_vector_type(2)));
typedef float f32x16 __attribute__((ext_vector_type(16)));
typedef short bf16x8 __attribute__((ext_vector_type(8)));
typedef short s16x4 __attribute__((ext_vector_type(4)));
typedef GAS unsigned gu32;
#define RLX_AGENT __ATOMIC_RELAXED, __HIP_MEMORY_SCOPE_AGENT
#define LDS_WAIT() asm volatile("s_waitcnt lgkmcnt(0)" ::: "memory")
using pg8::pk_bf16; using pg8::bf_lo; using pg8::bf_hi;

__device__ __forceinline__ float wave_sum(float v) {
#pragma unroll
    for (int o = 1; o < 64; o <<= 1) v += __shfl_xor(v, o);
    return v;
}
#define XB_TMO      128
#define XB_XCNT(j)  (256  + 64 * (j))
#define XB_XSUB(j)  (1280 + 64 * (j))
#define XB_XGEN(j)  (2304 + 64 * (j))
#define XB_TOP      3328
#define XB_TOPGEN   3392
#define XCD_BAR_WORDS 3456
#define XB_SPIN_CAP (1u << 18)

__device__ __forceinline__ unsigned xb_ld(unsigned* p)              { return __hip_atomic_load(p, __ATOMIC_RELAXED, __HIP_MEMORY_SCOPE_AGENT); }
__device__ __forceinline__ unsigned xb_add(unsigned* p, unsigned v) { return __hip_atomic_fetch_add(p, v, __ATOMIC_RELAXED, __HIP_MEMORY_SCOPE_AGENT); }
__device__ __forceinline__ unsigned xb_xcc_id() { return (unsigned)__builtin_amdgcn_s_getreg((3 << 11) | 20) & 0xFu; }
#define XB_SPIN(cond, bar) do { unsigned _sp = 0; while (cond) { __builtin_amdgcn_s_sleep(1); \
    if ((++_sp & 255u) == 0u) { if (xb_ld(&(bar)[XB_TMO])) break; if (_sp > XB_SPIN_CAP) { atomicAdd(&(bar)[XB_TMO], 1u); break; } } } } while (0)

struct XcdBarrier {
    unsigned* bar; unsigned x;
    volatile LAS unsigned* st;
};

__device__ __forceinline__ XcdBarrier xcd_barrier_post(unsigned* bar, volatile LAS unsigned* st) {
    XcdBarrier b; b.bar = bar; b.x = xb_xcc_id(); b.st = st;
    if (threadIdx.x == 0) (void)xb_add(&bar[XB_XCNT(b.x)], 1u);
    return b;
}
__device__ __forceinline__ void xcd_barrier_complete(unsigned* bar, unsigned x, unsigned& nloc, unsigned& nx) {
    const unsigned G = gridDim.x * gridDim.y * gridDim.z;
    unsigned sum, cnt, mine, sp = 0u;
    for (;;) {
        sum = 0u; cnt = 0u; mine = 0u;
#pragma unroll
        for (unsigned j = 0; j < 16; ++j) { const unsigned c = xb_ld(&bar[XB_XCNT(j)]); sum += c; cnt += (c > 0u) ? 1u : 0u; mine = (j == x) ? c : mine; }
        if (sum == G) break;
        __builtin_amdgcn_s_sleep(1);
        if ((++sp & 255u) == 0u) { if (xb_ld(&bar[XB_TMO])) break; if (sp > XB_SPIN_CAP) { atomicAdd(&bar[XB_TMO], 1u); break; } }
    }
    nloc = mine > 0u ? mine : 1u; nx = cnt > 0u ? cnt : 1u;
}

__device__ __forceinline__ void xcd_barrier(const XcdBarrier& b) {
    asm volatile("s_waitcnt vmcnt(0)" ::: "memory");
    __syncthreads();
    if (threadIdx.x == 0) {
        unsigned* bar = b.bar;
        __builtin_amdgcn_s_waitcnt(0);
        unsigned nloc = b.st[0], nx = b.st[1];
        if (nloc == 0u) { xcd_barrier_complete(bar, b.x, nloc, nx); b.st[0] = nloc; b.st[1] = nx; }
        const unsigned old = xb_add(&bar[XB_XSUB(b.x)], 1u);
        const unsigned gen = old / nloc;
        if (old + 1u == (gen + 1u) * nloc) {
            __builtin_amdgcn_fence(__ATOMIC_RELEASE, "agent");
            asm volatile("s_waitcnt vmcnt(0)" ::: "memory");
            const unsigned og = xb_add(&bar[XB_TOP], 1u);
            const unsigned tg = og / nx;
            if (og + 1u == (tg + 1u) * nx) xb_add(&bar[XB_TOPGEN], 1u);
            else XB_SPIN(xb_ld(&bar[XB_TOPGEN]) == tg, bar);
            __builtin_amdgcn_fence(__ATOMIC_ACQUIRE, "agent");
            xb_add(&bar[XB_XGEN(b.x)], 1u);
            asm volatile("s_waitcnt vmcnt(0)" ::: "memory");
        } else {
            XB_SPIN(xb_ld(&bar[XB_XGEN(b.x)]) == gen, bar);
            __builtin_amdgcn_fence(__ATOMIC_ACQUIRE, "agent");
            asm volatile("s_waitcnt vmcnt(0)" ::: "memory");
        }
    }
    __syncthreads();
}

__device__ const float ROPE_INVF[16] = {1.0f, 0.44036659598350525f, 0.1939227432012558f, 0.08539710193872452f, 0.03760603070259094f, 0.016560440883040428f, 0.007292664609849453f, 0.0032114461064338684f,
                                        0.0014142135623842478f, 0.0006227724370546639f, 0.00027424818836152554f, 0.00012076973507646471f, 5.3182957344688475e-05f, 2.34199997066753e-05f, 1.0313385246263351e-05f, 4.541670477919979e-06f};

__device__ __forceinline__ void p0_transpose_item(const float* __restrict__ W, int K, int N, bf16* __restrict__ WT, int k0, int n0, int dst_row0, LAS float* scr, int lane) {
    const int sub = lane >> 4, c4 = lane & 15;
    f32x4 v[16];
#pragma unroll
    for (int i = 0; i < 16; ++i) v[i] = *(const f32x4*)(W + (size_t)(k0 + 4 * i + sub) * N + n0 + 4 * c4);
#pragma unroll
    for (int i = 0; i < 16; ++i) { LAS float* p = scr + (4 * i + sub) * 65 + 4 * c4; p[0] = v[i][0]; p[1] = v[i][1]; p[2] = v[i][2]; p[3] = v[i][3]; }
    LDS_WAIT();
    const int c8 = lane & 7;
#pragma unroll
    for (int it = 0; it < 8; ++it) { const int nn = (lane >> 3) + 8 * it; const LAS float* s = scr + (8 * c8) * 65 + nn;
        v4u o; o.x = pk_bf16(s[0 * 65], s[1 * 65]); o.y = pk_bf16(s[2 * 65], s[3 * 65]); o.z = pk_bf16(s[4 * 65], s[5 * 65]); o.w = pk_bf16(s[6 * 65], s[7 * 65]);
        *(v4u*)(WT + (size_t)(dst_row0 + nn) * K + k0 + 8 * c8) = o; }
    LDS_WAIT();
}
__device__ __forceinline__ void p0_gemv_item(const float* __restrict__ c, const float* __restrict__ w_ada, float* __restrict__ part, int cg, int kc, LAS float* scr, int lane) {
    const int k0 = kc * 64;
#pragma unroll
    for (int b = 0; b < 4; ++b) { const float cv = c[b * DM + k0 + lane]; scr[b * 64 + lane] = cv / (1.0f + __expf(-cv)); }
    LDS_WAIT();
    f32x4 a0 = {0.f, 0.f, 0.f, 0.f}, a1 = a0, a2 = a0, a3 = a0;
    const float* wp = w_ada + (size_t)k0 * NMOD + cg * 256 + 4 * lane;
#pragma unroll 8
    for (int kk = 0; kk < 64; ++kk) { const f32x4 w = *(const f32x4*)(wp + (size_t)kk * NMOD);
        a0 += w * scr[kk]; a1 += w * scr[64 + kk]; a2 += w * scr[128 + kk]; a3 += w * scr[192 + kk]; }
    float* pp = part + (size_t)(kc * 4) * NMOD + cg * 256 + 4 * lane;
    *(f32x4*)(pp) = a0; *(f32x4*)(pp + NMOD) = a1; *(f32x4*)(pp + 2 * NMOD) = a2; *(f32x4*)(pp + 3 * NMOD) = a3;
    LDS_WAIT();
}
struct P0Args { const float *c, *w_ada, *w_in, *sgu_w, *w_ps, *w_pa, *w_out, *w_gate, *w_up, *w_down; const int* positions;
                float *modp, *ropeC, *ropeS; bf16 *sguw, *win_t, *wps_t, *wpa_t, *wout_t, *wgu_t, *wdn_t; };
__device__ __forceinline__ void p0_prologue(const P0Args& A, LAS unsigned char* lds, int gw, int NGW, int wave, int lane) {
    LAS float* scr = (LAS float*)(lds + wave * 16640);
    constexpr int I_GEMV = 96 * 64;
    constexpr int I_IN = (DM / 64) * (INW / 64), I_PS = (2048 / 64) * (DM / 64), I_OUT = (DM / 64) * (DM / 64), I_G = (DM / 64) * (FF / 64), I_DN = (FF / 64) * (DM / 64);
    constexpr int I_ROPE = M / 64, I_SW = 64;
    constexpr int NITEMS = I_GEMV + I_IN + 2 * I_PS + I_OUT + 2 * I_G + I_DN + I_ROPE + I_SW;
    for (int it = gw; it < NITEMS; it += NGW) {
        int r = it;
        if (r < I_GEMV) { p0_gemv_item(A.c, A.w_ada, A.modp, r % 96, r / 96, scr, lane); continue; } r -= I_GEMV;
        if (r < I_IN) { const int nnb = INW / 64, kb = r / nnb, nb = r % nnb; p0_transpose_item(A.w_in, DM, INW, A.win_t, 64 * kb, 64 * nb, 64 * nb, scr, lane); continue; } r -= I_IN;
        if (r < I_PS) { const int nnb = DM / 64, kb = r / nnb, nb = r % nnb; p0_transpose_item(A.w_ps, 2048, DM, A.wps_t, 64 * kb, 64 * nb, 64 * nb, scr, lane); continue; } r -= I_PS;
        if (r < I_PS) { const int nnb = DM / 64, kb = r / nnb, nb = r % nnb; p0_transpose_item(A.w_pa, 2048, DM, A.wpa_t, 64 * kb, 64 * nb, 64 * nb, scr, lane); continue; } r -= I_PS;
        if (r < I_OUT) { const int nnb = DM / 64, kb = r / nnb, nb = r % nnb; p0_transpose_item(A.w_out, DM, DM, A.wout_t, 64 * kb, 64 * nb, 64 * nb, scr, lane); continue; } r -= I_OUT;
        if (r < I_G) { const int nnb = FF / 64, kb = r / nnb, nb = r % nnb, n0 = 64 * nb;
            p0_transpose_item(A.w_gate, DM, FF, A.wgu_t, 64 * kb, n0, 256 * (n0 >> 7) + (n0 & 127), scr, lane); continue; } r -= I_G;
        if (r < I_G) { const int nnb = FF / 64, kb = r / nnb, nb = r % nnb, n0 = 64 * nb;
            p0_transpose_item(A.w_up, DM, FF, A.wgu_t, 64 * kb, n0, 256 * (n0 >> 7) + 128 + (n0 & 127), scr, lane); continue; } r -= I_G;
        if (r < I_DN) { const int nnb = DM / 64, kb = r / nnb, nb = r % nnb; p0_transpose_item(A.w_down, FF, DM, A.wdn_t, 64 * kb, 64 * nb, 64 * nb, scr, lane); continue; } r -= I_DN;
        if (r < I_ROPE) {
#pragma unroll 4
            for (int e = 0; e < 16; ++e) { const int idx = r * 1024 + e * 64 + lane, mrow = idx >> 4, i = idx & 15;
                const float ang = (float)A.positions[mrow] * ROPE_INVF[i];
                const double rev = (double)ang * 0.15915494309189535; const float fr = (float)(rev - __builtin_rint(rev));
                A.ropeC[idx] = __builtin_amdgcn_cosf(fr); A.ropeS[idx] = __builtin_amdgcn_sinf(fr); }
            continue; } r -= I_ROPE;
        {
#pragma unroll 4
            for (int e = 0; e < 64; ++e) { const int idx = r * 4096 + e * 64 + lane, t = (idx >> 7) & 127, s = idx & 127;
                const float w = (s <= t) ? A.sgu_w[idx] : 0.0f; A.sguw[idx] = (bf16)(pk_bf16(w, 0.f) & 0xffffu); }
        }
    }
}
__device__ __forceinline__ void p1_mod_reduce(const float* __restrict__ modp, const float* __restrict__ b_ada, const float* g_pre_mix, const float* g_post_mix, const float* g_pre_ffn, const float* g_post_ffn,
                                              float* __restrict__ mod, int gtid, int gthreads) {
    for (int idx = gtid; idx < 4 * (NMOD / 4); idx += gthreads) {
        const int b = idx / (NMOD / 4), j = 4 * (idx % (NMOD / 4));
        f32x4 s = *(const f32x4*)(b_ada + j);
#pragma unroll 8
        for (int kc = 0; kc < 64; ++kc) s += *(const f32x4*)(modp + (size_t)(kc * 4 + b) * NMOD + j);
        const int chunk = j >> 12, e = j & 4095;
        if (chunk == 1) s = *(const f32x4*)(g_pre_mix + e) * (s + 1.0f);
        else if (chunk == 2) s = s * *(const f32x4*)(g_post_mix + e);
        else if (chunk == 4) s = *(const f32x4*)(g_pre_ffn + e) * (s + 1.0f);
        else if (chunk == 5) s = s * *(const f32x4*)(g_post_ffn + e);
        *(f32x4*)(mod + (size_t)b * NMOD + j) = s;
    }
}
__device__ __forceinline__ void p2_norm_rows(const float* __restrict__ x, const float* __restrict__ mod, bf16* __restrict__ h, int gw, int NGW, int lane) {
    for (int m = gw; m < M; m += NGW) {
        const f32x4* xr = (const f32x4*)(x + (size_t)m * DM) + lane;
        f32x4 v[16]; float ss = 0.f;
#pragma unroll
        for (int j = 0; j < 16; ++j) { v[j] = xr[64 * j]; ss += (v[j].x * v[j].x + v[j].y * v[j].y) + (v[j].z * v[j].z + v[j].w * v[j].w); }
        const float rstd = 1.0f / sqrtf(wave_sum(ss) * (1.0f / DM) + RMS_EPS);
        const int b = m >> 12;
        const f32x4* sh = (const f32x4*)(mod + (size_t)b * NMOD + 0 * DM) + lane; const f32x4* ga = (const f32x4*)(mod + (size_t)b * NMOD + 1 * DM) + lane;
        v2u* o8 = (v2u*)(h + (size_t)m * DM) + lane;
#pragma unroll
        for (int j = 0; j < 16; ++j) { const f32x4 o = (v[j] * rstd) * ga[64 * j] + sh[64 * j]; o8[64 * j] = (v2u){pk_bf16(o.x, o.y), pk_bf16(o.z, o.w)};
            if ((j & 3) == 3) asm volatile("" ::: "memory"); }
    }
}
__device__ __forceinline__ void p7_mid_rows(const float* __restrict__ x, const bf16* __restrict__ y, const float* __restrict__ ssq, const float* __restrict__ mod, float* __restrict__ x1, bf16* __restrict__ h2, int gw, int NGW, int lane) {
    for (int m = gw; m < M; m += NGW) {
        const float rstd1 = 1.0f / sqrtf(wave_sum(ssq[(size_t)m * 64 + lane]) * (1.0f / DM) + RMS_EPS);
        const int b = m >> 12;
        const f32x4* xr = (const f32x4*)(x + (size_t)m * DM) + lane; const v2u* yr = (const v2u*)(y + (size_t)m * DM) + lane;
        const f32x4* gp = (const f32x4*)(mod + (size_t)b * NMOD + 2 * DM) + lane;
        f32x4* x1r = (f32x4*)(x1 + (size_t)m * DM) + lane;
        f32x4 v[16]; float ss = 0.f;
#pragma unroll
        for (int j = 0; j < 16; ++j) { const v2u yw = yr[64 * j]; const f32x4 yv = {bf_lo(yw.x), bf_hi(yw.x), bf_lo(yw.y), bf_hi(yw.y)};
            v[j] = xr[64 * j] + (yv * rstd1) * gp[64 * j]; x1r[64 * j] = v[j];
            ss += (v[j].x * v[j].x + v[j].y * v[j].y) + (v[j].z * v[j].z + v[j].w * v[j].w);
            if ((j & 3) == 3) asm volatile("" ::: "memory"); }
        const float rstd2 = 1.0f / sqrtf(wave_sum(ss) * (1.0f / DM) + RMS_EPS);
        const f32x4* sh = (const f32x4*)(mod + (size_t)b * NMOD + 3 * DM) + lane; const f32x4* ga = (const f32x4*)(mod + (size_t)b * NMOD + 4 * DM) + lane;
        v2u* o8 = (v2u*)(h2 + (size_t)m * DM) + lane;
#pragma unroll
        for (int j = 0; j < 16; ++j) { const f32x4 o = (v[j] * rstd2) * ga[64 * j] + sh[64 * j]; o8[64 * j] = (v2u){pk_bf16(o.x, o.y), pk_bf16(o.z, o.w)};
            if ((j & 3) == 3) asm volatile("" ::: "memory"); }
    }
}
__device__ __forceinline__ void p10_final_rows(const bf16* __restrict__ f, const float* __restrict__ ssq, const float* __restrict__ mod, float* __restrict__ out, int gw, int NGW, int lane) {
    for (int m = gw; m < M; m += NGW) {
        const float rstd = 1.0f / sqrtf(wave_sum(ssq[(size_t)m * 64 + lane]) * (1.0f / DM) + RMS_EPS);
        const int b = m >> 12;
        const v2u* fr = (const v2u*)(f + (size_t)m * DM) + lane; const f32x4* gp = (const f32x4*)(mod + (size_t)b * NMOD + 5 * DM) + lane;
        f32x4* orow = (f32x4*)(out + (size_t)m * DM) + lane;
#pragma unroll
        for (int j = 0; j < 16; ++j) { const v2u fw = fr[64 * j]; const f32x4 fv = {bf_lo(fw.x), bf_hi(fw.x), bf_lo(fw.y), bf_hi(fw.y)};
            orow[64 * j] = orow[64 * j] + (fv * rstd) * gp[64 * j];
            if ((j & 7) == 7) asm volatile("" ::: "memory"); }
    }
}

namespace att {
constexpr int KSTR = 272, VSTR = 520, K_OFF = 0, V_OFF = 256 * KSTR, END_OFF = V_OFF + 128 * VSTR;
static_assert(END_OFF <= LDSCTL_OFF, "attention LDS");
__device__ __forceinline__ void attn_unit(LAS unsigned char* lds, const bf16* __restrict__ Z, bf16* __restrict__ AO, const float* __restrict__ sinks, int unit, int tid) {
    const int b = unit >> 7, rem = unit & 127, n = rem >> 2, kvh = rem & 3;
    const int m0 = b * SEQ + n * 128;
#pragma unroll
    for (int it = 0; it < 8; ++it) { const int kk = (tid >> 4) + 32 * it, dc = tid & 15;
        v4u v = {0u, 0u, 0u, 0u};
        if (n > 0 || kk >= 128) v = *(const v4u*)(Z + (size_t)(m0 - 128 + kk) * INW + pg8::ZO_K + kvh * 128 + dc * 8);
        *(LAS v4u*)(lds + K_OFF + kk * KSTR + dc * 16) = v; }
#pragma unroll
    for (int it = 0; it < 8; ++it) { const int kk = tid & 255, dc = (tid >> 8) + 2 * it;
        v4u v = {0u, 0u, 0u, 0u};
        if (n > 0 || kk >= 128) v = *(const v4u*)(Z + (size_t)(m0 - 128 + kk) * INW + pg8::ZO_V + kvh * 128 + dc * 8);
        LAS unsigned char* vp = lds + V_OFF + (dc * 8) * VSTR + kk * 2;
        *(LAS unsigned short*)(vp + 0 * VSTR) = (unsigned short)(v.x & 0xffffu); *(LAS unsigned short*)(vp + 1 * VSTR) = (unsigned short)(v.x >> 16);
        *(LAS unsigned short*)(vp + 2 * VSTR) = (unsigned short)(v.y & 0xffffu); *(LAS unsigned short*)(vp + 3 * VSTR) = (unsigned short)(v.y >> 16);
        *(LAS unsigned short*)(vp + 4 * VSTR) = (unsigned short)(v.z & 0xffffu); *(LAS unsigned short*)(vp + 5 * VSTR) = (unsigned short)(v.z >> 16);
        *(LAS unsigned short*)(vp + 6 * VSTR) = (unsigned short)(v.w & 0xffffu); *(LAS unsigned short*)(vp + 7 * VSTR) = (unsigned short)(v.w >> 16); }
    __syncthreads();
    const int wid = tid >> 6, lane = tid & 63, r = lane & 31, h = lane >> 5;
    const int hf = wid & 1, head = kvh * 4 + (wid >> 1);
    const float sink = sinks[head];
    constexpr float SCALE = 0.08838834764831845f, LOG2E = 1.4426950408889634f;
#pragma unroll 1
    for (int qt = 0; qt < 2; ++qt) {
        const int ql0 = hf * 64 + qt * 32;
        const size_t mq = (size_t)(m0 + ql0 + r);
        bf16x8 qf[8];
#pragma unroll
        for (int ks = 0; ks < 8; ++ks) qf[ks] = *(const bf16x8*)(Z + mq * INW + pg8::ZO_Q + head * 128 + ks * 16 + 8 * h);
        f32x16 S[5];
#pragma unroll
        for (int kt = 0; kt < 5; ++kt) {
#pragma unroll
            for (int i = 0; i < 16; ++i) S[kt][i] = 0.f;
#pragma unroll
            for (int ks = 0; ks < 8; ++ks) { const bf16x8 kf = *(const LAS bf16x8*)(lds + K_OFF + (ql0 + 32 * kt + r) * KSTR + (ks * 16 + 8 * h) * 2);
                S[kt] = __builtin_amdgcn_mfma_f32_32x32x16_bf16(kf, qf[ks], S[kt], 0, 0, 0); } }
        float mx = sink;
#pragma unroll
        for (int kt = 0; kt < 5; ++kt)
#pragma unroll
            for (int i = 0; i < 16; ++i) { const int cr = (i & 3) + 8 * (i >> 2) + 4 * h;
                const int diff = 128 + r - 32 * kt - cr;
                const bool valid = ((unsigned)diff < 128u) && (n > 0 || (ql0 + 32 * kt + cr) >= 128);
                const float s = valid ? S[kt][i] * SCALE : -__builtin_inff();
                S[kt][i] = s; mx = fmaxf(mx, s); }
        mx = fmaxf(mx, __shfl_xor(mx, 32));
        float sum = 0.f;
#pragma unroll
        for (int kt = 0; kt < 5; ++kt)
#pragma unroll
            for (int i = 0; i < 16; ++i) { const float p = __builtin_amdgcn_exp2f((S[kt][i] - mx) * LOG2E); S[kt][i] = p; sum += p; }
        sum += __shfl_xor(sum, 32);
        const float inv = 1.0f / (sum + __builtin_amdgcn_exp2f((sink - mx) * LOG2E));
        f32x16 O[4];
#pragma unroll
        for (int dt = 0; dt < 4; ++dt)
#pragma unroll
            for (int i = 0; i < 16; ++i) O[dt][i] = 0.f;
#pragma unroll
        for (int kt = 0; kt < 5; ++kt)
#pragma unroll
            for (int s = 0; s < 2; ++s) {
                v4u pw; pw.x = pk_bf16(S[kt][8 * s + 0], S[kt][8 * s + 1]); pw.y = pk_bf16(S[kt][8 * s + 2], S[kt][8 * s + 3]);
                pw.z = pk_bf16(S[kt][8 * s + 4], S[kt][8 * s + 5]); pw.w = pk_bf16(S[kt][8 * s + 6], S[kt][8 * s + 7]);
                const bf16x8 pf = __builtin_bit_cast(bf16x8, pw);
#pragma unroll
                for (int dt = 0; dt < 4; ++dt) { const LAS unsigned char* vp = lds + V_OFF + (dt * 32 + r) * VSTR + (ql0 + 32 * kt + 16 * s + 4 * h) * 2;
                    const s16x4 lo = *(const LAS s16x4*)vp, hi = *(const LAS s16x4*)(vp + 16);
                    const bf16x8 vf = __builtin_shufflevector(lo, hi, 0, 1, 2, 3, 4, 5, 6, 7);
                    O[dt] = __builtin_amdgcn_mfma_f32_32x32x16_bf16(vf, pf, O[dt], 0, 0, 0); } }
        bf16* op = AO + mq * 2048 + head * 128 + 4 * h;
#pragma unroll
        for (int dt = 0; dt < 4; ++dt)
#pragma unroll
            for (int gq = 0; gq < 4; ++gq)
                *(v2u*)(op + dt * 32 + 8 * gq) = (v2u){pk_bf16(O[dt][4 * gq] * inv, O[dt][4 * gq + 1] * inv), pk_bf16(O[dt][4 * gq + 2] * inv, O[dt][4 * gq + 3] * inv)};
    }
    __syncthreads();
}
}

namespace sgu {
constexpr int VN_STR = 272, VN_OFF = 0, STAT_OFF = 128 * VN_STR;
__device__ __forceinline__ void sgu_unit(LAS unsigned char* lds, const bf16* __restrict__ Z, const float* __restrict__ svstat, const float* __restrict__ ln_g, const float* __restrict__ ln_b,
                                         const bf16* __restrict__ Wb, const float* __restrict__ bs, bf16* __restrict__ SO, int unit, int tid) {
    const int g = unit & 15, m0 = (unit >> 4) * 128;
    LAS float* st = (LAS float*)(lds + STAT_OFF);
    if (tid < 128) { const f32x4* p = (const f32x4*)(svstat + (size_t)(m0 + tid) * 64); float s1 = 0.f, s2 = 0.f;
#pragma unroll
        for (int i = 0; i < 16; ++i) { const f32x4 v = p[i]; s1 += v.x + v.z; s2 += v.y + v.w; }
        const float mu = s1 * (1.0f / 2048.0f), var = fmaxf(s2 * (1.0f / 2048.0f) - mu * mu, 0.f);
        st[tid] = mu; st[128 + tid] = 1.0f / sqrtf(var + LN_EPS); }
    __syncthreads();
#pragma unroll
    for (int it = 0; it < 4; ++it) { const int s = tid & 127, cc = (tid >> 7) + 4 * it;
        const v4u v = *(const v4u*)(Z + (size_t)(m0 + s) * INW + pg8::ZO_SV + g * 128 + cc * 8);
        const float mu = st[s], rs = st[128 + s];
        const float* gp = ln_g + g * 128 + cc * 8; const float* bp = ln_b + g * 128 + cc * 8;
        LAS unsigned char* vp = lds + VN_OFF + (cc * 8) * VN_STR + s * 2;
        const float x0 = bf_lo(v.x), x1 = bf_hi(v.x), x2 = bf_lo(v.y), x3 = bf_hi(v.y), x4 = bf_lo(v.z), x5 = bf_hi(v.z), x6 = bf_lo(v.w), x7 = bf_hi(v.w);
        *(LAS unsigned short*)(vp + 0 * VN_STR) = (unsigned short)(pk_bf16((x0 - mu) * rs * gp[0] + bp[0], 0.f) & 0xffffu);
        *(LAS unsigned short*)(vp + 1 * VN_STR) = (unsigned short)(pk_bf16((x1 - mu) * rs * gp[1] + bp[1], 0.f) & 0xffffu);
        *(LAS unsigned short*)(vp + 2 * VN_STR) = (unsigned short)(pk_bf16((x2 - mu) * rs * gp[2] + bp[2], 0.f) & 0xffffu);
        *(LAS unsigned short*)(vp + 3 * VN_STR) = (unsigned short)(pk_bf16((x3 - mu) * rs * gp[3] + bp[3], 0.f) & 0xffffu);
        *(LAS unsigned short*)(vp + 4 * VN_STR) = (unsigned short)(pk_bf16((x4 - mu) * rs * gp[4] + bp[4], 0.f) & 0xffffu);
        *(LAS unsigned short*)(vp + 5 * VN_STR) = (unsigned short)(pk_bf16((x5 - mu) * rs * gp[5] + bp[5], 0.f) & 0xffffu);
        *(LAS unsigned short*)(vp + 6 * VN_STR) = (unsigned short)(pk_bf16((x6 - mu) * rs * gp[6] + bp[6], 0.f) & 0xffffu);
        *(LAS unsigned short*)(vp + 7 * VN_STR) = (unsigned short)(pk_bf16((x7 - mu) * rs * gp[7] + bp[7], 0.f) & 0xffffu); }
    __syncthreads();
    const int wid = tid >> 6, lane = tid & 63, i = lane & 15, quad = lane >> 4, tb = 16 * wid;
    f32x4 acc[8];
#pragma unroll
    for (int ct = 0; ct < 8; ++ct) acc[ct] = (f32x4){0.f, 0.f, 0.f, 0.f};
#pragma unroll
    for (int ks = 0; ks < 4; ++ks) {
        if (32 * ks <= tb + 15) {
            const bf16x8 wf = *(const bf16x8*)(Wb + (size_t)(g * 128 + tb + i) * 128 + ks * 32 + quad * 8);
#pragma unroll
            for (int ct = 0; ct < 8; ++ct) { const bf16x8 vf = *(const LAS bf16x8*)(lds + VN_OFF + (ct * 16 + i) * VN_STR + (ks * 32 + quad * 8) * 2);
                acc[ct] = __builtin_amdgcn_mfma_f32_16x16x32_bf16(vf, wf, acc[ct], 0, 0, 0); } } }
    const int t = tb + i; const size_t row = (size_t)(m0 + t); const float bias = bs[g * 128 + t];
#pragma unroll
    for (int ct = 0; ct < 8; ++ct) { const int c = g * 128 + ct * 16 + quad * 4;
        const v2u sw = *(const v2u*)(Z + row * INW + pg8::ZO_SU + c);
        const float o0 = bf_lo(sw.x) * (acc[ct][0] + bias), o1 = bf_hi(sw.x) * (acc[ct][1] + bias), o2 = bf_lo(sw.y) * (acc[ct][2] + bias), o3 = bf_hi(sw.y) * (acc[ct][3] + bias);
        *(v2u*)(SO + row * 2048 + c) = (v2u){pk_bf16(o0, o1), pk_bf16(o2, o3)}; }
    __syncthreads();
}
}

#ifndef MK_N_LAUNCHES
#define MK_N_LAUNCHES 11
#endif
constexpr int N_PHASES = 11, N_LAUNCHES = MK_N_LAUNCHES;
struct Args { const void* in[21]; float* out; unsigned char* ws; int ph_lo, ph_hi; };
static_assert(sizeof(Args) == 21 * 8 + 8 + 8 + 8, "Args has no holes");

typedef const __attribute__((address_space(4))) unsigned char* kargp_t;
#define KP_REFRESH() kargp_t kp = kbase; asm volatile("" : "+s"(kp))
#define KIN(T, i) (*(T* const __attribute__((address_space(4)))*)(kp + 8 * (i)))
#define KOUT() (*(float* const __attribute__((address_space(4)))*)(kp + 8 * 21))
#define KWS() (*(unsigned char* const __attribute__((address_space(4)))*)(kp + 8 * 22))
__global__ void __launch_bounds__(NWAVES * 64, 2) fwd(Args args) {
    extern __shared__ __attribute__((aligned(16))) unsigned char lds_raw[];
    LAS unsigned char* lds = (LAS unsigned char*)lds_raw;
    const kargp_t kbase = (kargp_t)__builtin_amdgcn_kernarg_segment_ptr();
    const int tid = threadIdx.x, lane = tid & 63, wave = __builtin_amdgcn_readfirstlane(tid >> 6);
    const int G = gridDim.x, bx = blockIdx.x;
    const int vcu = (G % 8 == 0) ? (bx % 8) * (G / 8) + bx / 8 : bx;
    const int gw = vcu * NWAVES + wave, NGW = G * NWAVES;

    for (int u = tid; u < (LDS_BYTES - LDSCTL_OFF) / 4; u += NWAVES * 64) ((LAS unsigned*)(lds + LDSCTL_OFF))[u] = 0u;
    __syncthreads();
    XcdBarrier bar; bar.bar = (unsigned*)(args.ws + WS_CTL) + CW_BAR; bar.x = 0; bar.st = nullptr;
    if (N_LAUNCHES == 1) bar = xcd_barrier_post((unsigned*)(args.ws + WS_CTL) + CW_BAR, (volatile LAS unsigned*)(lds + LDSCTL_OFF));
    const int lo = args.ph_lo, hi = args.ph_hi;
#define IN(k) (lo <= (k) && (k) < hi)
#define SEAM(k) do { if (IN(k) && IN((k) + 1)) xcd_barrier(bar); } while (0)

    if (IN(0)) {
        KP_REFRESH(); unsigned char* ws = KWS();
        P0Args A; A.c = KIN(const float, 1); A.w_ada = KIN(const float, 3); A.w_in = KIN(const float, 6); A.sgu_w = KIN(const float, 10); A.w_ps = KIN(const float, 12); A.w_pa = KIN(const float, 13);
        A.w_out = KIN(const float, 14); A.w_gate = KIN(const float, 17); A.w_up = KIN(const float, 18); A.w_down = KIN(const float, 19); A.positions = KIN(const int, 2);
        A.modp = (float*)(ws + WS_MODP); A.ropeC = (float*)(ws + WS_ROPEC); A.ropeS = (float*)(ws + WS_ROPES); A.sguw = (bf16*)(ws + WS_SGUW);
        A.win_t = (bf16*)(ws + WS_WIN); A.wps_t = (bf16*)(ws + WS_WPS); A.wpa_t = (bf16*)(ws + WS_WPA); A.wout_t = (bf16*)(ws + WS_WOUT); A.wgu_t = (bf16*)(ws + WS_WGU); A.wdn_t = (bf16*)(ws + WS_WDN);
        p0_prologue(A, lds, gw, NGW, wave, lane);
    }
    SEAM(0);
    if (IN(1)) { KP_REFRESH(); unsigned char* ws = KWS();
        p1_mod_reduce((const float*)(ws + WS_MODP), KIN(const float, 4), KIN(const float, 5), KIN(const float, 15), KIN(const float, 16), KIN(const float, 20), (float*)(ws + WS_MOD), bx * (NWAVES * 64) + tid, G * NWAVES * 64); }
    SEAM(1);
    if (IN(2)) { KP_REFRESH(); unsigned char* ws = KWS(); p2_norm_rows(KIN(const float, 0), (const float*)(ws + WS_MOD), (bf16*)(ws + WS_A), gw, NGW, lane); }
    SEAM(2);
    if (IN(3)) { KP_REFRESH(); unsigned char* ws = KWS();
        pg8::Gemm g{(const bf16*)(ws + WS_A), (const bf16*)(ws + WS_WIN), M, INW, DM}; pg8::StaticOrder S; S.init(M, INW, G, bx);
        pg8::EpiZ E{(bf16*)(ws + WS_Z), (const float*)(ws + WS_ROPEC), (const float*)(ws + WS_ROPES), (float*)(ws + WS_SVSTAT)};
        pg8::gemm_phase<pg8::EpiZ, pg8::StaticOrder, true, true>(lds, g, S, E);
    }
    SEAM(3);
    if (IN(4)) { KP_REFRESH(); unsigned char* ws = KWS();
        { const bf16* Zb = (const bf16*)(ws + WS_Z); bf16* AO = (bf16*)(ws + WS_B); const float* sinks = KIN(const float, 7);
          for (int u = bx; u < 512; u += G) att::attn_unit(lds, Zb, AO, sinks, u, tid); }
        { const bf16* Zb = (const bf16*)(ws + WS_Z); bf16* SO = (bf16*)(ws + WS_B + (size_t)M * 2048 * 2);
          const float* svstat = (const float*)(ws + WS_SVSTAT); const float* ln_g = KIN(const float, 8); const float* ln_b = KIN(const float, 9); const float* sb = KIN(const float, 11); const bf16* sguw = (const bf16*)(ws + WS_SGUW);
          for (int u = bx; u < 2048; u += G) sgu::sgu_unit(lds, Zb, svstat, ln_g, ln_b, sguw, sb, SO, u, tid); }
    }
    SEAM(4);
    if (IN(5)) {
        { KP_REFRESH(); unsigned char* ws = KWS();
          pg8::Gemm g{(const bf16*)(ws + WS_B + (size_t)M * 2048 * 2), (const bf16*)(ws + WS_WPS), M, DM, 2048}; pg8::StaticOrder S; S.init(M, DM, G, bx); pg8::EpiMergeA E{(bf16*)(ws + WS_A), (const bf16*)(ws + WS_Z)};
          pg8::gemm_phase<pg8::EpiMergeA, pg8::StaticOrder, true, true>(lds, g, S, E); }
        { KP_REFRESH(); unsigned char* ws = KWS();
          pg8::Gemm g{(const bf16*)(ws + WS_B), (const bf16*)(ws + WS_WPA), M, DM, 2048}; pg8::StaticOrder S; S.init(M, DM, G, bx); pg8::EpiMergeB E{(bf16*)(ws + WS_A), (const bf16*)(ws + WS_Z)};
          pg8::gemm_phase<pg8::EpiMergeB, pg8::StaticOrder, true, true>(lds, g, S, E); }
    }
    SEAM(5);
    if (IN(6)) { KP_REFRESH(); unsigned char* ws = KWS();
        pg8::Gemm g{(const bf16*)(ws + WS_A), (const bf16*)(ws + WS_WOUT), M, DM, DM}; pg8::StaticOrder S; S.init(M, DM, G, bx); pg8::EpiStats E{(bf16*)(ws + WS_B), (float*)(ws + WS_SSQ)};
        pg8::gemm_phase<pg8::EpiStats, pg8::StaticOrder, true, true>(lds, g, S, E);
    }
    SEAM(6);
    if (IN(7)) { KP_REFRESH(); unsigned char* ws = KWS();
        p7_mid_rows(KIN(const float, 0), (const bf16*)(ws + WS_B), (const float*)(ws + WS_SSQ), (const float*)(ws + WS_MOD), KOUT(), (bf16*)(ws + WS_A), gw, NGW, lane); }
    SEAM(7);
    if (IN(8)) { KP_REFRESH(); unsigned char* ws = KWS();
        pg8::Gemm g{(const bf16*)(ws + WS_A), (const bf16*)(ws + WS_WGU), M, NGU, DM}; pg8::StaticOrder S; S.init(M, NGU, G, bx); pg8::EpiSwiGLU E{(bf16*)(ws + WS_Z)};
        pg8::gemm_phase<pg8::EpiSwiGLU, pg8::StaticOrder, true, true>(lds, g, S, E);
    }
    SEAM(8);
    if (IN(9)) { KP_REFRESH(); unsigned char* ws = KWS();
        pg8::Gemm g{(const bf16*)(ws + WS_Z), (const bf16*)(ws + WS_WDN), M, DM, FF}; pg8::StaticOrder S; S.init(M, DM, G, bx); pg8::EpiStats E{(bf16*)(ws + WS_B), (float*)(ws + WS_SSQ)};
        pg8::gemm_phase<pg8::EpiStats, pg8::StaticOrder, true, true>(lds, g, S, E);
    }
    SEAM(9);
    if (IN(10)) { KP_REFRESH(); unsigned char* ws = KWS();
        p10_final_rows((const bf16*)(ws + WS_B), (const float*)(ws + WS_SSQ), (const float*)(ws + WS_MOD), KOUT(), gw, NGW, lane); }
#undef IN
#undef SEAM
}

extern "C" void kernel_launch(void* const* d_in, const int* in_sizes, int n_in, void* d_out, int out_size, void* d_ws, size_t ws_size, hipStream_t stream) {
    static int grid = 0;
    if (grid == 0) {
        if (n_in != 21 || in_sizes[0] != M * DM || out_size != M * DM || ws_size < WS_END) {
            fprintf(stderr, "kernel_launch: built for 21 inputs, x/out of %d floats, >= %zu bytes of workspace; got n_in %d, in0 %d, out %d, ws %zu; nothing launched\n", M * DM, (size_t)WS_END, n_in, n_in > 0 ? in_sizes[0] : -1, out_size, ws_size);
            grid = -1; return; }
        int dev = 0, cus = 0, per_cu = 0;
        if (hipGetDevice(&dev) != hipSuccess || hipDeviceGetAttribute(&cus, hipDeviceAttributeMultiprocessorCount, dev) != hipSuccess) { fprintf(stderr, "kernel_launch: device query failed\n"); grid = -1; return; }
        if (hipFuncSetAttribute((const void*)fwd, hipFuncAttributeMaxDynamicSharedMemorySize, LDS_BYTES) != hipSuccess) { fprintf(stderr, "kernel_launch: hipFuncSetAttribute failed\n"); grid = -1; return; }
        if (hipOccupancyMaxActiveBlocksPerMultiprocessor(&per_cu, (const void*)fwd, NWAVES * 64, LDS_BYTES) != hipSuccess || per_cu < 1)
            fprintf(stderr, "kernel_launch: note: occupancy query reports %d workgroups per CU\n", per_cu);
        (void)hipGetLastError();
        grid = cus;
    }
    if (grid < 0) return;
    if (hipMemsetAsync((char*)d_ws + WS_CTL, 0, CTL_ZERO_BYTES, stream) != hipSuccess) { fprintf(stderr, "kernel_launch: hipMemsetAsync failed\n"); return; }
    Args a{};
    for (int i = 0; i < 21; ++i) a.in[i] = d_in[i];
    a.out = (float*)d_out; a.ws = (unsigned char*)d_ws;
    if (N_LAUNCHES == 1) {
        a.ph_lo = 0; a.ph_hi = N_PHASES;
        hipLaunchKernelGGL(fwd, dim3(grid), dim3(NWAVES * 64), LDS_BYTES, stream, a);
    } else {
        for (int li = 0; li < N_PHASES; ++li) { a.ph_lo = li; a.ph_hi = li + 1; hipLaunchKernelGGL(fwd, dim3(grid), dim3(NWAVES * 64), LDS_BYTES, stream, a); }
    }
    const hipError_t le = hipPeekAtLastError();
    if (le != hipSuccess) fprintf(stderr, "kernel_launch: launch failed: %s (grid %d)\n", hipGetErrorName(le), grid);
}
```

```cpp
#include <hip/hip_runtime.h>
#include <cstdio>
#include <cstdint>
namespace pg8 {
#define PG8_LAS __attribute__((address_space(3)))
typedef unsigned short bf16_t;
typedef short bf16x8 __attribute__((ext_vector_type(8)));
typedef float f32x4 __attribute__((ext_vector_type(4)));
typedef unsigned u32x4 __attribute__((ext_vector_type(4)));
constexpr int BM = 256, BK = 64, HALF = 128, HTB = HALF * BK * 2  , STAGE_BYTES = 8 * HTB, NXCD = 8, WGM = 8;

__host__ __device__ __forceinline__ int lds_byte(int r, int c) { const int st = (r >> 4) * 2 + (c >> 5), rr = r & 15, cc = c & 31, ob = rr * 64 + cc * 2; return st * 1024 + (ob ^ (((ob >> 9) & 1) << 5)); }
__host__ __device__ __forceinline__ void stage_rc(int b, int& R, int& C) { const int st = b / 1024, sb = b % 1024, swz = sb ^ (((sb >> 9) & 1) << 5); R = (st >> 1) * 16 + swz / 64; C = (st & 1) * 32 + (swz % 64) / 2; }
__host__ __device__ __forceinline__ int perm32(int rho) { const int n = rho >> 4, i = rho & 15; return 8 * (i >> 2) + 4 * n + (i & 3); }

struct Unit { int pm, pn; };
struct Gemm { const bf16_t* A; const bf16_t* Bt; int M, N, K; };

struct StaticOrder {
    int nM, nN, nwg, G, c;
    __host__ __device__ void init(int M, int N, int G_, int c_) { nM = M / BM; nN = N / BM; nwg = nM * nN; G = G_; c = c_; }
    __host__ __device__ bool next(int i, Unit& u) const {
        const long L = (long)i * G + c; if (L >= nwg) return false;
        int wgid = (int)L; { const int q = nwg / NXCD, r = nwg % NXCD, xcd = wgid % NXCD, off = wgid / NXCD; wgid = (xcd < r ? xcd * (q + 1) : r * (q + 1) + (xcd - r) * q) + off; }
        const int nig = WGM * nN, gid = wgid / nig, fm = gid * WGM, gsz = (nM - fm) < WGM ? (nM - fm) : WGM;
        u.pm = fm + ((wgid % nig) % gsz); u.pn = (wgid % nig) / gsz; return true;
    }
    __device__ __forceinline__ void a_ready(const Unit&) const {}
    __device__ __forceinline__ void done(const Unit&) const {}
};

__device__ __forceinline__ unsigned cvt_pk_bf16(float lo, float hi) { unsigned r; asm volatile("v_cvt_pk_bf16_f32 %0, %1, %2" : "=v"(r) : "v"(lo), "v"(hi)); return r; }
typedef float f32x2 __attribute__((ext_vector_type(2)));
__device__ __forceinline__ f32x2 gelu_pk(f32x2 v) {
    const f32x2 av = __builtin_elementwise_abs(v), d = av * 0.2316418882f + 1.0f;
    f32x2 t; t.x = __builtin_amdgcn_rcpf(d.x); t.y = __builtin_amdgcn_rcpf(d.y);
    f32x2 q = t * 0.5307027145f + (-0.7265760135f); q = q * t + 0.7107068705f; q = q * t + (-0.142248368f); q = q * t + 0.127414796f; q = q * t;
    const f32x2 s = (v * v) * (-0.72134752044f);
    f32x2 e; e.x = __builtin_amdgcn_exp2f(s.x); e.y = __builtin_amdgcn_exp2f(s.y);
    const f32x2 m = v * (q * e), r = v - m;
    f32x2 o; o.x = v.x < 0.f ? m.x : r.x; o.y = v.y < 0.f ? m.y : r.y; return o;
}

typedef float f32x2t __attribute__((ext_vector_type(2)));
typedef __bf16 bf16x2t __attribute__((ext_vector_type(2)));
__device__ __forceinline__ unsigned pk_bf16(float lo, float hi) { f32x2t v = {lo, hi}; bf16x2t b = __builtin_convertvector(v, bf16x2t); return __builtin_bit_cast(unsigned, b); }
__device__ __forceinline__ float bf_lo(unsigned w) { return __builtin_bit_cast(float, w << 16); }
__device__ __forceinline__ float bf_hi(unsigned w) { return __builtin_bit_cast(float, w & 0xffff0000u); }
__device__ __forceinline__ float sigmoid_f(float x) { return __builtin_amdgcn_rcpf(1.0f + __builtin_amdgcn_exp2f(-1.4426950408889634f * x)); }
__device__ __forceinline__ u32x4 pack8(const f32x4& a, const f32x4& b) { u32x4 w; w.x = pk_bf16(a[0], a[1]); w.y = pk_bf16(a[2], a[3]); w.z = pk_bf16(b[0], b[1]); w.w = pk_bf16(b[2], b[3]); return w; }
__device__ __forceinline__ void unpack8(const u32x4& w, f32x4& a, f32x4& b) { a = (f32x4){bf_lo(w.x), bf_hi(w.x), bf_lo(w.y), bf_hi(w.y)}; b = (f32x4){bf_lo(w.z), bf_hi(w.z), bf_lo(w.w), bf_hi(w.w)}; }

constexpr int Z_LD = 15360, ZO_Q = 0, ZO_K = 2048, ZO_V = 2560, ZO_SU = 3072, ZO_SV = 5120, ZO_GA = 7168, ZO_GB = 11264;

struct EpiZ {
    static constexpr bool PERM = true, AFTER_DRAIN = false;
    bf16_t* Z; const float* ropeC; const float* ropeS; float* svstat;
    __device__ __forceinline__ void operator()(const f32x4 (&acc)[2][2][4][2], const Unit& u, int wr, int wc, int fr, int fq) const {
        const int pn = u.pn;
        const int mode = pn < 10 ? 0 : (pn < 12 ? 1 : (pn < 20 ? 2 : (pn < 28 ? 3 : 4)));
        const int row0 = u.pm * BM + wr * 64 + fr, col0 = pn * BM + wc * 32 + 8 * fq;
        const bool rot = (mode == 0) && (wc == 0);
        const float sgn = fq < 2 ? -1.0f : 1.0f;
#pragma unroll
        for (int ai = 0; ai < 2; ++ai)
#pragma unroll
            for (int m = 0; m < 4; ++m) {
                const int row = row0 + ai * HALF + m * 16;
                bf16_t* rowp = Z + (size_t)row * Z_LD + col0;
                f32x4 c0 = {1.f, 1.f, 1.f, 1.f}, c1 = c0, s0 = {0.f, 0.f, 0.f, 0.f}, s1 = s0;
                if (rot) { const float* cp = ropeC + (size_t)row * 16 + 8 * (fq & 1); const float* sp = ropeS + (size_t)row * 16 + 8 * (fq & 1);
                    c0 = *(const f32x4*)cp; c1 = *(const f32x4*)(cp + 4); s0 = *(const f32x4*)sp; s1 = *(const f32x4*)(sp + 4); }
                float t1 = 0.f, t2 = 0.f;
#pragma unroll
                for (int bj = 0; bj < 2; ++bj) {
                    f32x4 v0 = acc[ai][bj][m][0], v1 = acc[ai][bj][m][1];
                    if (rot) {
                        f32x4 o0, o1;
#pragma unroll
                        for (int j = 0; j < 4; ++j) { o0[j] = __shfl_xor(v0[j], 32); o1[j] = __shfl_xor(v1[j], 32); }
                        v0 = v0 * c0 + (o0 * s0) * sgn; v1 = v1 * c1 + (o1 * s1) * sgn;
                    } else if (mode == 2 || mode == 3) {
                        f32x2 a = gelu_pk((f32x2){v0[0], v0[1]}), b = gelu_pk((f32x2){v0[2], v0[3]}), c = gelu_pk((f32x2){v1[0], v1[1]}), d = gelu_pk((f32x2){v1[2], v1[3]});
                        v0 = (f32x4){a.x, a.y, b.x, b.y}; v1 = (f32x4){c.x, c.y, d.x, d.y};
                        if (mode == 3) {
#pragma unroll
                            for (int j = 0; j < 4; ++j) { t1 += v0[j] + v1[j]; t2 += v0[j] * v0[j] + v1[j] * v1[j]; } }
                    } else if (mode == 4) {
#pragma unroll
                        for (int j = 0; j < 4; ++j) { v0[j] = sigmoid_f(v0[j]); v1[j] = sigmoid_f(v1[j]); }
                    }
                    *(u32x4*)(rowp + bj * HALF) = pack8(v0, v1);
                }
                if (mode == 3) {
                    t1 += __shfl_xor(t1, 16); t1 += __shfl_xor(t1, 32); t2 += __shfl_xor(t2, 16); t2 += __shfl_xor(t2, 32);
                    if (fq == 0) *(f32x2*)(svstat + ((size_t)row * 32 + (pn - 20) * 4 + wc) * 2) = (f32x2){t1, t2};
                }
            }
    }
};
struct EpiMergeA {
    static constexpr bool PERM = true, AFTER_DRAIN = false;
    bf16_t* T; const bf16_t* Z;
    __device__ __forceinline__ void operator()(const f32x4 (&acc)[2][2][4][2], const Unit& u, int wr, int wc, int fr, int fq) const {
        const int row0 = u.pm * BM + wr * 64 + fr, col0 = u.pn * BM + wc * 32 + 8 * fq;
#pragma unroll
        for (int ai = 0; ai < 2; ++ai)
#pragma unroll
            for (int m = 0; m < 4; ++m) { const int row = row0 + ai * HALF + m * 16;
#pragma unroll
                for (int bj = 0; bj < 2; ++bj) {
                    const u32x4 gw = *(const u32x4*)(Z + (size_t)row * Z_LD + ZO_GA + col0 + bj * HALF); f32x4 g0, g1; unpack8(gw, g0, g1);
                    *(u32x4*)(T + (size_t)row * 4096 + col0 + bj * HALF) = pack8(acc[ai][bj][m][0] * g0, acc[ai][bj][m][1] * g1); } }
    }
};
struct EpiMergeB {
    static constexpr bool PERM = true, AFTER_DRAIN = false;
    bf16_t* T; const bf16_t* Z;
    __device__ __forceinline__ void operator()(const f32x4 (&acc)[2][2][4][2], const Unit& u, int wr, int wc, int fr, int fq) const {
        const int row0 = u.pm * BM + wr * 64 + fr, col0 = u.pn * BM + wc * 32 + 8 * fq;
#pragma unroll
        for (int ai = 0; ai < 2; ++ai)
#pragma unroll
            for (int m = 0; m < 4; ++m) { const int row = row0 + ai * HALF + m * 16;
#pragma unroll
                for (int bj = 0; bj < 2; ++bj) {
                    const u32x4 gw = *(const u32x4*)(Z + (size_t)row * Z_LD + ZO_GB + col0 + bj * HALF); f32x4 g0, g1; unpack8(gw, g0, g1);
                    bf16_t* tp = T + (size_t)row * 4096 + col0 + bj * HALF;
                    const u32x4 tw = *(const u32x4*)tp; f32x4 t0, t1; unpack8(tw, t0, t1);
                    *(u32x4*)tp = pack8(t0 + acc[ai][bj][m][0] * g0, t1 + acc[ai][bj][m][1] * g1); } }
    }
};
struct EpiStats {
    static constexpr bool PERM = true, AFTER_DRAIN = false;
    bf16_t* Y; float* ssq;
    __device__ __forceinline__ void operator()(const f32x4 (&acc)[2][2][4][2], const Unit& u, int wr, int wc, int fr, int fq) const {
        const int row0 = u.pm * BM + wr * 64 + fr, col0 = u.pn * BM + wc * 32 + 8 * fq;
#pragma unroll
        for (int ai = 0; ai < 2; ++ai)
#pragma unroll
            for (int m = 0; m < 4; ++m) { const int row = row0 + ai * HALF + m * 16; float t2 = 0.f;
#pragma unroll
                for (int bj = 0; bj < 2; ++bj) { const f32x4 v0 = acc[ai][bj][m][0], v1 = acc[ai][bj][m][1];
#pragma unroll
                    for (int j = 0; j < 4; ++j) t2 += v0[j] * v0[j] + v1[j] * v1[j];
                    *(u32x4*)(Y + (size_t)row * 4096 + col0 + bj * HALF) = pack8(v0, v1); }
                t2 += __shfl_xor(t2, 16); t2 += __shfl_xor(t2, 32);
                if (fq == 0) ssq[(size_t)row * 64 + u.pn * 4 + wc] = t2; }
    }
};
struct EpiSwiGLU {
    static constexpr bool PERM = true, AFTER_DRAIN = false;
    bf16_t* H;
    __device__ __forceinline__ void operator()(const f32x4 (&acc)[2][2][4][2], const Unit& u, int wr, int wc, int fr, int fq) const {
        const int row0 = u.pm * BM + wr * 64 + fr, col0 = u.pn * HALF + wc * 32 + 8 * fq;
#pragma unroll
        for (int ai = 0; ai < 2; ++ai)
#pragma unroll
            for (int m = 0; m < 4; ++m) { const int row = row0 + ai * HALF + m * 16;
                f32x4 h0, h1;
#pragma unroll
                for (int j = 0; j < 4; ++j) { const float g0 = acc[ai][0][m][0][j], g1 = acc[ai][0][m][1][j];
                    h0[j] = g0 * sigmoid_f(g0) * acc[ai][1][m][0][j]; h1[j] = g1 * sigmoid_f(g1) * acc[ai][1][m][1][j]; }
                *(u32x4*)(H + (size_t)row * 11008 + col0) = pack8(h0, h1); }
    }
};
template <class Epi, class Sched, bool ALIGN_EPI = false, bool SP2 = false>
__device__ __forceinline__ void gemm_phase(PG8_LAS unsigned char* lds, const Gemm g, const Sched& S, const Epi& E) {
    const int tid = threadIdx.x, wid = __builtin_amdgcn_readfirstlane(tid >> 6), lane = tid & 63, wr = wid >> 2, wc = wid & 3, fr = lane & 15, fq = lane >> 4;
    const int K = g.K, nt = K / BK;
    unsigned voffA[2], voffB[2];
#pragma unroll
    for (int i = 0; i < 2; ++i) { int R, C; stage_rc(tid * 16 + i * 8192, R, C); const int Rb = Epi::PERM ? ((R & ~31) + perm32(R & 31)) : R;
        voffA[i] = (unsigned)(R * K + C) * 2u; voffB[i] = (unsigned)(Rb * K + C) * 2u; }
    const size_t kstep = (size_t)(BK * 2);
    const size_t hstep = (size_t)HALF * K * 2;
    const size_t tstep = 2 * hstep;
    const unsigned ldsw = (unsigned)wid * 1024u;
    const int aoff = lds_byte(wr * 64 + fr, fq * 8), boff = lds_byte(wc * 32 + fr, fq * 8);
#define PG8_SA(b, h) (((b) * 2 + (h)) * HTB)
#define PG8_SB(b, h) ((4 + (b) * 2 + (h)) * HTB)
#define PG8_STAGE(bufoff, gbase, voff) do { _Pragma("unroll") for (int _i = 0; _i < 2; ++_i) \
        __builtin_amdgcn_global_load_lds((const unsigned*)((const char*)(gbase) + (voff)[_i]), (PG8_LAS unsigned*)(lds + (bufoff) + ldsw + _i * 8192), 16, 0, 0); } while (0)
#define PG8_LDA(dst, b, h) do { _Pragma("unroll") for (int m = 0; m < 4; ++m) _Pragma("unroll") for (int k = 0; k < 2; ++k) dst[m][k] = *(const PG8_LAS bf16x8*)(lds + PG8_SA(b, h) + aoff + m * 2048 + k * 1024); } while (0)
#define PG8_LDB(dst, b, h) do { _Pragma("unroll") for (int n = 0; n < 2; ++n) _Pragma("unroll") for (int k = 0; k < 2; ++k) dst[n][k] = *(const PG8_LAS bf16x8*)(lds + PG8_SB(b, h) + boff + n * 2048 + k * 1024); } while (0)
#define PG8_MMA(ai, bj, At, Bt) do { __builtin_amdgcn_s_setprio(1); _Pragma("unroll") for (int m = 0; m < 4; ++m) _Pragma("unroll") for (int n = 0; n < 2; ++n) _Pragma("unroll") for (int k = 0; k < 2; ++k) \
        acc[ai][bj][m][n] = __builtin_amdgcn_mfma_f32_16x16x32_bf16(Bt[n][k], At[m][k], acc[ai][bj][m][n], 0, 0, 0); __builtin_amdgcn_s_setprio(0); } while (0)
#define PG8_WAIT_V(n) asm volatile("s_waitcnt vmcnt(" #n ")" ::: "memory")
#define PG8_WAIT_L(n) asm volatile("s_waitcnt lgkmcnt(" #n ")" ::: "memory")
#define PG8_BAR __builtin_amdgcn_s_barrier()
#define PG8_SCHED __builtin_amdgcn_sched_barrier(0)
    Unit cur, nxt; int ui = 0;
    if (!S.next(0, cur)) return;
    f32x4 acc[2][2][4][2];
#pragma unroll
    for (int a = 0; a < 2; ++a)
#pragma unroll
        for (int b = 0; b < 2; ++b)
#pragma unroll
            for (int m = 0; m < 4; ++m)
#pragma unroll
                for (int n = 0; n < 2; ++n) acc[a][b][m][n] = (f32x4){0.f, 0.f, 0.f, 0.f};
    bf16x8 At[4][2], B0[2][2], B1[2][2];
    const char* cA = (const char*)g.A + (size_t)cur.pm * tstep; const char* cB = (const char*)g.Bt + (size_t)cur.pn * tstep;
    S.a_ready(cur);
    if constexpr (SP2) {
        PG8_STAGE(PG8_SB(0, 0), cB, voffB); PG8_STAGE(PG8_SB(0, 1), cB + hstep, voffB); PG8_STAGE(PG8_SA(0, 0), cA, voffA); PG8_STAGE(PG8_SA(0, 1), cA + hstep, voffA);
        if (wr == 1) PG8_BAR;
        PG8_WAIT_V(2); PG8_BAR;
        PG8_STAGE(PG8_SB(1, 0), cB + kstep, voffB); PG8_STAGE(PG8_SA(1, 0), cA + kstep, voffA); PG8_STAGE(PG8_SB(1, 1), cB + hstep + kstep, voffB);
        PG8_WAIT_V(6); PG8_BAR;
    } else {
        PG8_STAGE(PG8_SB(0, 0), cB, voffB); PG8_STAGE(PG8_SA(0, 0), cA, voffA); PG8_STAGE(PG8_SB(0, 1), cB + hstep, voffB); PG8_STAGE(PG8_SA(0, 1), cA + hstep, voffA);
        if (wr == 1) PG8_BAR;
        PG8_WAIT_V(4); PG8_BAR;
        PG8_STAGE(PG8_SB(1, 0), cB + kstep, voffB); PG8_STAGE(PG8_SA(1, 0), cA + kstep, voffA); PG8_STAGE(PG8_SB(1, 1), cB + hstep + kstep, voffB);
        PG8_WAIT_V(6); PG8_BAR;
    }
    for (;;) {
        const bool has_next = S.next(ui + 1, nxt);
        const char* nA = has_next ? (const char*)g.A + (size_t)nxt.pm * tstep : cA; const char* nB = has_next ? (const char*)g.Bt + (size_t)nxt.pn * tstep : cB;
        for (int t = 0; t < nt; t += 2) {
            const bool last = (t == nt - 2);
            const char* a1 = cA + (size_t)(t + 1) * kstep;
            const char* a2 = last ? nA : cA + (size_t)(t + 2) * kstep; const char* b2 = last ? nB : cB + (size_t)(t + 2) * kstep;
            const char* a3 = a2 + kstep; const char* b3 = b2 + kstep;
            if (last && has_next) S.a_ready(nxt);
            if constexpr (SP2) {
            PG8_LDB(B0, 0, 0); PG8_LDB(B1, 0, 1); PG8_SCHED; PG8_LDA(At, 0, 0); PG8_STAGE(PG8_SA(1, 1), a1 + hstep, voffA);
            PG8_WAIT_V(8); PG8_WAIT_L(0); PG8_BAR; PG8_MMA(0, 0, At, B0); PG8_MMA(0, 1, At, B1); PG8_BAR; PG8_SCHED;
            PG8_LDA(At, 0, 1); PG8_STAGE(PG8_SB(0, 0), b2, voffB); PG8_STAGE(PG8_SB(0, 1), b2 + hstep, voffB); PG8_STAGE(PG8_SA(0, 0), a2, voffA);
            PG8_WAIT_V(8); PG8_WAIT_L(0); PG8_BAR; PG8_MMA(1, 0, At, B0); PG8_MMA(1, 1, At, B1); PG8_BAR; PG8_SCHED;
            PG8_LDB(B0, 1, 0); PG8_LDB(B1, 1, 1); PG8_SCHED; PG8_LDA(At, 1, 0); PG8_STAGE(PG8_SA(0, 1), a2 + hstep, voffA);
            PG8_WAIT_V(8); PG8_WAIT_L(0); PG8_BAR; PG8_MMA(0, 0, At, B0); PG8_MMA(0, 1, At, B1); PG8_BAR; PG8_SCHED;
            PG8_LDA(At, 1, 1); PG8_STAGE(PG8_SB(1, 0), b3, voffB); PG8_STAGE(PG8_SB(1, 1), b3 + hstep, voffB); PG8_STAGE(PG8_SA(1, 0), a3, voffA);
            PG8_WAIT_V(8); PG8_WAIT_L(0); PG8_BAR; PG8_MMA(1, 0, At, B0); PG8_MMA(1, 1, At, B1); PG8_BAR; PG8_SCHED;
            } else {
            PG8_LDB(B0, 0, 0); PG8_SCHED; PG8_LDA(At, 0, 0); PG8_STAGE(PG8_SA(1, 1), a1 + hstep, voffA);
            PG8_WAIT_L(8); PG8_BAR; PG8_WAIT_L(0); PG8_MMA(0, 0, At, B0); PG8_BAR; PG8_SCHED;
            PG8_LDB(B1, 0, 1); PG8_STAGE(PG8_SB(0, 0), b2, voffB);
            PG8_BAR; PG8_WAIT_L(0); PG8_MMA(0, 1, At, B1); PG8_BAR;
            PG8_LDA(At, 0, 1); PG8_STAGE(PG8_SA(0, 0), a2, voffA);
            PG8_BAR; PG8_WAIT_L(0); PG8_MMA(1, 0, At, B0); PG8_BAR; PG8_SCHED;
            PG8_STAGE(PG8_SB(0, 1), b2 + hstep, voffB);
            PG8_WAIT_V(6); PG8_BAR; PG8_MMA(1, 1, At, B1); PG8_BAR;
            PG8_LDB(B0, 1, 0); PG8_SCHED; PG8_LDA(At, 1, 0); PG8_STAGE(PG8_SA(0, 1), a2 + hstep, voffA);
            PG8_WAIT_L(8); PG8_BAR; PG8_WAIT_L(0); PG8_MMA(0, 0, At, B0); PG8_BAR; PG8_SCHED;
            PG8_LDB(B1, 1, 1); PG8_STAGE(PG8_SB(1, 0), b3, voffB);
            PG8_BAR; PG8_WAIT_L(0); PG8_MMA(0, 1, At, B1); PG8_BAR;
            PG8_LDA(At, 1, 1); PG8_STAGE(PG8_SA(1, 0), a3, voffA);
            PG8_BAR; PG8_WAIT_L(0); PG8_MMA(1, 0, At, B0); PG8_BAR; PG8_SCHED;
            PG8_STAGE(PG8_SB(1, 1), b3 + hstep, voffB);
            PG8_WAIT_V(6); PG8_BAR; PG8_MMA(1, 1, At, B1); PG8_BAR;
            }
        }
        if constexpr (ALIGN_EPI) { if (wr == 0) PG8_BAR; }
        if constexpr (!Epi::AFTER_DRAIN) { E(acc, cur, wr, wc, fr, fq); S.done(cur); }
        if (!has_next) break;
#pragma unroll
        for (int a = 0; a < 2; ++a)
#pragma unroll
            for (int b = 0; b < 2; ++b)
#pragma unroll
                for (int m = 0; m < 4; ++m)
#pragma unroll
                    for (int n = 0; n < 2; ++n) acc[a][b][m][n] = (f32x4){0.f, 0.f, 0.f, 0.f};
        cur = nxt; cA = nA; cB = nB; ++ui;
        if constexpr (ALIGN_EPI) { if (wr == 1) PG8_BAR; }
    }
    PG8_WAIT_V(0);
    if constexpr (!ALIGN_EPI) { if (wr == 0) PG8_BAR; }
    PG8_BAR;
    if constexpr (Epi::AFTER_DRAIN) { E.fused(acc, cur, wr, wc, fr, fq, lds, wid, lane); S.done(cur); }
#undef PG8_SA
#undef PG8_SB
#undef PG8_STAGE
#undef PG8_LDA
#undef PG8_LDB
#undef PG8_MMA
#undef PG8_WAIT_V
#undef PG8_WAIT_L
#undef PG8_BAR
#undef PG8_SCHED
}
}

constexpr int NWAVES = 8;
constexpr int NB = 4, SEQ = 4096, DM = 4096, M = NB * SEQ;
constexpr int INW = 15360, FF = 11008, NGU = 2 * FF, NMOD = 6 * DM;
constexpr float RMS_EPS = 1e-6f, LN_EPS = 1e-5f;

constexpr size_t MiB = 1u << 20;
constexpr size_t WS_CTL = 0, CTL_ZERO_BYTES = 1 * MiB;
constexpr size_t WS_MODP = 1 * MiB;
constexpr size_t WS_MOD = 25 * MiB;
constexpr size_t WS_ROPEC = 26 * MiB, WS_ROPES = 27 * MiB;
constexpr size_t WS_SGUW = 28 * MiB;
constexpr size_t WS_SVSTAT = 29 * MiB;
constexpr size_t WS_SSQ = 33 * MiB;
constexpr size_t WS_WIN = 64 * MiB, WS_WPS = 184 * MiB, WS_WPA = 200 * MiB, WS_WOUT = 216 * MiB, WS_WGU = 248 * MiB, WS_WDN = 420 * MiB;
constexpr size_t WS_Z = 512 * MiB;
constexpr size_t WS_A = 992 * MiB;
constexpr size_t WS_B = 1120 * MiB;
constexpr size_t WS_END = 1248 * MiB;
static_assert(WS_WIN + (size_t)INW * DM * 2 <= WS_WPS && WS_WPS + (size_t)DM * 2048 * 2 <= WS_WPA && WS_WPA + (size_t)DM * 2048 * 2 <= WS_WOUT && WS_WOUT + (size_t)DM * DM * 2 <= WS_WGU &&
              WS_WGU + (size_t)NGU * DM * 2 <= WS_WDN && WS_WDN + (size_t)DM * FF * 2 <= WS_Z && WS_Z + (size_t)M * INW * 2 <= WS_A && WS_A + (size_t)M * DM * 2 <= WS_B && WS_B + (size_t)M * DM * 2 <= WS_END, "d_ws map");
static_assert(WS_MODP + (size_t)64 * 4 * NMOD * 4 <= WS_MOD && WS_SVSTAT + (size_t)M * 64 * 4 <= WS_SSQ && WS_SSQ + (size_t)M * 64 * 4 <= WS_WIN, "d_ws map (small)");
constexpr int CW_BAR = 4096;

constexpr int LDS_BYTES = 147456;
constexpr int LDSCTL_OFF = LDS_BYTES - 256;

#define GAS __attribute__((address_space(1)))
#define LAS __attribute__((address_space(3)))
typedef unsigned short bf16;
typedef unsigned v4u __attribute__((ext_vector_type(4)));
typedef unsigned v2u __attribute__((ext_vector_type(2)));
typedef float f32x4 __attribute__((ext_vector_type(4)));
typedef float f32x2 __attribute__((ext_vector_type(2)));
typedef float f32x16 __attribute__((ext_vector_type(16)));
typedef short bf16x8 __attribute__((ext_vector_type(8)));
typedef short s16x4 __attribute__((ext_vector_type(4)));
typedef GAS unsigned gu32;
#define RLX_AGENT __ATOMIC_RELAXED, __HIP_MEMORY_SCOPE_AGENT
#define LDS_WAIT() asm volatile("s_waitcnt lgkmcnt(0)" ::: "memory")
using pg8::pk_bf16; using pg8::bf_lo; using pg8::bf_hi;

__device__ __forceinline__ float wave_sum(float v) {
#pragma unroll
    for (int o = 1; o < 64; o <<= 1) v += __shfl_xor(v, o);
    return v;
}
#define XB_TMO      128
#define XB_XCNT(j)  (256  + 64 * (j))
#define XB_XSUB(j)  (1280 + 64 * (j))
#define XB_XGEN(j)  (2304 + 64 * (j))
#define XB_TOP      3328
#define XB_TOPGEN   3392
#define XCD_BAR_WORDS 3456
#define XB_SPIN_CAP (1u << 18)

__device__ __forceinline__ unsigned xb_ld(unsigned* p)              { return __hip_atomic_load(p, __ATOMIC_RELAXED, __HIP_MEMORY_SCOPE_AGENT); }
__device__ __forceinline__ unsigned xb_add(unsigned* p, unsigned v) { return __hip_atomic_fetch_add(p, v, __ATOMIC_RELAXED, __HIP_MEMORY_SCOPE_AGENT); }
__device__ __forceinline__ unsigned xb_xcc_id() { return (unsigned)__builtin_amdgcn_s_getreg((3 << 11) | 20) & 0xFu; }
#define XB_SPIN(cond, bar) do { unsigned _sp = 0; while (cond) { __builtin_amdgcn_s_sleep(1); \
    if ((++_sp & 255u) == 0u) { if (xb_ld(&(bar)[XB_TMO])) break; if (_sp > XB_SPIN_CAP) { atomicAdd(&(bar)[XB_TMO], 1u); break; } } } } while (0)

struct XcdBarrier {
    unsigned* bar; unsigned x;
    volatile LAS unsigned* st;
};

__device__ __forceinline__ XcdBarrier xcd_barrier_post(unsigned* bar, volatile LAS unsigned* st) {
    XcdBarrier b; b.bar = bar; b.x = xb_xcc_id(); b.st = st;
    if (threadIdx.x == 0) (void)xb_add(&bar[XB_XCNT(b.x)], 1u);
    return b;
}
__device__ __forceinline__ void xcd_barrier_complete(unsigned* bar, unsigned x, unsigned& nloc, unsigned& nx) {
    const unsigned G = gridDim.x * gridDim.y * gridDim.z;
    unsigned sum, cnt, mine, sp = 0u;
    for (;;) {
        sum = 0u; cnt = 0u; mine = 0u;
#pragma unroll
        for (unsigned j = 0; j < 16; ++j) { const unsigned c = xb_ld(&bar[XB_XCNT(j)]); sum += c; cnt += (c > 0u) ? 1u : 0u; mine = (j == x) ? c : mine; }
        if (sum == G) break;
        __builtin_amdgcn_s_sleep(1);
        if ((++sp & 255u) == 0u) { if (xb_ld(&bar[XB_TMO])) break; if (sp > XB_SPIN_CAP) { atomicAdd(&bar[XB_TMO], 1u); break; } }
    }
    nloc = mine > 0u ? mine : 1u; nx = cnt > 0u ? cnt : 1u;
}

__device__ __forceinline__ void xcd_barrier(const XcdBarrier& b) {
    asm volatile("s_waitcnt vmcnt(0)" ::: "memory");
    __syncthreads();
    if (threadIdx.x == 0) {
        unsigned* bar = b.bar;
        __builtin_amdgcn_s_waitcnt(0);
        unsigned nloc = b.st[0], nx = b.st[1];
        if (nloc == 0u) { xcd_barrier_complete(bar, b.x, nloc, nx); b.st[0] = nloc; b.st[1] = nx; }
        const unsigned old = xb_add(&bar[XB_XSUB(b.x)], 1u);
        const unsigned gen = old / nloc;
        if (old + 1u == (gen + 1u) * nloc) {
            __builtin_amdgcn_fence(__ATOMIC_RELEASE, "agent");
            asm volatile("s_waitcnt vmcnt(0)" ::: "memory");
            const unsigned og = xb_add(&bar[XB_TOP], 1u);
            const unsigned tg = og / nx;
            if (og + 1u == (tg + 1u) * nx) xb_add(&bar[XB_TOPGEN], 1u);
            else XB_SPIN(xb_ld(&bar[XB_TOPGEN]) == tg, bar);
            __builtin_amdgcn_fence(__ATOMIC_ACQUIRE, "agent");
            xb_add(&bar[XB_XGEN(b.x)], 1u);
            asm volatile("s_waitcnt vmcnt(0)" ::: "memory");
        } else {
            XB_SPIN(xb_ld(&bar[XB_XGEN(b.x)]) == gen, bar);
            __builtin_amdgcn_fence(__ATOMIC_ACQUIRE, "agent");
            asm volatile("s_waitcnt vmcnt(0)" ::: "memory");
        }
    }
    __syncthreads();
}

__device__ const float ROPE_INVF[16] = {1.0f, 0.44036659598350525f, 0.1939227432012558f, 0.08539710193872452f, 0.03760603070259094f, 0.016560440883040428f, 0.007292664609849453f, 0.0032114461064338684f,
                                        0.0014142135623842478f, 0.0006227724370546639f, 0.00027424818836152554f, 0.00012076973507646471f, 5.3182957344688475e-05f, 2.34199997066753e-05f, 1.0313385246263351e-05f, 4.541670477919979e-06f};

__device__ __forceinline__ void p0_transpose_item(const float* __restrict__ W, int K, int N, bf16* __restrict__ WT, int k0, int n0, int dst_row0, LAS float* scr, int lane) {
    const int sub = lane >> 4, c4 = lane & 15;
    f32x4 v[16];
#pragma unroll
    for (int i = 0; i < 16; ++i) v[i] = *(const f32x4*)(W + (size_t)(k0 + 4 * i + sub) * N + n0 + 4 * c4);
#pragma unroll
    for (int i = 0; i < 16; ++i) { LAS float* p = scr + (4 * i + sub) * 65 + 4 * c4; p[0] = v[i][0]; p[1] = v[i][1]; p[2] = v[i][2]; p[3] = v[i][3]; }
    LDS_WAIT();
    const int c8 = lane & 7;
#pragma unroll
    for (int it = 0; it < 8; ++it) { const int nn = (lane >> 3) + 8 * it; const LAS float* s = scr + (8 * c8) * 65 + nn;
        v4u o; o.x = pk_bf16(s[0 * 65], s[1 * 65]); o.y = pk_bf16(s[2 * 65], s[3 * 65]); o.z = pk_bf16(s[4 * 65], s[5 * 65]); o.w = pk_bf16(s[6 * 65], s[7 * 65]);
        *(v4u*)(WT + (size_t)(dst_row0 + nn) * K + k0 + 8 * c8) = o; }
    LDS_WAIT();
}
__device__ __forceinline__ void p0_gemv_item(const float* __restrict__ c, const float* __restrict__ w_ada, float* __restrict__ part, int cg, int kc, LAS float* scr, int lane) {
    const int k0 = kc * 64;
#pragma unroll
    for (int b = 0; b < 4; ++b) { const float cv = c[b * DM + k0 + lane]; scr[b * 64 + lane] = cv / (1.0f + __expf(-cv)); }
    LDS_WAIT();
    f32x4 a0 = {0.f, 0.f, 0.f, 0.f}, a1 = a0, a2 = a0, a3 = a0;
    const float* wp = w_ada + (size_t)k0 * NMOD + cg * 256 + 4 * lane;
#pragma unroll 8
    for (int kk = 0; kk < 64; ++kk) { const f32x4 w = *(const f32x4*)(wp + (size_t)kk * NMOD);
        a0 += w * scr[kk]; a1 += w * scr[64 + kk]; a2 += w * scr[128 + kk]; a3 += w * scr[192 + kk]; }
    float* pp = part + (size_t)(kc * 4) * NMOD + cg * 256 + 4 * lane;
    *(f32x4*)(pp) = a0; *(f32x4*)(pp + NMOD) = a1; *(f32x4*)(pp + 2 * NMOD) = a2; *(f32x4*)(pp + 3 * NMOD) = a3;
    LDS_WAIT();
}
struct P0Args { const float *c, *w_ada, *w_in, *sgu_w, *w_ps, *w_pa, *w_out, *w_gate, *w_up, *w_down; const int* positions;
                float *modp, *ropeC, *ropeS; bf16 *sguw, *win_t, *wps_t, *wpa_t, *wout_t, *wgu_t, *wdn_t; };
__device__ __forceinline__ void p0_prologue(const P0Args& A, LAS unsigned char* lds, int gw, int NGW, int wave, int lane) {
    LAS float* scr = (LAS float*)(lds + wave * 16640);
    constexpr int I_GEMV = 96 * 64;
    constexpr int I_IN = (DM / 64) * (INW / 64), I_PS = (2048 / 64) * (DM / 64), I_OUT = (DM / 64) * (DM / 64), I_G = (DM / 64) * (FF / 64), I_DN = (FF / 64) * (DM / 64);
    constexpr int I_ROPE = M / 64, I_SW = 64;
    constexpr int NITEMS = I_GEMV + I_IN + 2 * I_PS + I_OUT + 2 * I_G + I_DN + I_ROPE + I_SW;
    for (int it = gw; it < NITEMS; it += NGW) {
        int r = it;
        if (r < I_GEMV) { p0_gemv_item(A.c, A.w_ada, A.modp, r % 96, r / 96, scr, lane); continue; } r -= I_GEMV;
        if (r < I_IN) { const int nnb = INW / 64, kb = r / nnb, nb = r % nnb; p0_transpose_item(A.w_in, DM, INW, A.win_t, 64 * kb, 64 * nb, 64 * nb, scr, lane); continue; } r -= I_IN;
        if (r < I_PS) { const int nnb = DM / 64, kb = r / nnb, nb = r % nnb; p0_transpose_item(A.w_ps, 2048, DM, A.wps_t, 64 * kb, 64 * nb, 64 * nb, scr, lane); continue; } r -= I_PS;
        if (r < I_PS) { const int nnb = DM / 64, kb = r / nnb, nb = r % nnb; p0_transpose_item(A.w_pa, 2048, DM, A.wpa_t, 64 * kb, 64 * nb, 64 * nb, scr, lane); continue; } r -= I_PS;
        if (r < I_OUT) { const int nnb = DM / 64, kb = r / nnb, nb = r % nnb; p0_transpose_item(A.w_out, DM, DM, A.wout_t, 64 * kb, 64 * nb, 64 * nb, scr, lane); continue; } r -= I_OUT;
        if (r < I_G) { const int nnb = FF / 64, kb = r / nnb, nb = r % nnb, n0 = 64 * nb;
            p0_transpose_item(A.w_gate, DM, FF, A.wgu_t, 64 * kb, n0, 256 * (n0 >> 7) + (n0 & 127), scr, lane); continue; } r -= I_G;
        if (r < I_G) { const int nnb = FF / 64, kb = r / nnb, nb = r % nnb, n0 = 64 * nb;
            p0_transpose_item(A.w_up, DM, FF, A.wgu_t, 64 * kb, n0, 256 * (n0 >> 7) + 128 + (n0 & 127), scr, lane); continue; } r -= I_G;
        if (r < I_DN) { const int nnb = DM / 64, kb = r / nnb, nb = r % nnb; p0_transpose_item(A.w_down, FF, DM, A.wdn_t, 64 * kb, 64 * nb, 64 * nb, scr, lane); continue; } r -= I_DN;
        if (r < I_ROPE) {
#pragma unroll 4
            for (int e = 0; e < 16; ++e) { const int idx = r * 1024 + e * 64 + lane, mrow = idx >> 4, i = idx & 15;
                const float ang = (float)A.positions[mrow] * ROPE_INVF[i];
                const double rev = (double)ang * 0.15915494309189535; const float fr = (float)(rev - __builtin_rint(rev));
                A.ropeC[idx] = __builtin_amdgcn_cosf(fr); A.ropeS[idx] = __builtin_amdgcn_sinf(fr); }
            continue; } r -= I_ROPE;
        {
#pragma unroll 4
            for (int e = 0; e < 64; ++e) { const int idx = r * 4096 + e * 64 + lane, t = (idx >> 7) & 127, s = idx & 127;
                const float w = (s <= t) ? A.sgu_w[idx] : 0.0f; A.sguw[idx] = (bf16)(pk_bf16(w, 0.f) & 0xffffu); }
        }
    }
}
__device__ __forceinline__ void p1_mod_reduce(const float* __restrict__ modp, const float* __restrict__ b_ada, const float* g_pre_mix, const float* g_post_mix, const float* g_pre_ffn, const float* g_post_ffn,
                                              float* __restrict__ mod, int gtid, int gthreads) {
    for (int idx = gtid; idx < 4 * (NMOD / 4); idx += gthreads) {
        const int b = idx / (NMOD / 4), j = 4 * (idx % (NMOD / 4));
        f32x4 s = *(const f32x4*)(b_ada + j);
#pragma unroll 8
        for (int kc = 0; kc < 64; ++kc) s += *(const f32x4*)(modp + (size_t)(kc * 4 + b) * NMOD + j);
        const int chunk = j >> 12, e = j & 4095;
        if (chunk == 1) s = *(const f32x4*)(g_pre_mix + e) * (s + 1.0f);
        else if (chunk == 2) s = s * *(const f32x4*)(g_post_mix + e);
        else if (chunk == 4) s = *(const f32x4*)(g_pre_ffn + e) * (s + 1.0f);
        else if (chunk == 5) s = s * *(const f32x4*)(g_post_ffn + e);
        *(f32x4*)(mod + (size_t)b * NMOD + j) = s;
    }
}
__device__ __forceinline__ void p2_norm_rows(const float* __restrict__ x, const float* __restrict__ mod, bf16* __restrict__ h, int gw, int NGW, int lane) {
    for (int m = gw; m < M; m += NGW) {
        const f32x4* xr = (const f32x4*)(x + (size_t)m * DM) + lane;
        f32x4 v[16]; float ss = 0.f;
#pragma unroll
        for (int j = 0; j < 16; ++j) { v[j] = xr[64 * j]; ss += (v[j].x * v[j].x + v[j].y * v[j].y) + (v[j].z * v[j].z + v[j].w * v[j].w); }
        const float rstd = 1.0f / sqrtf(wave_sum(ss) * (1.0f / DM) + RMS_EPS);
        const int b = m >> 12;
        const f32x4* sh = (const f32x4*)(mod + (size_t)b * NMOD + 0 * DM) + lane; const f32x4* ga = (const f32x4*)(mod + (size_t)b * NMOD + 1 * DM) + lane;
        v2u* o8 = (v2u*)(h + (size_t)m * DM) + lane;
#pragma unroll
        for (int j = 0; j < 16; ++j) { const f32x4 o = (v[j] * rstd) * ga[64 * j] + sh[64 * j]; o8[64 * j] = (v2u){pk_bf16(o.x, o.y), pk_bf16(o.z, o.w)};
            if ((j & 3) == 3) asm volatile("" ::: "memory"); }
    }
}
__device__ __forceinline__ void p7_mid_rows(const float* __restrict__ x, const bf16* __restrict__ y, const float* __restrict__ ssq, const float* __restrict__ mod, float* __restrict__ x1, bf16* __restrict__ h2, int gw, int NGW, int lane) {
    for (int m = gw; m < M; m += NGW) {
        const float rstd1 = 1.0f / sqrtf(wave_sum(ssq[(size_t)m * 64 + lane]) * (1.0f / DM) + RMS_EPS);
        const int b = m >> 12;
        const f32x4* xr = (const f32x4*)(x + (size_t)m * DM) + lane; const v2u* yr = (const v2u*)(y + (size_t)m * DM) + lane;
        const f32x4* gp = (const f32x4*)(mod + (size_t)b * NMOD + 2 * DM) + lane;
        f32x4* x1r = (f32x4*)(x1 + (size_t)m * DM) + lane;
        f32x4 v[16]; float ss = 0.f;
#pragma unroll
        for (int j = 0; j < 16; ++j) { const v2u yw = yr[64 * j]; const f32x4 yv = {bf_lo(yw.x), bf_hi(yw.x), bf_lo(yw.y), bf_hi(yw.y)};
            v[j] = xr[64 * j] + (yv * rstd1) * gp[64 * j]; x1r[64 * j] = v[j];
            ss += (v[j].x * v[j].x + v[j].y * v[j].y) + (v[j].z * v[j].z + v[j].w * v[j].w);
            if ((j & 3) == 3) asm volatile("" ::: "memory"); }
        const float rstd2 = 1.0f / sqrtf(wave_sum(ss) * (1.0f / DM) + RMS_EPS);
        const f32x4* sh = (const f32x4*)(mod + (size_t)b * NMOD + 3 * DM) + lane; const f32x4* ga = (const f32x4*)(mod + (size_t)b * NMOD + 4 * DM) + lane;
        v2u* o8 = (v2u*)(h2 + (size_t)m * DM) + lane;
#pragma unroll
        for (int j = 0; j < 16; ++j) { const f32x4 o = (v[j] * rstd2) * ga[64 * j] + sh[64 * j]; o8[64 * j] = (v2u){pk_bf16(o.x, o.y), pk_bf16(o.z, o.w)};
            if ((j & 3) == 3) asm volatile("" ::: "memory"); }
    }
}
__device__ __forceinline__ void p10_final_rows(const bf16* __restrict__ f, const float* __restrict__ ssq, const float* __restrict__ mod, float* __restrict__ out, int gw, int NGW, int lane) {
    for (int m = gw; m < M; m += NGW) {
        const float rstd = 1.0f / sqrtf(wave_sum(ssq[(size_t)m * 64 + lane]) * (1.0f / DM) + RMS_EPS);
        const int b = m >> 12;
        const v2u* fr = (const v2u*)(f + (size_t)m * DM) + lane; const f32x4* gp = (const f32x4*)(mod + (size_t)b * NMOD + 5 * DM) + lane;
        f32x4* orow = (f32x4*)(out + (size_t)m * DM) + lane;
#pragma unroll
        for (int j = 0; j < 16; ++j) { const v2u fw = fr[64 * j]; const f32x4 fv = {bf_lo(fw.x), bf_hi(fw.x), bf_lo(fw.y), bf_hi(fw.y)};
            orow[64 * j] = orow[64 * j] + (fv * rstd) * gp[64 * j];
            if ((j & 7) == 7) asm volatile("" ::: "memory"); }
    }
}

namespace att {
constexpr int KSTR = 272, VSTR = 520, K_OFF = 0, V_OFF = 256 * KSTR, END_OFF = V_OFF + 128 * VSTR;
static_assert(END_OFF <= LDSCTL_OFF, "attention LDS");
__device__ __forceinline__ void attn_unit(LAS unsigned char* lds, const bf16* __restrict__ Z, bf16* __restrict__ AO, const float* __restrict__ sinks, int unit, int tid) {
    const int b = unit >> 7, rem = unit & 127, n = rem >> 2, kvh = rem & 3;
    const int m0 = b * SEQ + n * 128;
#pragma unroll
    for (int it = 0; it < 8; ++it) { const int kk = (tid >> 4) + 32 * it, dc = tid & 15;
        v4u v = {0u, 0u, 0u, 0u};
        if (n > 0 || kk >= 128) v = *(const v4u*)(Z + (size_t)(m0 - 128 + kk) * INW + pg8::ZO_K + kvh * 128 + dc * 8);
        *(LAS v4u*)(lds + K_OFF + kk * KSTR + dc * 16) = v; }
#pragma unroll
    for (int it = 0; it < 8; ++it) { const int kk = tid & 255, dc = (tid >> 8) + 2 * it;
        v4u v = {0u, 0u, 0u, 0u};
        if (n > 0 || kk >= 128) v = *(const v4u*)(Z + (size_t)(m0 - 128 + kk) * INW + pg8::ZO_V + kvh * 128 + dc * 8);
        LAS unsigned char* vp = lds + V_OFF + (dc * 8) * VSTR + kk * 2;
        *(LAS unsigned short*)(vp + 0 * VSTR) = (unsigned short)(v.x & 0xffffu); *(LAS unsigned short*)(vp + 1 * VSTR) = (unsigned short)(v.x >> 16);
        *(LAS unsigned short*)(vp + 2 * VSTR) = (unsigned short)(v.y & 0xffffu); *(LAS unsigned short*)(vp + 3 * VSTR) = (unsigned short)(v.y >> 16);
        *(LAS unsigned short*)(vp + 4 * VSTR) = (unsigned short)(v.z & 0xffffu); *(LAS unsigned short*)(vp + 5 * VSTR) = (unsigned short)(v.z >> 16);
        *(LAS unsigned short*)(vp + 6 * VSTR) = (unsigned short)(v.w & 0xffffu); *(LAS unsigned short*)(vp + 7 * VSTR) = (unsigned short)(v.w >> 16); }
    __syncthreads();
    const int wid = tid >> 6, lane = tid & 63, r = lane & 31, h = lane >> 5;
    const int hf = wid & 1, head = kvh * 4 + (wid >> 1);
    const float sink = sinks[head];
    constexpr float SCALE = 0.08838834764831845f, LOG2E = 1.4426950408889634f;
#pragma unroll 1
    for (int qt = 0; qt < 2; ++qt) {
        const int ql0 = hf * 64 + qt * 32;
        const size_t mq = (size_t)(m0 + ql0 + r);
        bf16x8 qf[8];
#pragma unroll
        for (int ks = 0; ks < 8; ++ks) qf[ks] = *(const bf16x8*)(Z + mq * INW + pg8::ZO_Q + head * 128 + ks * 16 + 8 * h);
        f32x16 S[5];
#pragma unroll
        for (int kt = 0; kt < 5; ++kt) {
#pragma unroll
            for (int i = 0; i < 16; ++i) S[kt][i] = 0.f;
#pragma unroll
            for (int ks = 0; ks < 8; ++ks) { const bf16x8 kf = *(const LAS bf16x8*)(lds + K_OFF + (ql0 + 32 * kt + r) * KSTR + (ks * 16 + 8 * h) * 2);
                S[kt] = __builtin_amdgcn_mfma_f32_32x32x16_bf16(kf, qf[ks], S[kt], 0, 0, 0); } }
        float mx = sink;
#pragma unroll
        for (int kt = 0; kt < 5; ++kt)
#pragma unroll
            for (int i = 0; i < 16; ++i) { const int cr = (i & 3) + 8 * (i >> 2) + 4 * h;
                const int diff = 128 + r - 32 * kt - cr;
                const bool valid = ((unsigned)diff < 128u) && (n > 0 || (ql0 + 32 * kt + cr) >= 128);
                const float s = valid ? S[kt][i] * SCALE : -__builtin_inff();
                S[kt][i] = s; mx = fmaxf(mx, s); }
        mx = fmaxf(mx, __shfl_xor(mx, 32));
        float sum = 0.f;
#pragma unroll
        for (int kt = 0; kt < 5; ++kt)
#pragma unroll
            for (int i = 0; i < 16; ++i) { const float p = __builtin_amdgcn_exp2f((S[kt][i] - mx) * LOG2E); S[kt][i] = p; sum += p; }
        sum += __shfl_xor(sum, 32);
        const float inv = 1.0f / (sum + __builtin_amdgcn_exp2f((sink - mx) * LOG2E));
        f32x16 O[4];
#pragma unroll
        for (int dt = 0; dt < 4; ++dt)
#pragma unroll
            for (int i = 0; i < 16; ++i) O[dt][i] = 0.f;
#pragma unroll
        for (int kt = 0; kt < 5; ++kt)
#pragma unroll
            for (int s = 0; s < 2; ++s) {
                v4u pw; pw.x = pk_bf16(S[kt][8 * s + 0], S[kt][8 * s + 1]); pw.y = pk_bf16(S[kt][8 * s + 2], S[kt][8 * s + 3]);
                pw.z = pk_bf16(S[kt][8 * s + 4], S[kt][8 * s + 5]); pw.w = pk_bf16(S[kt][8 * s + 6], S[kt][8 * s + 7]);
                const bf16x8 pf = __builtin_bit_cast(bf16x8, pw);
#pragma unroll
                for (int dt = 0; dt < 4; ++dt) { const LAS unsigned char* vp = lds + V_OFF + (dt * 32 + r) * VSTR + (ql0 + 32 * kt + 16 * s + 4 * h) * 2;
                    const s16x4 lo = *(const LAS s16x4*)vp, hi = *(const LAS s16x4*)(vp + 16);
                    const bf16x8 vf = __builtin_shufflevector(lo, hi, 0, 1, 2, 3, 4, 5, 6, 7);
                    O[dt] = __builtin_amdgcn_mfma_f32_32x32x16_bf16(vf, pf, O[dt], 0, 0, 0); } }
        bf16* op = AO + mq * 2048 + head * 128 + 4 * h;
#pragma unroll
        for (int dt = 0; dt < 4; ++dt)
#pragma unroll
            for (int gq = 0; gq < 4; ++gq)
                *(v2u*)(op + dt * 32 + 8 * gq) = (v2u){pk_bf16(O[dt][4 * gq] * inv, O[dt][4 * gq + 1] * inv), pk_bf16(O[dt][4 * gq + 2] * inv, O[dt][4 * gq + 3] * inv)};
    }
    __syncthreads();
}
}

namespace sgu {
constexpr int VN_STR = 272, VN_OFF = 0, STAT_OFF = 128 * VN_STR;
__device__ __forceinline__ void sgu_unit(LAS unsigned char* lds, const bf16* __restrict__ Z, const float* __restrict__ svstat, const float* __restrict__ ln_g, const float* __restrict__ ln_b,
                                         const bf16* __restrict__ Wb, const float* __restrict__ bs, bf16* __restrict__ SO, int unit, int tid) {
    const int g = unit & 15, m0 = (unit >> 4) * 128;
    LAS float* st = (LAS float*)(lds + STAT_OFF);
    if (tid < 128) { const f32x4* p = (const f32x4*)(svstat + (size_t)(m0 + tid) * 64); float s1 = 0.f, s2 = 0.f;
#pragma unroll
        for (int i = 0; i < 16; ++i) { const f32x4 v = p[i]; s1 += v.x + v.z; s2 += v.y + v.w; }
        const float mu = s1 * (1.0f / 2048.0f), var = fmaxf(s2 * (1.0f / 2048.0f) - mu * mu, 0.f);
        st[tid] = mu; st[128 + tid] = 1.0f / sqrtf(var + LN_EPS); }
    __syncthreads();
#pragma unroll
    for (int it = 0; it < 4; ++it) { const int s = tid & 127, cc = (tid >> 7) + 4 * it;
        const v4u v = *(const v4u*)(Z + (size_t)(m0 + s) * INW + pg8::ZO_SV + g * 128 + cc * 8);
        const float mu = st[s], rs = st[128 + s];
        const float* gp = ln_g + g * 128 + cc * 8; const float* bp = ln_b + g * 128 + cc * 8;
        LAS unsigned char* vp = lds + VN_OFF + (cc * 8) * VN_STR + s * 2;
        const float x0 = bf_lo(v.x), x1 = bf_hi(v.x), x2 = bf_lo(v.y), x3 = bf_hi(v.y), x4 = bf_lo(v.z), x5 = bf_hi(v.z), x6 = bf_lo(v.w), x7 = bf_hi(v.w);
        *(LAS unsigned short*)(vp + 0 * VN_STR) = (unsigned short)(pk_bf16((x0 - mu) * rs * gp[0] + bp[0], 0.f) & 0xffffu);
        *(LAS unsigned short*)(vp + 1 * VN_STR) = (unsigned short)(pk_bf16((x1 - mu) * rs * gp[1] + bp[1], 0.f) & 0xffffu);
        *(LAS unsigned short*)(vp + 2 * VN_STR) = (unsigned short)(pk_bf16((x2 - mu) * rs * gp[2] + bp[2], 0.f) & 0xffffu);
        *(LAS unsigned short*)(vp + 3 * VN_STR) = (unsigned short)(pk_bf16((x3 - mu) * rs * gp[3] + bp[3], 0.f) & 0xffffu);
        *(LAS unsigned short*)(vp + 4 * VN_STR) = (unsigned short)(pk_bf16((x4 - mu) * rs * gp[4] + bp[4], 0.f) & 0xffffu);
        *(LAS unsigned short*)(vp + 5 * VN_STR) = (unsigned short)(pk_bf16((x5 - mu) * rs * gp[5] + bp[5], 0.f) & 0xffffu);
        *(LAS unsigned short*)(vp + 6 * VN_STR) = (unsigned short)(pk_bf16((x6 - mu) * rs * gp[6] + bp[6], 0.f) & 0xffffu);
        *(LAS unsigned short*)(vp + 7 * VN_STR) = (unsigned short)(pk_bf16((x7 - mu) * rs * gp[7] + bp[7], 0.f) & 0xffffu); }
    __syncthreads();
    const int wid = tid >> 6, lane = tid & 63, i = lane & 15, quad = lane >> 4, tb = 16 * wid;
    f32x4 acc[8];
#pragma unroll
    for (int ct = 0; ct < 8; ++ct) acc[ct] = (f32x4){0.f, 0.f, 0.f, 0.f};
#pragma unroll
    for (int ks = 0; ks < 4; ++ks) {
        if (32 * ks <= tb + 15) {
            const bf16x8 wf = *(const bf16x8*)(Wb + (size_t)(g * 128 + tb + i) * 128 + ks * 32 + quad * 8);
#pragma unroll
            for (int ct = 0; ct < 8; ++ct) { const bf16x8 vf = *(const LAS bf16x8*)(lds + VN_OFF + (ct * 16 + i) * VN_STR + (ks * 32 + quad * 8) * 2);
                acc[ct] = __builtin_amdgcn_mfma_f32_16x16x32_bf16(vf, wf, acc[ct], 0, 0, 0); } } }
    const int t = tb + i; const size_t row = (size_t)(m0 + t); const float bias = bs[g * 128 + t];
#pragma unroll
    for (int ct = 0; ct < 8; ++ct) { const int c = g * 128 + ct * 16 + quad * 4;
        const v2u sw = *(const v2u*)(Z + row * INW + pg8::ZO_SU + c);
        const float o0 = bf_lo(sw.x) * (acc[ct][0] + bias), o1 = bf_hi(sw.x) * (acc[ct][1] + bias), o2 = bf_lo(sw.y) * (acc[ct][2] + bias), o3 = bf_hi(sw.y) * (acc[ct][3] + bias);
        *(v2u*)(SO + row * 2048 + c) = (v2u){pk_bf16(o0, o1), pk_bf16(o2, o3)}; }
    __syncthreads();
}
}

#ifndef MK_N_LAUNCHES
#define MK_N_LAUNCHES 1
#endif
constexpr int N_PHASES = 11, N_LAUNCHES = MK_N_LAUNCHES;
struct Args { const void* in[21]; float* out; unsigned char* ws; int ph_lo, ph_hi; };
static_assert(sizeof(Args) == 21 * 8 + 8 + 8 + 8, "Args has no holes");

typedef const __attribute__((address_space(4))) unsigned char* kargp_t;
#define KP_REFRESH() kargp_t kp = kbase; asm volatile("" : "+s"(kp))
#define KIN(T, i) (*(T* const __attribute__((address_space(4)))*)(kp + 8 * (i)))
#define KOUT() (*(float* const __attribute__((address_space(4)))*)(kp + 8 * 21))
#define KWS() (*(unsigned char* const __attribute__((address_space(4)))*)(kp + 8 * 22))
__global__ void __launch_bounds__(NWAVES * 64, 2) fwd(Args args) {
    extern __shared__ __attribute__((aligned(16))) unsigned char lds_raw[];
    LAS unsigned char* lds = (LAS unsigned char*)lds_raw;
    const kargp_t kbase = (kargp_t)__builtin_amdgcn_kernarg_segment_ptr();
    const int tid = threadIdx.x, lane = tid & 63, wave = __builtin_amdgcn_readfirstlane(tid >> 6);
    const int G = gridDim.x, bx = blockIdx.x;
    const int vcu = (G % 8 == 0) ? (bx % 8) * (G / 8) + bx / 8 : bx;
    const int gw = vcu * NWAVES + wave, NGW = G * NWAVES;

    for (int u = tid; u < (LDS_BYTES - LDSCTL_OFF) / 4; u += NWAVES * 64) ((LAS unsigned*)(lds + LDSCTL_OFF))[u] = 0u;
    __syncthreads();
    XcdBarrier bar; bar.bar = (unsigned*)(args.ws + WS_CTL) + CW_BAR; bar.x = 0; bar.st = nullptr;
    if (N_LAUNCHES == 1) bar = xcd_barrier_post((unsigned*)(args.ws + WS_CTL) + CW_BAR, (volatile LAS unsigned*)(lds + LDSCTL_OFF));
    const int lo = args.ph_lo, hi = args.ph_hi;
#define IN(k) (lo <= (k) && (k) < hi)
#define SEAM(k) do { if (IN(k) && IN((k) + 1)) xcd_barrier(bar); } while (0)

    if (IN(0)) {
        KP_REFRESH(); unsigned char* ws = KWS();
        P0Args A; A.c = KIN(const float, 1); A.w_ada = KIN(const float, 3); A.w_in = KIN(const float, 6); A.sgu_w = KIN(const float, 10); A.w_ps = KIN(const float, 12); A.w_pa = KIN(const float, 13);
        A.w_out = KIN(const float, 14); A.w_gate = KIN(const float, 17); A.w_up = KIN(const float, 18); A.w_down = KIN(const float, 19); A.positions = KIN(const int, 2);
        A.modp = (float*)(ws + WS_MODP); A.ropeC = (float*)(ws + WS_ROPEC); A.ropeS = (float*)(ws + WS_ROPES); A.sguw = (bf16*)(ws + WS_SGUW);
        A.win_t = (bf16*)(ws + WS_WIN); A.wps_t = (bf16*)(ws + WS_WPS); A.wpa_t = (bf16*)(ws + WS_WPA); A.wout_t = (bf16*)(ws + WS_WOUT); A.wgu_t = (bf16*)(ws + WS_WGU); A.wdn_t = (bf16*)(ws + WS_WDN);
        p0_prologue(A, lds, gw, NGW, wave, lane);
    }
    SEAM(0);
    if (IN(1)) { KP_REFRESH(); unsigned char* ws = KWS();
        p1_mod_reduce((const float*)(ws + WS_MODP), KIN(const float, 4), KIN(const float, 5), KIN(const float, 15), KIN(const float, 16), KIN(const float, 20), (float*)(ws + WS_MOD), bx * (NWAVES * 64) + tid, G * NWAVES * 64); }
    SEAM(1);
    if (IN(2)) { KP_REFRESH(); unsigned char* ws = KWS(); p2_norm_rows(KIN(const float, 0), (const float*)(ws + WS_MOD), (bf16*)(ws + WS_A), gw, NGW, lane); }
    SEAM(2);
    if (IN(3)) { KP_REFRESH(); unsigned char* ws = KWS();
        pg8::Gemm g{(const bf16*)(ws + WS_A), (const bf16*)(ws + WS_WIN), M, INW, DM}; pg8::StaticOrder S; S.init(M, INW, G, bx);
        pg8::EpiZ E{(bf16*)(ws + WS_Z), (const float*)(ws + WS_ROPEC), (const float*)(ws + WS_ROPES), (float*)(ws + WS_SVSTAT)};
        pg8::gemm_phase<pg8::EpiZ, pg8::StaticOrder, true, true>(lds, g, S, E);
    }
    SEAM(3);
    if (IN(4)) { KP_REFRESH(); unsigned char* ws = KWS();
        { const bf16* Zb = (const bf16*)(ws + WS_Z); bf16* AO = (bf16*)(ws + WS_B); const float* sinks = KIN(const float, 7);
          for (int u = bx; u < 512; u += G) att::attn_unit(lds, Zb, AO, sinks, u, tid); }
        { const bf16* Zb = (const bf16*)(ws + WS_Z); bf16* SO = (bf16*)(ws + WS_B + (size_t)M * 2048 * 2);
          const float* svstat = (const float*)(ws + WS_SVSTAT); const float* ln_g = KIN(const float, 8); const float* ln_b = KIN(const float, 9); const float* sb = KIN(const float, 11); const bf16* sguw = (const bf16*)(ws + WS_SGUW);
          for (int u = bx; u < 2048; u += G) sgu::sgu_unit(lds, Zb, svstat, ln_g, ln_b, sguw, sb, SO, u, tid); }
    }
    SEAM(4);
    if (IN(5)) {
        { KP_REFRESH(); unsigned char* ws = KWS();
          pg8::Gemm g{(const bf16*)(ws + WS_B + (size_t)M * 2048 * 2), (const bf16*)(ws + WS_WPS), M, DM, 2048}; pg8::StaticOrder S; S.init(M, DM, G, bx); pg8::EpiMergeA E{(bf16*)(ws + WS_A), (const bf16*)(ws + WS_Z)};
          pg8::gemm_phase<pg8::EpiMergeA, pg8::StaticOrder, true, true>(lds, g, S, E); }
        { KP_REFRESH(); unsigned char* ws = KWS();
          pg8::Gemm g{(const bf16*)(ws + WS_B), (const bf16*)(ws + WS_WPA), M, DM, 2048}; pg8::StaticOrder S; S.init(M, DM, G, bx); pg8::EpiMergeB E{(bf16*)(ws + WS_A), (const bf16*)(ws + WS_Z)};
          pg8::gemm_phase<pg8::EpiMergeB, pg8::StaticOrder, true, true>(lds, g, S, E); }
    }
    SEAM(5);
    if (IN(6)) { KP_REFRESH(); unsigned char* ws = KWS();
        pg8::Gemm g{(const bf16*)(ws + WS_A), (const bf16*)(ws + WS_WOUT), M, DM, DM}; pg8::StaticOrder S; S.init(M, DM, G, bx); pg8::EpiStats E{(bf16*)(ws + WS_B), (float*)(ws + WS_SSQ)};
        pg8::gemm_phase<pg8::EpiStats, pg8::StaticOrder, true, true>(lds, g, S, E);
    }
    SEAM(6);
    if (IN(7)) { KP_REFRESH(); unsigned char* ws = KWS();
        p7_mid_rows(KIN(const float, 0), (const bf16*)(ws + WS_B), (const float*)(ws + WS_SSQ), (const float*)(ws + WS_MOD), KOUT(), (bf16*)(ws + WS_A), gw, NGW, lane); }
    SEAM(7);
    if (IN(8)) { KP_REFRESH(); unsigned char* ws = KWS();
        pg8::Gemm g{(const bf16*)(ws + WS_A), (const bf16*)(ws + WS_WGU), M, NGU, DM}; pg8::StaticOrder S; S.init(M, NGU, G, bx); pg8::EpiSwiGLU E{(bf16*)(ws + WS_Z)};
        pg8::gemm_phase<pg8::EpiSwiGLU, pg8::StaticOrder, true, true>(lds, g, S, E);
    }
    SEAM(8);
    if (IN(9)) { KP_REFRESH(); unsigned char* ws = KWS();
        pg8::Gemm g{(const bf16*)(ws + WS_Z), (const bf16*)(ws + WS_WDN), M, DM, FF}; pg8::StaticOrder S; S.init(M, DM, G, bx); pg8::EpiStats E{(bf16*)(ws + WS_B), (float*)(ws + WS_SSQ)};
        pg8::gemm_phase<pg8::EpiStats, pg8::StaticOrder, true, true>(lds, g, S, E);
    }
    SEAM(9);
    if (IN(10)) { KP_REFRESH(); unsigned char* ws = KWS();
        p10_final_rows((const bf16*)(ws + WS_B), (const float*)(ws + WS_SSQ), (const float*)(ws + WS_MOD), KOUT(), gw, NGW, lane); }
#undef IN
#undef SEAM
}

extern "C" void kernel_launch(void* const* d_in, const int* in_sizes, int n_in, void* d_out, int out_size, void* d_ws, size_t ws_size, hipStream_t stream) {
    static int grid = 0;
    if (grid == 0) {
        if (n_in != 21 || in_sizes[0] != M * DM || out_size != M * DM || ws_size < WS_END) {
            fprintf(stderr, "kernel_launch: built for 21 inputs, x/out of %d floats, >= %zu bytes of workspace; got n_in %d, in0 %d, out %d, ws %zu; nothing launched\n", M * DM, (size_t)WS_END, n_in, n_in > 0 ? in_sizes[0] : -1, out_size, ws_size);
            grid = -1; return; }
        int dev = 0, cus = 0, per_cu = 0;
        if (hipGetDevice(&dev) != hipSuccess || hipDeviceGetAttribute(&cus, hipDeviceAttributeMultiprocessorCount, dev) != hipSuccess) { fprintf(stderr, "kernel_launch: device query failed\n"); grid = -1; return; }
        if (hipFuncSetAttribute((const void*)fwd, hipFuncAttributeMaxDynamicSharedMemorySize, LDS_BYTES) != hipSuccess) { fprintf(stderr, "kernel_launch: hipFuncSetAttribute failed\n"); grid = -1; return; }
        if (hipOccupancyMaxActiveBlocksPerMultiprocessor(&per_cu, (const void*)fwd, NWAVES * 64, LDS_BYTES) != hipSuccess || per_cu < 1)
            fprintf(stderr, "kernel_launch: note: occupancy query reports %d workgroups per CU\n", per_cu);
        (void)hipGetLastError();
        grid = cus;
    }
    if (grid < 0) return;
    if (hipMemsetAsync((char*)d_ws + WS_CTL, 0, CTL_ZERO_BYTES, stream) != hipSuccess) { fprintf(stderr, "kernel_launch: hipMemsetAsync failed\n"); return; }
    Args a{};
    for (int i = 0; i < 21; ++i) a.in[i] = d_in[i];
    a.out = (float*)d_out; a.ws = (unsigned char*)d_ws;
    if (N_LAUNCHES == 1) {
        a.ph_lo = 0; a.ph_hi = N_PHASES;
        hipLaunchKernelGGL(fwd, dim3(grid), dim3(NWAVES * 64), LDS_BYTES, stream, a);
    } else {
        for (int li = 0; li < N_PHASES; ++li) { a.ph_lo = li; a.ph_hi = li + 1; hipLaunchKernelGGL(fwd, dim3(grid), dim3(NWAVES * 64), LDS_BYTES, stream, a); }
    }
    const hipError_t le = hipPeekAtLastError();
    if (le != hipSuccess) fprintf(stderr, "kernel_launch: launch failed: %s (grid %d)\n", hipGetErrorName(le), grid);
}
```

```cpp
#include <hip/hip_runtime.h>
#include <cstdio>
#include <cstdint>
namespace pg8 {
#define PG8_LAS __attribute__((address_space(3)))
typedef unsigned short bf16_t;
typedef short bf16x8 __attribute__((ext_vector_type(8)));
typedef float f32x4 __attribute__((ext_vector_type(4)));
typedef unsigned u32x4 __attribute__((ext_vector_type(4)));
typedef unsigned u32x2 __attribute__((ext_vector_type(2)));
typedef int i32x4 __attribute__((ext_vector_type(4)));
constexpr int BM = 256, BK = 64, HALF = 128, HTB = HALF * BK * 2  , STAGE_BYTES = 8 * HTB, NXCD = 8, WGM = 8;

__host__ __device__ __forceinline__ int lds_byte(int r, int c) { const int st = (r >> 4) * 2 + (c >> 5), rr = r & 15, cc = c & 31, ob = rr * 64 + cc * 2; return st * 1024 + (ob ^ (((ob >> 9) & 1) << 5)); }
__host__ __device__ __forceinline__ void stage_rc(int b, int& R, int& C) { const int st = b / 1024, sb = b % 1024, swz = sb ^ (((sb >> 9) & 1) << 5); R = (st >> 1) * 16 + swz / 64; C = (st & 1) * 32 + (swz % 64) / 2; }
__host__ __device__ __forceinline__ int perm32(int rho) { const int n = rho >> 4, i = rho & 15; return 8 * (i >> 2) + 4 * n + (i & 3); }

struct Unit { int pm, pn; };
struct Gemm { const bf16_t* A; const bf16_t* Bt; int M, N, K; };

struct StaticOrder {
    int nM, nN, nwg, G, c;
    __host__ __device__ void init(int M, int N, int G_, int c_) { nM = M / BM; nN = N / BM; nwg = nM * nN; G = G_; c = c_; }
    __host__ __device__ bool next(int i, Unit& u) const {
        const long L = (long)i * G + c; if (L >= nwg) return false;
        int wgid = (int)L; { const int q = nwg / NXCD, r = nwg % NXCD, xcd = wgid % NXCD, off = wgid / NXCD; wgid = (xcd < r ? xcd * (q + 1) : r * (q + 1) + (xcd - r) * q) + off; }
        const int nig = WGM * nN, gid = wgid / nig, fm = gid * WGM, gsz = (nM - fm) < WGM ? (nM - fm) : WGM;
        u.pm = fm + ((wgid % nig) % gsz); u.pn = (wgid % nig) / gsz; return true;
    }
    __device__ __forceinline__ void a_ready(const Unit&) const {}
    __device__ __forceinline__ void done(const Unit&) const {}
};

__device__ __forceinline__ unsigned cvt_pk_bf16(float lo, float hi) { unsigned r; asm volatile("v_cvt_pk_bf16_f32 %0, %1, %2" : "=v"(r) : "v"(lo), "v"(hi)); return r; }
typedef float f32x2 __attribute__((ext_vector_type(2)));
__device__ __forceinline__ f32x2 gelu_pk(f32x2 v) {
    const f32x2 av = __builtin_elementwise_abs(v), d = av * 0.2316418882f + 1.0f;
    f32x2 t; t.x = __builtin_amdgcn_rcpf(d.x); t.y = __builtin_amdgcn_rcpf(d.y);
    f32x2 q = t * 0.5307027145f + (-0.7265760135f); q = q * t + 0.7107068705f; q = q * t + (-0.142248368f); q = q * t + 0.127414796f; q = q * t;
    const f32x2 s = (v * v) * (-0.72134752044f);
    f32x2 e; e.x = __builtin_amdgcn_exp2f(s.x); e.y = __builtin_amdgcn_exp2f(s.y);
    const f32x2 m = v * (q * e), r = v - m;
    f32x2 o; o.x = v.x < 0.f ? m.x : r.x; o.y = v.y < 0.f ? m.y : r.y; return o;
}

typedef float f32x2t __attribute__((ext_vector_type(2)));
typedef __bf16 bf16x2t __attribute__((ext_vector_type(2)));
__device__ __forceinline__ unsigned pk_bf16(float lo, float hi) { f32x2t v = {lo, hi}; bf16x2t b = __builtin_convertvector(v, bf16x2t); return __builtin_bit_cast(unsigned, b); }
__device__ __forceinline__ float bf_lo(unsigned w) { return __builtin_bit_cast(float, w << 16); }
__device__ __forceinline__ float bf_hi(unsigned w) { return __builtin_bit_cast(float, w & 0xffff0000u); }
__device__ __forceinline__ float sigmoid_f(float x) { return __builtin_amdgcn_rcpf(1.0f + __builtin_amdgcn_exp2f(-1.4426950408889634f * x)); }
__device__ __forceinline__ u32x4 pack8(const f32x4& a, const f32x4& b) { u32x4 w; w.x = pk_bf16(a[0], a[1]); w.y = pk_bf16(a[2], a[3]); w.z = pk_bf16(b[0], b[1]); w.w = pk_bf16(b[2], b[3]); return w; }
__device__ __forceinline__ void unpack8(const u32x4& w, f32x4& a, f32x4& b) { a = (f32x4){bf_lo(w.x), bf_hi(w.x), bf_lo(w.y), bf_hi(w.y)}; b = (f32x4){bf_lo(w.z), bf_hi(w.z), bf_lo(w.w), bf_hi(w.w)}; }

constexpr int Z_LD = 15360, ZO_Q = 0, ZO_K = 2048, ZO_V = 2560, ZO_SU = 3072, ZO_SV = 5120, ZO_GA = 7168, ZO_GB = 11264;

struct EpiZ {
    static constexpr bool PERM = true, AFTER_DRAIN = false, HAS_MID = false;
    bf16_t* Z; const float* ropeC; const float* ropeS; float* svstat;
    __device__ __forceinline__ void operator()(const f32x4 (&acc)[2][2][4][2], const Unit& u, int wr, int wc, int fr, int fq) const {
        const int pn = u.pn;
        const int mode = pn < 10 ? 0 : (pn < 12 ? 1 : (pn < 20 ? 2 : (pn < 28 ? 3 : 4)));
        const int row0 = u.pm * BM + wr * 64 + fr, col0 = pn * BM + wc * 32 + 8 * fq;
        const bool rot = (mode == 0) && (wc == 0);
        const float sgn = fq < 2 ? -1.0f : 1.0f;
#pragma unroll
        for (int aim = 0; aim < 4; ++aim) { const int ai = aim >> 1;
            f32x4 cs[4][4];
            if (rot) {
#pragma unroll
                for (int m = 2 * (aim & 1); m < 2 * (aim & 1) + 2; ++m) { const size_t ro = (size_t)(row0 + ai * HALF + m * 16) * 16 + 8 * (fq & 1);
                    cs[m][0] = *(const f32x4*)(ropeC + ro); cs[m][1] = *(const f32x4*)(ropeC + ro + 4); cs[m][2] = *(const f32x4*)(ropeS + ro); cs[m][3] = *(const f32x4*)(ropeS + ro + 4); }
                asm volatile("" ::: "memory");
            }
#pragma unroll
            for (int m = 2 * (aim & 1); m < 2 * (aim & 1) + 2; ++m) {
                const int row = row0 + ai * HALF + m * 16;
                bf16_t* rowp = Z + (size_t)row * Z_LD + col0;
                f32x4 c0 = {1.f, 1.f, 1.f, 1.f}, c1 = c0, s0 = {0.f, 0.f, 0.f, 0.f}, s1 = s0;
                if (rot) { c0 = cs[m][0]; c1 = cs[m][1]; s0 = cs[m][2]; s1 = cs[m][3]; }
                float t1 = 0.f, t2 = 0.f;
#pragma unroll
                for (int bj = 0; bj < 2; ++bj) {
                    f32x4 v0 = acc[ai][bj][m][0], v1 = acc[ai][bj][m][1];
                    if (rot) {
                        f32x4 o0, o1;
#pragma unroll
                        for (int j = 0; j < 4; ++j) { o0[j] = __shfl_xor(v0[j], 32); o1[j] = __shfl_xor(v1[j], 32); }
                        v0 = v0 * c0 + (o0 * s0) * sgn; v1 = v1 * c1 + (o1 * s1) * sgn;
                    } else if (mode == 2 || mode == 3) {
                        f32x2 a = gelu_pk((f32x2){v0[0], v0[1]}), b = gelu_pk((f32x2){v0[2], v0[3]}), c = gelu_pk((f32x2){v1[0], v1[1]}), d = gelu_pk((f32x2){v1[2], v1[3]});
                        v0 = (f32x4){a.x, a.y, b.x, b.y}; v1 = (f32x4){c.x, c.y, d.x, d.y};
                        if (mode == 3) {
#pragma unroll
                            for (int j = 0; j < 4; ++j) { t1 += v0[j] + v1[j]; t2 += v0[j] * v0[j] + v1[j] * v1[j]; } }
                    } else if (mode == 4) {
#pragma unroll
                        for (int j = 0; j < 4; ++j) { v0[j] = sigmoid_f(v0[j]); v1[j] = sigmoid_f(v1[j]); }
                    }
                    *(u32x4*)(rowp + bj * HALF) = pack8(v0, v1);
                }
                if (mode == 3) {
                    t1 += __shfl_xor(t1, 16); t1 += __shfl_xor(t1, 32); t2 += __shfl_xor(t2, 16); t2 += __shfl_xor(t2, 32);
                    if (fq == 0) *(f32x2*)(svstat + ((size_t)row * 32 + (pn - 20) * 4 + wc) * 2) = (f32x2){t1, t2};
                }
            }
        }
    }
};
struct EpiMerge {
    static constexpr bool PERM = true, AFTER_DRAIN = false, HAS_MID = true;
    bf16_t* T; const bf16_t* Z;
    __device__ __forceinline__ void mid(f32x4 (&acc)[2][2][4][2], const Unit& u, int wr, int wc, int fr, int fq) const {
        int row0 = u.pm * BM + wr * 64 + fr, col0 = u.pn * BM + wc * 32 + 8 * fq;
        asm volatile("" : "+v"(row0), "+v"(col0));
#pragma unroll
        for (int ai = 0; ai < 2; ++ai)
#pragma unroll
            for (int mp = 0; mp < 2; ++mp) {
                u32x4 aw[2][2], bw[2][2];
#pragma unroll
                for (int mm = 0; mm < 2; ++mm)
#pragma unroll
                    for (int bj = 0; bj < 2; ++bj) { const bf16_t* zp = Z + (size_t)(row0 + ai * HALF + (2 * mp + mm) * 16) * Z_LD + col0 + bj * HALF;
                        aw[mm][bj] = *(const u32x4*)(zp + ZO_GA); bw[mm][bj] = *(const u32x4*)(zp + ZO_GB); }
                asm volatile("" ::: "memory");
#pragma unroll
                for (int mm = 0; mm < 2; ++mm)
#pragma unroll
                    for (int bj = 0; bj < 2; ++bj) { f32x4 a0, a1, b0, b1; unpack8(aw[mm][bj], a0, a1); unpack8(bw[mm][bj], b0, b1); const int m = 2 * mp + mm;
#pragma unroll
                        for (int j = 0; j < 4; ++j) { acc[ai][bj][m][0][j] *= a0[j] * __builtin_amdgcn_rcpf(b0[j]); acc[ai][bj][m][1][j] *= a1[j] * __builtin_amdgcn_rcpf(b1[j]); } }
            }
    }
    __device__ __forceinline__ void operator()(const f32x4 (&acc)[2][2][4][2], const Unit& u, int wr, int wc, int fr, int fq) const {
        const int row0 = u.pm * BM + wr * 64 + fr, col0 = u.pn * BM + wc * 32 + 8 * fq;
#pragma unroll
        for (int ai = 0; ai < 2; ++ai) {
            u32x4 gw[4][2];
#pragma unroll
            for (int m = 0; m < 4; ++m)
#pragma unroll
                for (int bj = 0; bj < 2; ++bj) gw[m][bj] = *(const u32x4*)(Z + (size_t)(row0 + ai * HALF + m * 16) * Z_LD + ZO_GB + col0 + bj * HALF);
            asm volatile("" ::: "memory");
#pragma unroll
            for (int m = 0; m < 4; ++m)
#pragma unroll
                for (int bj = 0; bj < 2; ++bj) { f32x4 g0, g1; unpack8(gw[m][bj], g0, g1);
                    *(u32x4*)(T + (size_t)(row0 + ai * HALF + m * 16) * 4096 + col0 + bj * HALF) = pack8(acc[ai][bj][m][0] * g0, acc[ai][bj][m][1] * g1); }
            asm volatile("" ::: "memory");
        }
    }
};
struct EpiStats {
    static constexpr bool PERM = true, AFTER_DRAIN = false, HAS_MID = false;
    bf16_t* Y; float* ssq;
    __device__ __forceinline__ void operator()(const f32x4 (&acc)[2][2][4][2], const Unit& u, int wr, int wc, int fr, int fq) const {
        const int row0 = u.pm * BM + wr * 64 + fr, col0 = u.pn * BM + wc * 32 + 8 * fq;
#pragma unroll
        for (int ai = 0; ai < 2; ++ai)
#pragma unroll
            for (int m = 0; m < 4; ++m) { const int row = row0 + ai * HALF + m * 16; float t2 = 0.f;
#pragma unroll
                for (int bj = 0; bj < 2; ++bj) { const f32x4 v0 = acc[ai][bj][m][0], v1 = acc[ai][bj][m][1];
#pragma unroll
                    for (int j = 0; j < 4; ++j) t2 += v0[j] * v0[j] + v1[j] * v1[j];
                    *(u32x4*)(Y + (size_t)row * 4096 + col0 + bj * HALF) = pack8(v0, v1); }
                t2 += __shfl_xor(t2, 16); t2 += __shfl_xor(t2, 32);
                if (fq == 0) ssq[(size_t)row * 64 + u.pn * 4 + wc] = t2; }
    }
};
struct EpiStatsI8 {
    static constexpr bool PERM = true, AFTER_DRAIN = false, HAS_MID = false;
    bf16_t* Y; float* ssq; const float* sa; const float* sbw;
    __device__ __forceinline__ void operator()(const f32x4 (&acc)[2][2][4][2], const Unit& u, int wr, int wc, int fr, int fq) const {
        const int row0 = u.pm * BM + wr * 64 + fr, col0 = u.pn * BM + wc * 32 + 8 * fq;
        float sr[2][4]; f32x4 sc[2][2];
#pragma unroll
        for (int ai = 0; ai < 2; ++ai)
#pragma unroll
            for (int m = 0; m < 4; ++m) sr[ai][m] = sa[row0 + ai * HALF + m * 16];
#pragma unroll
        for (int bj = 0; bj < 2; ++bj)
#pragma unroll
            for (int n = 0; n < 2; ++n) sc[bj][n] = *(const f32x4*)(sbw + col0 + bj * HALF + 4 * n);
        asm volatile("" ::: "memory");
#pragma unroll
        for (int ai = 0; ai < 2; ++ai)
#pragma unroll
            for (int m = 0; m < 4; ++m) { const int row = row0 + ai * HALF + m * 16; const float s = sr[ai][m]; float t2 = 0.f;
#pragma unroll
                for (int bj = 0; bj < 2; ++bj) { f32x4 v0, v1; const i32x4 i0 = __builtin_bit_cast(i32x4, acc[ai][bj][m][0]), i1 = __builtin_bit_cast(i32x4, acc[ai][bj][m][1]);
#pragma unroll
                    for (int j = 0; j < 4; ++j) { v0[j] = (float)i0[j] * (s * sc[bj][0][j]); v1[j] = (float)i1[j] * (s * sc[bj][1][j]); t2 += v0[j] * v0[j] + v1[j] * v1[j]; }
                    *(u32x4*)(Y + (size_t)row * 4096 + col0 + bj * HALF) = pack8(v0, v1); }
                t2 += __shfl_xor(t2, 16); t2 += __shfl_xor(t2, 32);
                if (fq == 0) ssq[(size_t)row * 64 + u.pn * 4 + wc] = t2; }
    }
};
struct EpiSwiGLU_I8 {
    static constexpr bool PERM = true, AFTER_DRAIN = false, HAS_MID = false;
    bf16_t* H; const float* sa; const float* sbw;
    __device__ __forceinline__ void operator()(const f32x4 (&acc)[2][2][4][2], const Unit& u, int wr, int wc, int fr, int fq) const {
        const int row0 = u.pm * BM + wr * 64 + fr, col0 = u.pn * HALF + wc * 32 + 8 * fq, wrow0 = u.pn * BM + wc * 32 + 8 * fq;
        float sr[2][4]; f32x4 sg[2], su[2];
#pragma unroll
        for (int ai = 0; ai < 2; ++ai)
#pragma unroll
            for (int m = 0; m < 4; ++m) sr[ai][m] = sa[row0 + ai * HALF + m * 16];
#pragma unroll
        for (int n = 0; n < 2; ++n) { sg[n] = *(const f32x4*)(sbw + wrow0 + 4 * n); su[n] = *(const f32x4*)(sbw + wrow0 + HALF + 4 * n); }
        asm volatile("" ::: "memory");
#pragma unroll
        for (int ai = 0; ai < 2; ++ai)
#pragma unroll
            for (int m = 0; m < 4; ++m) { const int row = row0 + ai * HALF + m * 16; const float s = sr[ai][m];
                f32x4 h[2];
#pragma unroll
                for (int n = 0; n < 2; ++n) { const i32x4 gi = __builtin_bit_cast(i32x4, acc[ai][0][m][n]), ui = __builtin_bit_cast(i32x4, acc[ai][1][m][n]);
#pragma unroll
                    for (int j = 0; j < 4; ++j) { const float g = (float)gi[j] * (s * sg[n][j]), uu = (float)ui[j] * (s * su[n][j]); h[n][j] = g * sigmoid_f(g) * uu; } }
                *(u32x4*)(H + (size_t)row * 11008 + col0) = pack8(h[0], h[1]); }
    }
};

__device__ __forceinline__ void wht8(f32x4& a, f32x4& b) {
    f32x4 t0 = {a.x + a.y, a.x - a.y, a.z + a.w, a.z - a.w}, t1 = {b.x + b.y, b.x - b.y, b.z + b.w, b.z - b.w};
    f32x4 u0 = {t0.x + t0.z, t0.y + t0.w, t0.x - t0.z, t0.y - t0.w}, u1 = {t1.x + t1.z, t1.y + t1.w, t1.x - t1.z, t1.y - t1.w};
    a = u0 + u1; b = u0 - u1;
}
struct EpiSwiGLU_I8H {
    static constexpr bool PERM = true, AFTER_DRAIN = false, HAS_MID = false;
    bf16_t* H; const float* sa; const float* sbw;
    __device__ __forceinline__ void operator()(const f32x4 (&acc)[2][2][4][2], const Unit& u, int wr, int wc, int fr, int fq) const {
        const int row0 = u.pm * BM + wr * 64 + fr, colw = u.pn * HALF + wc * 32, wrow0 = u.pn * BM + wc * 32 + 8 * fq;
        float sr[2][4]; f32x4 sg[2], su[2];
#pragma unroll
        for (int ai = 0; ai < 2; ++ai)
#pragma unroll
            for (int m = 0; m < 4; ++m) sr[ai][m] = sa[row0 + ai * HALF + m * 16];
#pragma unroll
        for (int n = 0; n < 2; ++n) { sg[n] = *(const f32x4*)(sbw + wrow0 + 4 * n); su[n] = *(const f32x4*)(sbw + wrow0 + HALF + 4 * n) * 0.17677669529663687f; }
        asm volatile("" ::: "memory");
#pragma unroll
        for (int ai = 0; ai < 2; ++ai) {
            f32x4 h[4][2];
#pragma unroll
            for (int m = 0; m < 4; ++m) { const float s = sr[ai][m];
#pragma unroll
                for (int n = 0; n < 2; ++n) { const i32x4 gi = __builtin_bit_cast(i32x4, acc[ai][0][m][n]), ui = __builtin_bit_cast(i32x4, acc[ai][1][m][n]);
#pragma unroll
                    for (int j = 0; j < 4; ++j) { const float g = (float)gi[j] * (s * sg[n][j]), uu = (float)ui[j] * (s * su[n][j]); h[m][n][j] = g * sigmoid_f(g) * uu; } }
                wht8(h[m][0], h[m][1]); }
            f32x4 t[2][2][2];
#pragma unroll
            for (int p = 0; p < 2; ++p)
#pragma unroll
                for (int n = 0; n < 2; ++n)
#pragma unroll
                    for (int j = 0; j < 4; ++j) { const auto r = __builtin_amdgcn_permlane16_swap(__float_as_uint(h[2 * p][n][j]), __float_as_uint(h[2 * p + 1][n][j]), false, false);
                        const float x = __uint_as_float((unsigned)r[0]), y = __uint_as_float((unsigned)r[1]); t[p][0][n][j] = x + y; t[p][1][n][j] = x - y; }
            const int row = row0 + ai * HALF + fq * 16;
#pragma unroll
            for (int b3 = 0; b3 < 2; ++b3) { f32x4 o[2][2];
#pragma unroll
                for (int n = 0; n < 2; ++n)
#pragma unroll
                    for (int j = 0; j < 4; ++j) { const auto r = __builtin_amdgcn_permlane32_swap(__float_as_uint(t[0][b3][n][j]), __float_as_uint(t[1][b3][n][j]), false, false);
                        const float x = __uint_as_float((unsigned)r[0]), y = __uint_as_float((unsigned)r[1]); o[0][n][j] = x + y; o[1][n][j] = x - y; }
#pragma unroll
                for (int b4 = 0; b4 < 2; ++b4) *(u32x4*)(H + (size_t)row * 11008 + colw + 16 * b4 + 8 * b3) = pack8(o[b4][0], o[b4][1]); }
        }
    }
};

struct EpiGateI8 {
    static constexpr bool PERM = true, AFTER_DRAIN = false, HAS_MID = false;
    bf16_t* Z; const float* sa; const float* sbw;
    __device__ __forceinline__ void operator()(const f32x4 (&acc)[2][2][4][2], const Unit& u, int wr, int wc, int fr, int fq) const {
        const int row0 = u.pm * BM + wr * 64 + fr, col0 = u.pn * BM + wc * 32 + 8 * fq;
        float sr[2][4]; f32x4 sc[2][2];
#pragma unroll
        for (int ai = 0; ai < 2; ++ai)
#pragma unroll
            for (int m = 0; m < 4; ++m) sr[ai][m] = sa[row0 + ai * HALF + m * 16];
#pragma unroll
        for (int bj = 0; bj < 2; ++bj)
#pragma unroll
            for (int n = 0; n < 2; ++n) sc[bj][n] = *(const f32x4*)(sbw + col0 + bj * HALF + 4 * n);
        asm volatile("" ::: "memory");
#pragma unroll
        for (int ai = 0; ai < 2; ++ai)
#pragma unroll
            for (int m = 0; m < 4; ++m) { const int row = row0 + ai * HALF + m * 16; const float s = sr[ai][m];
#pragma unroll
                for (int bj = 0; bj < 2; ++bj) { f32x4 v[2];
#pragma unroll
                    for (int n = 0; n < 2; ++n) { const i32x4 gi = __builtin_bit_cast(i32x4, acc[ai][bj][m][n]);
#pragma unroll
                        for (int j = 0; j < 4; ++j) v[n][j] = sigmoid_f((float)gi[j] * (s * sc[bj][n][j])); }
                    *(u32x4*)(Z + (size_t)row * Z_LD + ZO_GA + col0 + bj * HALF) = pack8(v[0], v[1]); } }
    }
};

struct EpiSvGateI8 {
    static constexpr bool PERM = true, AFTER_DRAIN = false, HAS_MID = false;
    bf16_t* Z; const float* sa; const float* sbw; float* svstat;
    __device__ __forceinline__ void operator()(const f32x4 (&acc)[2][2][4][2], const Unit& u, int wr, int wc, int fr, int fq) const {
        const int row0 = u.pm * BM + wr * 64 + fr, col0 = u.pn * BM + wc * 32 + 8 * fq; const bool issv = u.pn < 8;
        float sr[2][4]; f32x4 sc[2][2];
#pragma unroll
        for (int ai = 0; ai < 2; ++ai)
#pragma unroll
            for (int m = 0; m < 4; ++m) sr[ai][m] = sa[row0 + ai * HALF + m * 16];
#pragma unroll
        for (int bj = 0; bj < 2; ++bj)
#pragma unroll
            for (int n = 0; n < 2; ++n) sc[bj][n] = *(const f32x4*)(sbw + col0 + bj * HALF + 4 * n);
        asm volatile("" ::: "memory");
#pragma unroll
        for (int ai = 0; ai < 2; ++ai)
#pragma unroll
            for (int m = 0; m < 4; ++m) { const int row = row0 + ai * HALF + m * 16; const float s = sr[ai][m]; float t1 = 0.f, t2 = 0.f;
#pragma unroll
                for (int bj = 0; bj < 2; ++bj) { f32x4 v0, v1; const i32x4 i0 = __builtin_bit_cast(i32x4, acc[ai][bj][m][0]), i1 = __builtin_bit_cast(i32x4, acc[ai][bj][m][1]);
#pragma unroll
                    for (int j = 0; j < 4; ++j) { v0[j] = (float)i0[j] * (s * sc[bj][0][j]); v1[j] = (float)i1[j] * (s * sc[bj][1][j]); }
                    if (issv) {
                        f32x2 a = gelu_pk((f32x2){v0[0], v0[1]}), b = gelu_pk((f32x2){v0[2], v0[3]}), c = gelu_pk((f32x2){v1[0], v1[1]}), d = gelu_pk((f32x2){v1[2], v1[3]});
                        v0 = (f32x4){a.x, a.y, b.x, b.y}; v1 = (f32x4){c.x, c.y, d.x, d.y};
#pragma unroll
                        for (int j = 0; j < 4; ++j) { t1 += v0[j] + v1[j]; t2 += v0[j] * v0[j] + v1[j] * v1[j]; }
                    } else {
#pragma unroll
                        for (int j = 0; j < 4; ++j) { v0[j] = sigmoid_f(v0[j]); v1[j] = sigmoid_f(v1[j]); }
                    }
                    *(u32x4*)(Z + (size_t)row * Z_LD + ZO_SV + col0 + bj * HALF) = pack8(v0, v1); }
                if (issv) {
                    t1 += __shfl_xor(t1, 16); t1 += __shfl_xor(t1, 32); t2 += __shfl_xor(t2, 16); t2 += __shfl_xor(t2, 32);
                    if (fq == 0) *(f32x2*)(svstat + ((size_t)row * 32 + u.pn * 4 + wc) * 2) = (f32x2){t1, t2}; }
            }
    }
};
template <class Epi, class Sched, bool ALIGN_EPI = false, bool SP2 = false, bool I8 = false>
__device__ __forceinline__ void gemm_phase(PG8_LAS unsigned char* lds, const Gemm g, const Sched& S, const Epi& E, const int tid_in) {
    const int tid = tid_in, wid = __builtin_amdgcn_readfirstlane(tid >> 6), lane = tid & 63, wr = wid >> 2, wc = wid & 3, fr = lane & 15, fq = lane >> 4;
    const int K = g.K, nt = K / BK;
    unsigned voffA[2], voffB[2];
#pragma unroll
    for (int i = 0; i < 2; ++i) { int R, C; stage_rc(tid * 16 + i * 8192, R, C); const int Rb = Epi::PERM ? ((R & ~31) + perm32(R & 31)) : R;
        voffA[i] = (unsigned)(R * K + C) * 2u; voffB[i] = (unsigned)(Rb * K + C) * 2u; }
    const size_t kstep = (size_t)(BK * 2);
    const size_t hstep = (size_t)HALF * K * 2;
    const size_t tstep = 2 * hstep;
    const unsigned ldsw = (unsigned)wid * 1024u;
    const int aoff = lds_byte(wr * 64 + fr, fq * 8), boff = lds_byte(wc * 32 + fr, fq * 8);
#define PG8_SA(b, h) (((b) * 2 + (h)) * HTB)
#define PG8_SB(b, h) ((4 + (b) * 2 + (h)) * HTB)
#define PG8_STAGE(bufoff, gbase, voff) do { _Pragma("unroll") for (int _i = 0; _i < 2; ++_i) \
        __builtin_amdgcn_global_load_lds((const unsigned*)((const char*)(gbase) + (voff)[_i]), (PG8_LAS unsigned*)(lds + (bufoff) + ldsw + _i * 8192), 16, 0, 0); } while (0)
#define PG8_LDA(dst, b, h) do { _Pragma("unroll") for (int m = 0; m < 4; ++m) _Pragma("unroll") for (int k = 0; k < 2; ++k) dst[m][k] = *(const PG8_LAS bf16x8*)(lds + PG8_SA(b, h) + aoff + m * 2048 + k * 1024); } while (0)
#define PG8_LDB(dst, b, h) do { _Pragma("unroll") for (int n = 0; n < 2; ++n) _Pragma("unroll") for (int k = 0; k < 2; ++k) dst[n][k] = *(const PG8_LAS bf16x8*)(lds + PG8_SB(b, h) + boff + n * 2048 + k * 1024); } while (0)
#define PG8_MMA(ai, bj, At, Bt) do { __builtin_amdgcn_s_setprio(1); _Pragma("unroll") for (int m = 0; m < 4; ++m) _Pragma("unroll") for (int n = 0; n < 2; ++n) _Pragma("unroll") for (int k = 0; k < 2; ++k) \
        { if constexpr (I8) acc[ai][bj][m][n] = __builtin_bit_cast(f32x4, __builtin_amdgcn_mfma_i32_16x16x64_i8(__builtin_bit_cast(i32x4, Bt[n][k]), __builtin_bit_cast(i32x4, At[m][k]), __builtin_bit_cast(i32x4, acc[ai][bj][m][n]), 0, 0, 0)); \
          else acc[ai][bj][m][n] = __builtin_amdgcn_mfma_f32_16x16x32_bf16(Bt[n][k], At[m][k], acc[ai][bj][m][n], 0, 0, 0); } __builtin_amdgcn_s_setprio(0); } while (0)
#define PG8_WAIT_V(n) asm volatile("s_waitcnt vmcnt(" #n ")" ::: "memory")
#define PG8_WAIT_L(n) asm volatile("s_waitcnt lgkmcnt(" #n ")" ::: "memory")
#define PG8_BAR __builtin_amdgcn_s_barrier()
#define PG8_SCHED __builtin_amdgcn_sched_barrier(0)
    Unit cur, nxt; int ui = 0;
    if (!S.next(0, cur)) return;
    f32x4 acc[2][2][4][2];
#pragma unroll
    for (int a = 0; a < 2; ++a)
#pragma unroll
        for (int b = 0; b < 2; ++b)
#pragma unroll
            for (int m = 0; m < 4; ++m)
#pragma unroll
                for (int n = 0; n < 2; ++n) acc[a][b][m][n] = (f32x4){0.f, 0.f, 0.f, 0.f};
    bf16x8 At[4][2], B0[2][2], B1[2][2];
    const char* cA = (const char*)g.A + (size_t)cur.pm * tstep; const char* cB = (const char*)g.Bt + (size_t)cur.pn * tstep;
    S.a_ready(cur);
    if constexpr (SP2) {
        PG8_STAGE(PG8_SB(0, 0), cB, voffB); PG8_STAGE(PG8_SB(0, 1), cB + hstep, voffB); PG8_STAGE(PG8_SA(0, 0), cA, voffA); PG8_STAGE(PG8_SA(0, 1), cA + hstep, voffA);
        if (wr == 1) PG8_BAR;
        PG8_WAIT_V(2); PG8_BAR;
        PG8_STAGE(PG8_SB(1, 0), cB + kstep, voffB); PG8_STAGE(PG8_SA(1, 0), cA + kstep, voffA); PG8_STAGE(PG8_SB(1, 1), cB + hstep + kstep, voffB);
        PG8_WAIT_V(6); PG8_BAR;
    } else {
        PG8_STAGE(PG8_SB(0, 0), cB, voffB); PG8_STAGE(PG8_SA(0, 0), cA, voffA); PG8_STAGE(PG8_SB(0, 1), cB + hstep, voffB); PG8_STAGE(PG8_SA(0, 1), cA + hstep, voffA);
        if (wr == 1) PG8_BAR;
        PG8_WAIT_V(4); PG8_BAR;
        PG8_STAGE(PG8_SB(1, 0), cB + kstep, voffB); PG8_STAGE(PG8_SA(1, 0), cA + kstep, voffA); PG8_STAGE(PG8_SB(1, 1), cB + hstep + kstep, voffB);
        PG8_WAIT_V(6); PG8_BAR;
    }
    for (;;) {
        const bool has_next = S.next(ui + 1, nxt);
        const char* nA = has_next ? (const char*)g.A + (size_t)nxt.pm * tstep : cA; const char* nB = has_next ? (const char*)g.Bt + (size_t)nxt.pn * tstep : cB;
        for (int t = 0; t < nt; t += 2) {
            const bool last = (t == nt - 2);
            const char* a1 = cA + (size_t)(t + 1) * kstep;
            const char* a2 = last ? nA : cA + (size_t)(t + 2) * kstep; const char* b2 = last ? nB : cB + (size_t)(t + 2) * kstep;
            const char* a3 = a2 + kstep; const char* b3 = b2 + kstep;
            if constexpr (Epi::HAS_MID) { if (t == nt / 2) E.mid(acc, cur, wr, wc, fr, fq); }
            if (last && has_next) S.a_ready(nxt);
            if constexpr (SP2) {
            PG8_LDB(B0, 0, 0); PG8_LDB(B1, 0, 1); PG8_SCHED; PG8_LDA(At, 0, 0); PG8_STAGE(PG8_SA(1, 1), a1 + hstep, voffA);
            PG8_WAIT_V(8); PG8_WAIT_L(0); PG8_BAR; PG8_MMA(0, 0, At, B0); PG8_MMA(0, 1, At, B1); PG8_BAR; PG8_SCHED;
            PG8_LDA(At, 0, 1); PG8_STAGE(PG8_SB(0, 0), b2, voffB); PG8_STAGE(PG8_SB(0, 1), b2 + hstep, voffB); PG8_STAGE(PG8_SA(0, 0), a2, voffA);
            PG8_WAIT_V(8); PG8_WAIT_L(0); PG8_BAR; PG8_MMA(1, 0, At, B0); PG8_MMA(1, 1, At, B1); PG8_BAR; PG8_SCHED;
            PG8_LDB(B0, 1, 0); PG8_LDB(B1, 1, 1); PG8_SCHED; PG8_LDA(At, 1, 0); PG8_STAGE(PG8_SA(0, 1), a2 + hstep, voffA);
            PG8_WAIT_V(8); PG8_WAIT_L(0); PG8_BAR; PG8_MMA(0, 0, At, B0); PG8_MMA(0, 1, At, B1); PG8_BAR; PG8_SCHED;
            PG8_LDA(At, 1, 1); PG8_STAGE(PG8_SB(1, 0), b3, voffB); PG8_STAGE(PG8_SB(1, 1), b3 + hstep, voffB); PG8_STAGE(PG8_SA(1, 0), a3, voffA);
            PG8_WAIT_V(8); PG8_WAIT_L(0); PG8_BAR; PG8_MMA(1, 0, At, B0); PG8_MMA(1, 1, At, B1); PG8_BAR; PG8_SCHED;
            } else {
            PG8_LDB(B0, 0, 0); PG8_SCHED; PG8_LDA(At, 0, 0); PG8_STAGE(PG8_SA(1, 1), a1 + hstep, voffA);
            PG8_WAIT_L(8); PG8_BAR; PG8_WAIT_L(0); PG8_MMA(0, 0, At, B0); PG8_BAR; PG8_SCHED;
            PG8_LDB(B1, 0, 1); PG8_STAGE(PG8_SB(0, 0), b2, voffB);
            PG8_BAR; PG8_WAIT_L(0); PG8_MMA(0, 1, At, B1); PG8_BAR;
            PG8_LDA(At, 0, 1); PG8_STAGE(PG8_SA(0, 0), a2, voffA);
            PG8_BAR; PG8_WAIT_L(0); PG8_MMA(1, 0, At, B0); PG8_BAR; PG8_SCHED;
            PG8_STAGE(PG8_SB(0, 1), b2 + hstep, voffB);
            PG8_WAIT_V(6); PG8_BAR; PG8_MMA(1, 1, At, B1); PG8_BAR;
            PG8_LDB(B0, 1, 0); PG8_SCHED; PG8_LDA(At, 1, 0); PG8_STAGE(PG8_SA(0, 1), a2 + hstep, voffA);
            PG8_WAIT_L(8); PG8_BAR; PG8_WAIT_L(0); PG8_MMA(0, 0, At, B0); PG8_BAR; PG8_SCHED;
            PG8_LDB(B1, 1, 1); PG8_STAGE(PG8_SB(1, 0), b3, voffB);
            PG8_BAR; PG8_WAIT_L(0); PG8_MMA(0, 1, At, B1); PG8_BAR;
            PG8_LDA(At, 1, 1); PG8_STAGE(PG8_SA(1, 0), a3, voffA);
            PG8_BAR; PG8_WAIT_L(0); PG8_MMA(1, 0, At, B0); PG8_BAR; PG8_SCHED;
            PG8_STAGE(PG8_SB(1, 1), b3 + hstep, voffB);
            PG8_WAIT_V(6); PG8_BAR; PG8_MMA(1, 1, At, B1); PG8_BAR;
            }
        }
        if constexpr (ALIGN_EPI) { if (wr == 0) PG8_BAR; }
        if constexpr (!Epi::AFTER_DRAIN) { E(acc, cur, wr, wc, fr, fq); S.done(cur); }
        if (!has_next) break;
#pragma unroll
        for (int a = 0; a < 2; ++a)
#pragma unroll
            for (int b = 0; b < 2; ++b)
#pragma unroll
                for (int m = 0; m < 4; ++m)
#pragma unroll
                    for (int n = 0; n < 2; ++n) acc[a][b][m][n] = (f32x4){0.f, 0.f, 0.f, 0.f};
        cur = nxt; cA = nA; cB = nB; ++ui;
        if constexpr (ALIGN_EPI) { if (wr == 1) PG8_BAR; }
    }
    PG8_WAIT_V(0);
    if constexpr (!ALIGN_EPI) { if (wr == 0) PG8_BAR; }
    PG8_BAR;
    if constexpr (Epi::AFTER_DRAIN) { E.fused(acc, cur, wr, wc, fr, fq, lds, wid, lane); S.done(cur); }
#undef PG8_SA
#undef PG8_SB
#undef PG8_STAGE
#undef PG8_LDA
#undef PG8_LDB
#undef PG8_MMA
#undef PG8_WAIT_V
#undef PG8_WAIT_L
#undef PG8_BAR
#undef PG8_SCHED
}
}

constexpr int NWAVES = 8;
constexpr int NB = 4, SEQ = 4096, DM = 4096, M = NB * SEQ;
constexpr int INW = 15360, FF = 11008, NGU = 2 * FF, NMOD = 6 * DM;
constexpr float RMS_EPS = 1e-6f, LN_EPS = 1e-5f;

constexpr size_t MiB = 1u << 20;
constexpr size_t WS_CTL = 0, CTL_ZERO_BYTES = 1 * MiB;
constexpr size_t WS_MODP = 1 * MiB;
constexpr size_t WS_MOD = 25 * MiB;
constexpr size_t WS_ROPEC = 26 * MiB, WS_ROPES = 27 * MiB;
constexpr size_t WS_SGUW = 28 * MiB;
constexpr size_t WS_SVSTAT = 29 * MiB;
constexpr size_t WS_SSQ = 33 * MiB;
constexpr size_t WS_WIN = 64 * MiB, WS_WPS = 184 * MiB, WS_WPA = 200 * MiB, WS_WOUT = 216 * MiB, WS_WGU = 248 * MiB, WS_WDN = 420 * MiB;
constexpr size_t WS_Z = 512 * MiB;
constexpr size_t WS_A = 992 * MiB;
constexpr size_t WS_B = 1120 * MiB;
constexpr size_t WS_WQ = 1248 * MiB;
constexpr size_t WS_SBW = 37 * MiB;
constexpr size_t WS_SA = 38 * MiB;
constexpr size_t WS_HQ = 1334 * MiB;
constexpr size_t WS_WQIN = 1398 * MiB;
constexpr size_t WS_SA1 = 39 * MiB, WS_SBWIN = 40 * MiB;
constexpr size_t WS_WDQ = 1438 * MiB;
constexpr size_t WS_SBWD = 41 * MiB;
constexpr size_t WS_HIDQ = WS_A;
constexpr size_t WS_END = 1481 * MiB;
static_assert(WS_WQIN + (size_t)10240 * 4096 <= WS_WDQ && WS_WDQ + (size_t)4096 * 11008 <= WS_END && WS_HIDQ + (size_t)16384 * 11008 <= WS_WQ && WS_SBWIN + 10240 * 4 <= WS_SBWD && WS_SBWD + 4096 * 4 <= 64 * MiB, "d_ws map (down-proj int8)");
static_assert(WS_WIN + (size_t)INW * DM * 2 <= WS_WPS && WS_WPS + (size_t)DM * 2048 * 2 <= WS_WPA && WS_WPA + (size_t)DM * 2048 * 2 <= WS_WOUT && WS_WOUT + (size_t)DM * DM * 2 <= WS_WGU &&
              WS_WGU + (size_t)NGU * DM * 2 <= WS_WDN && WS_WDN + (size_t)DM * FF * 2 <= WS_Z && WS_Z + (size_t)M * INW * 2 <= WS_A && WS_A + (size_t)M * DM * 2 <= WS_B && WS_B + (size_t)M * DM * 2 <= WS_WQ && WS_WQ + (size_t)NGU * DM <= WS_HQ && WS_HQ + (size_t)M * DM <= WS_WQIN && WS_WQIN + (size_t)10240 * DM <= WS_END, "d_ws map");
static_assert(WS_MODP + (size_t)64 * 4 * NMOD * 4 <= WS_MOD && WS_SVSTAT + (size_t)M * 64 * 4 <= WS_SSQ && WS_SSQ + (size_t)M * 64 * 4 <= WS_WIN, "d_ws map (small)");
constexpr int CW_BAR = 4096;

constexpr int LDS_BYTES = 147456;
constexpr int LDSCTL_OFF = LDS_BYTES - 256;

#define GAS __attribute__((address_space(1)))
#define LAS __attribute__((address_space(3)))
typedef unsigned short bf16;
typedef unsigned v4u __attribute__((ext_vector_type(4)));
typedef unsigned v2u __attribute__((ext_vector_type(2)));
typedef float f32x4 __attribute__((ext_vector_type(4)));
typedef float f32x2 __attribute__((ext_vector_type(2)));
typedef float f32x16 __attribute__((ext_vector_type(16)));
typedef short bf16x8 __attribute__((ext_vector_type(8)));
typedef short s16x4 __attribute__((ext_vector_type(4)));
typedef GAS unsigned gu32;
#define RLX_AGENT __ATOMIC_RELAXED, __HIP_MEMORY_SCOPE_AGENT
#define LDS_WAIT() asm volatile("s_waitcnt lgkmcnt(0)" ::: "memory")
using pg8::pk_bf16; using pg8::bf_lo; using pg8::bf_hi;

__device__ __forceinline__ float wave_sum(float v) {
#pragma unroll
    for (int o = 1; o < 64; o <<= 1) v += __shfl_xor(v, o);
    return v;
}
#define XB_TMO      128
#define XB_XCNT(j)  (256  + 64 * (j))
#define XB_XSUB(j)  (1280 + 64 * (j))
#define XB_XGEN(j)  (2304 + 64 * (j))
#define XB_TOP      3328
#define XB_TOPGEN   3392
#define XCD_BAR_WORDS 3456
#define XB_SPIN_CAP (1u << 18)

__device__ __forceinline__ unsigned xb_ld(unsigned* p)              { return __hip_atomic_load(p, __ATOMIC_RELAXED, __HIP_MEMORY_SCOPE_AGENT); }
__device__ __forceinline__ unsigned xb_add(unsigned* p, unsigned v) { return __hip_atomic_fetch_add(p, v, __ATOMIC_RELAXED, __HIP_MEMORY_SCOPE_AGENT); }
__device__ __forceinline__ unsigned xb_xcc_id() { return (unsigned)__builtin_amdgcn_s_getreg((3 << 11) | 20) & 0xFu; }
#define XB_SPIN(cond, bar) do { unsigned _sp = 0; while (cond) { __builtin_amdgcn_s_sleep(1); \
    if ((++_sp & 255u) == 0u) { if (xb_ld(&(bar)[XB_TMO])) break; if (_sp > XB_SPIN_CAP) { atomicAdd(&(bar)[XB_TMO], 1u); break; } } } } while (0)

struct XcdBarrier {
    unsigned* bar; unsigned x;
    volatile LAS unsigned* st;
};

__device__ __forceinline__ XcdBarrier xcd_barrier_post(unsigned* bar, volatile LAS unsigned* st) {
    XcdBarrier b; b.bar = bar; b.x = xb_xcc_id(); b.st = st;
    if (threadIdx.x == 0) (void)xb_add(&bar[XB_XCNT(b.x)], 1u);
    return b;
}
__device__ __forceinline__ void xcd_barrier_complete(unsigned* bar, unsigned x, unsigned& nloc, unsigned& nx) {
    const unsigned G = gridDim.x * gridDim.y * gridDim.z;
    unsigned sum, cnt, mine, sp = 0u;
    for (;;) {
        sum = 0u; cnt = 0u; mine = 0u;
#pragma unroll
        for (unsigned j = 0; j < 16; ++j) { const unsigned c = xb_ld(&bar[XB_XCNT(j)]); sum += c; cnt += (c > 0u) ? 1u : 0u; mine = (j == x) ? c : mine; }
        if (sum == G) break;
        __builtin_amdgcn_s_sleep(1);
        if ((++sp & 255u) == 0u) { if (xb_ld(&bar[XB_TMO])) break; if (sp > XB_SPIN_CAP) { atomicAdd(&bar[XB_TMO], 1u); break; } }
    }
    nloc = mine > 0u ? mine : 1u; nx = cnt > 0u ? cnt : 1u;
}

__device__ __forceinline__ void xcd_barrier(const XcdBarrier& b) {
    asm volatile("s_waitcnt vmcnt(0)" ::: "memory");
    __syncthreads();
    if (threadIdx.x == 0) {
        unsigned* bar = b.bar;
        __builtin_amdgcn_s_waitcnt(0);
        unsigned nloc = b.st[0], nx = b.st[1];
        if (nloc == 0u) { xcd_barrier_complete(bar, b.x, nloc, nx); b.st[0] = nloc; b.st[1] = nx; }
        const unsigned old = xb_add(&bar[XB_XSUB(b.x)], 1u);
        const unsigned gen = old / nloc;
        if (old + 1u == (gen + 1u) * nloc) {
            __builtin_amdgcn_fence(__ATOMIC_RELEASE, "agent");
            asm volatile("s_waitcnt vmcnt(0)" ::: "memory");
            const unsigned og = xb_add(&bar[XB_TOP], 1u);
            const unsigned tg = og / nx;
            if (og + 1u == (tg + 1u) * nx) xb_add(&bar[XB_TOPGEN], 1u);
            else XB_SPIN(xb_ld(&bar[XB_TOPGEN]) == tg, bar);
            __builtin_amdgcn_fence(__ATOMIC_ACQUIRE, "agent");
            xb_add(&bar[XB_XGEN(b.x)], 1u);
            asm volatile("s_waitcnt vmcnt(0)" ::: "memory");
        } else {
            XB_SPIN(xb_ld(&bar[XB_XGEN(b.x)]) == gen, bar);
            __builtin_amdgcn_fence(__ATOMIC_ACQUIRE, "agent");
            asm volatile("s_waitcnt vmcnt(0)" ::: "memory");
        }
    }
    __syncthreads();
}

__device__ const float ROPE_INVF[16] = {1.0f, 0.44036659598350525f, 0.1939227432012558f, 0.08539710193872452f, 0.03760603070259094f, 0.016560440883040428f, 0.007292664609849453f, 0.0032114461064338684f,
                                        0.0014142135623842478f, 0.0006227724370546639f, 0.00027424818836152554f, 0.00012076973507646471f, 5.3182957344688475e-05f, 2.34199997066753e-05f, 1.0313385246263351e-05f, 4.541670477919979e-06f};

__device__ __forceinline__ void p0_transpose_item(const float* __restrict__ W, int K, int N, bf16* __restrict__ WT, int k0, int n0, int dst_row0, LAS float* scr, int lane, int dstK = 0, int dk0 = 0) {
    if (dstK == 0) dstK = K;
    const int sub = lane >> 4, c4 = lane & 15;
    f32x4 v[16];
#pragma unroll
    for (int i = 0; i < 16; ++i) v[i] = __builtin_nontemporal_load((const f32x4*)(W + (size_t)(k0 + 4 * i + sub) * N + n0 + 4 * c4));
#pragma unroll
    for (int i = 0; i < 16; ++i) { LAS float* p = scr + (4 * i + sub) * 65 + 4 * c4; p[0] = v[i][0]; p[1] = v[i][1]; p[2] = v[i][2]; p[3] = v[i][3]; }
    LDS_WAIT();
    const int c8 = lane & 7;
#pragma unroll
    for (int it = 0; it < 8; ++it) { const int nn = (lane >> 3) + 8 * it; const LAS float* s = scr + (8 * c8) * 65 + nn;
        v4u o; o.x = pk_bf16(s[0 * 65], s[1 * 65]); o.y = pk_bf16(s[2 * 65], s[3 * 65]); o.z = pk_bf16(s[4 * 65], s[5 * 65]); o.w = pk_bf16(s[6 * 65], s[7 * 65]);
        *(v4u*)(WT + (size_t)(dst_row0 + nn) * dstK + dk0 + k0 + 8 * c8) = o; }
    LDS_WAIT();
}
__device__ __forceinline__ void p0_gemv_item(const float* __restrict__ c, const float* __restrict__ w_ada, float* __restrict__ part, int cg, int kc, LAS float* scr, int lane) {
    const int k0 = kc * 64;
#pragma unroll
    for (int b = 0; b < 4; ++b) { const float cv = c[b * DM + k0 + lane]; scr[b * 64 + lane] = cv / (1.0f + __expf(-cv)); }
    LDS_WAIT();
    f32x4 a0 = {0.f, 0.f, 0.f, 0.f}, a1 = a0, a2 = a0, a3 = a0;
    const float* wp = w_ada + (size_t)k0 * NMOD + cg * 256 + 4 * lane;
#pragma unroll 16
    for (int kk = 0; kk < 64; ++kk) { const f32x4 w = __builtin_nontemporal_load((const f32x4*)(wp + (size_t)kk * NMOD));
        a0 += w * scr[kk]; a1 += w * scr[64 + kk]; a2 += w * scr[128 + kk]; a3 += w * scr[192 + kk]; }
    float* pp = part + (size_t)(kc * 4) * NMOD + cg * 256 + 4 * lane;
    *(f32x4*)(pp) = a0; *(f32x4*)(pp + NMOD) = a1; *(f32x4*)(pp + 2 * NMOD) = a2; *(f32x4*)(pp + 3 * NMOD) = a3;
    LDS_WAIT();
}
struct P0Args { const float *c, *w_ada, *w_in, *sgu_w, *w_ps, *w_pa, *w_out, *w_gate, *w_up, *w_down; const int* positions;
                float *modp, *ropeC, *ropeS; bf16 *sguw, *win_t, *wps_t, *wpa_t, *wout_t, *wgu_t, *wdn_t; };
__device__ __forceinline__ void p0_prologue(const P0Args& A, LAS unsigned char* lds, int gw, int NGW, int wave, int lane) {
    LAS float* scr = (LAS float*)(lds + wave * 16640);
    constexpr int I_GEMV = 96 * 64;
    constexpr int I_IN = (DM / 64) * (INW / 64), I_PS = (2048 / 64) * (DM / 64), I_OUT = (DM / 64) * (DM / 64), I_G = (DM / 64) * (FF / 64), I_DN = (FF / 64) * (DM / 64);
    constexpr int I_ROPE = M / 64, I_SW = 64;
    constexpr int NITEMS = I_GEMV + I_IN + 2 * I_PS + I_OUT + 2 * I_G + I_DN + I_ROPE + I_SW;
    for (int it = gw; it < NITEMS; it += NGW) {
        int r = it;
        if (r < I_GEMV) { p0_gemv_item(A.c, A.w_ada, A.modp, r % 96, r / 96, scr, lane); continue; } r -= I_GEMV;
        if (r < I_IN) { const int nnb = INW / 64, kb = r / nnb, nb = r % nnb; p0_transpose_item(A.w_in, DM, INW, A.win_t, 64 * kb, 64 * nb, 64 * nb, scr, lane); continue; } r -= I_IN;
        if (r < I_PS) { const int nnb = DM / 64, kb = r / nnb, nb = r % nnb; p0_transpose_item(A.w_ps, 2048, DM, A.wps_t, 64 * kb, 64 * nb, 64 * nb, scr, lane, 4096, 0); continue; } r -= I_PS;
        if (r < I_PS) { const int nnb = DM / 64, kb = r / nnb, nb = r % nnb; p0_transpose_item(A.w_pa, 2048, DM, A.wps_t, 64 * kb, 64 * nb, 64 * nb, scr, lane, 4096, 2048); continue; } r -= I_PS;
        if (r < I_OUT) { const int nnb = DM / 64, kb = r / nnb, nb = r % nnb; p0_transpose_item(A.w_out, DM, DM, A.wout_t, 64 * kb, 64 * nb, 64 * nb, scr, lane); continue; } r -= I_OUT;
        if (r < I_G) { const int nnb = FF / 64, kb = r / nnb, nb = r % nnb, n0 = 64 * nb;
            p0_transpose_item(A.w_gate, DM, FF, A.wgu_t, 64 * kb, n0, 256 * (n0 >> 7) + (n0 & 127), scr, lane); continue; } r -= I_G;
        if (r < I_G) { const int nnb = FF / 64, kb = r / nnb, nb = r % nnb, n0 = 64 * nb;
            p0_transpose_item(A.w_up, DM, FF, A.wgu_t, 64 * kb, n0, 256 * (n0 >> 7) + 128 + (n0 & 127), scr, lane); continue; } r -= I_G;
        if (r < I_DN) { const int nnb = DM / 64, kb = r / nnb, nb = r % nnb; p0_transpose_item(A.w_down, FF, DM, A.wdn_t, 64 * kb, 64 * nb, 64 * nb, scr, lane); continue; } r -= I_DN;
        if (r < I_ROPE) {
#pragma unroll 4
            for (int e = 0; e < 16; ++e) { const int idx = r * 1024 + e * 64 + lane, mrow = idx >> 4, i = idx & 15;
                const float ang = (float)A.positions[mrow] * ROPE_INVF[i];
                const double rev = (double)ang * 0.15915494309189535; const float fr = (float)(rev - __builtin_rint(rev));
                A.ropeC[idx] = __builtin_amdgcn_cosf(fr); A.ropeS[idx] = __builtin_amdgcn_sinf(fr); }
            continue; } r -= I_ROPE;
        {
#pragma unroll 4
            for (int e = 0; e < 64; ++e) { const int idx = r * 4096 + e * 64 + lane, t = (idx >> 7) & 127, s = idx & 127;
                const float w = (s <= t) ? A.sgu_w[idx] : 0.0f; A.sguw[idx] = (bf16)(pk_bf16(w, 0.f) & 0xffffu); }
        }
    }
}
__device__ __forceinline__ void p1_mod_reduce(const float* __restrict__ modp, const float* __restrict__ b_ada, const float* g_pre_mix, const float* g_post_mix, const float* g_pre_ffn, const float* g_post_ffn,
                                              float* __restrict__ mod, int gtid, int gthreads) {
    for (int idx = gtid; idx < 4 * (NMOD / 4); idx += gthreads) {
        const int b = idx / (NMOD / 4), j = 4 * (idx % (NMOD / 4));
        f32x4 s = *(const f32x4*)(b_ada + j);
#pragma unroll 32
        for (int kc = 0; kc < 64; ++kc) s += *(const f32x4*)(modp + (size_t)(kc * 4 + b) * NMOD + j);
        const int chunk = j >> 12, e = j & 4095;
        if (chunk == 1) s = *(const f32x4*)(g_pre_mix + e) * (s + 1.0f);
        else if (chunk == 2) s = s * *(const f32x4*)(g_post_mix + e);
        else if (chunk == 4) s = *(const f32x4*)(g_pre_ffn + e) * (s + 1.0f);
        else if (chunk == 5) s = s * *(const f32x4*)(g_post_ffn + e);
        *(f32x4*)(mod + (size_t)b * NMOD + j) = s;
    }
}
__device__ __forceinline__ void p1_quant_wrows(const bf16* __restrict__ W, signed char* __restrict__ WQ, float* __restrict__ sbw, int nrows, int gw, int NGW, int lane) {
    for (int r = gw; r < nrows; r += NGW) {
        const v4u* wr = (const v4u*)(W + (size_t)r * DM) + lane;
        v4u w[8]; float mx = 0.f;
#pragma unroll
        for (int j = 0; j < 8; ++j) { w[j] = __builtin_nontemporal_load(wr + 64 * j);
            mx = fmaxf(mx, fmaxf(fmaxf(fabsf(bf_lo(w[j].x)), fabsf(bf_hi(w[j].x))), fmaxf(fabsf(bf_lo(w[j].y)), fabsf(bf_hi(w[j].y)))));
            mx = fmaxf(mx, fmaxf(fmaxf(fabsf(bf_lo(w[j].z)), fabsf(bf_hi(w[j].z))), fmaxf(fabsf(bf_lo(w[j].w)), fabsf(bf_hi(w[j].w))))); }
#pragma unroll
        for (int o = 1; o < 64; o <<= 1) mx = fmaxf(mx, __shfl_xor(mx, o));
        const float inv = mx > 0.f ? 127.0f / mx : 0.f;
        if (lane == 0) sbw[r] = mx * (1.0f / 127.0f);
        v2u* qr = (v2u*)(WQ + (size_t)r * DM) + lane;
#pragma unroll
        for (int j = 0; j < 8; ++j) {
            const int q0 = (int)__builtin_rintf(bf_lo(w[j].x) * inv), q1 = (int)__builtin_rintf(bf_hi(w[j].x) * inv), q2 = (int)__builtin_rintf(bf_lo(w[j].y) * inv), q3 = (int)__builtin_rintf(bf_hi(w[j].y) * inv);
            const int q4 = (int)__builtin_rintf(bf_lo(w[j].z) * inv), q5 = (int)__builtin_rintf(bf_hi(w[j].z) * inv), q6 = (int)__builtin_rintf(bf_lo(w[j].w) * inv), q7 = (int)__builtin_rintf(bf_hi(w[j].w) * inv);
            v2u o; o.x = (unsigned)(q0 & 255) | ((unsigned)(q1 & 255) << 8) | ((unsigned)(q2 & 255) << 16) | ((unsigned)(q3 & 255) << 24);
            o.y = (unsigned)(q4 & 255) | ((unsigned)(q5 & 255) << 8) | ((unsigned)(q6 & 255) << 16) | ((unsigned)(q7 & 255) << 24);
            qr[64 * j] = o; }
    }
}
template <int CTRL> __device__ __forceinline__ float dpp_mov(float x) { return __builtin_bit_cast(float, __builtin_amdgcn_mov_dpp(__builtin_bit_cast(int, x), CTRL, 0xf, 0xf, true)); }
__device__ __forceinline__ f32x4 wht32_chunk(v2u w, float s1, float s2, float s4) {
    f32x4 a = {bf_lo(w.x), bf_hi(w.x), bf_lo(w.y), bf_hi(w.y)};
    { const f32x4 t = {a.x + a.y, a.x - a.y, a.z + a.w, a.z - a.w}; a = (f32x4){t.x + t.z, t.y + t.w, t.x - t.z, t.y - t.w}; }
    { f32x4 o; o.x = dpp_mov<0xB1>(a.x); o.y = dpp_mov<0xB1>(a.y); o.z = dpp_mov<0xB1>(a.z); o.w = dpp_mov<0xB1>(a.w); a = a * s1 + o; }
    { f32x4 o; o.x = dpp_mov<0x4E>(a.x); o.y = dpp_mov<0x4E>(a.y); o.z = dpp_mov<0x4E>(a.z); o.w = dpp_mov<0x4E>(a.w); a = a * s2 + o; }
    { f32x4 o; o.x = dpp_mov<0x1B>(dpp_mov<0x141>(a.x)); o.y = dpp_mov<0x1B>(dpp_mov<0x141>(a.y)); o.z = dpp_mov<0x1B>(dpp_mov<0x141>(a.z)); o.w = dpp_mov<0x1B>(dpp_mov<0x141>(a.w)); a = a * s4 + o; }
    return a * 0.17677669529663687f;
}
__device__ __forceinline__ void p1_quant_wdown_h32(const bf16* __restrict__ W, signed char* __restrict__ WQ, float* __restrict__ sbw, int gw, int NGW, int lane) {
    const float s1 = (lane & 1) ? -1.f : 1.f, s2 = (lane & 2) ? -1.f : 1.f, s4 = (lane & 4) ? -1.f : 1.f;
    for (int r = gw; r < DM; r += NGW) {
        const v2u* wr = (const v2u*)(W + (size_t)r * FF) + lane;
        float mx = 0.f;
#pragma unroll 1
        for (int i0 = 0; i0 < 43; i0 += 8) { v2u w[8];
#pragma unroll
            for (int k = 0; k < 8; ++k) { const int i = (i0 + k < 43) ? i0 + k : 42; w[k] = wr[64 * i]; }
#pragma unroll
            for (int k = 0; k < 8; ++k) { const f32x4 a = wht32_chunk(w[k], s1, s2, s4); mx = fmaxf(mx, fmaxf(fmaxf(fabsf(a.x), fabsf(a.y)), fmaxf(fabsf(a.z), fabsf(a.w)))); } }
#pragma unroll
        for (int o = 1; o < 64; o <<= 1) mx = fmaxf(mx, __shfl_xor(mx, o));
        const float inv = mx > 0.f ? 127.0f / mx : 0.f;
        if (lane == 0) sbw[r] = mx * (1.0f / 127.0f);
        unsigned* qr = (unsigned*)(WQ + (size_t)r * FF) + lane;
#pragma unroll 1
        for (int i0 = 0; i0 < 43; i0 += 8) { v2u w[8];
#pragma unroll
            for (int k = 0; k < 8; ++k) { const int i = (i0 + k < 43) ? i0 + k : 42; w[k] = wr[64 * i]; }
#pragma unroll
            for (int k = 0; k < 8; ++k) { const int i = (i0 + k < 43) ? i0 + k : 42; const f32x4 a = wht32_chunk(w[k], s1, s2, s4);
                const int q0 = (int)__builtin_rintf(a.x * inv), q1 = (int)__builtin_rintf(a.y * inv), q2 = (int)__builtin_rintf(a.z * inv), q3 = (int)__builtin_rintf(a.w * inv);
                qr[64 * i] = (unsigned)(q0 & 255) | ((unsigned)(q1 & 255) << 8) | ((unsigned)(q2 & 255) << 16) | ((unsigned)(q3 & 255) << 24); } }
    }
}
__device__ __forceinline__ void p8b_quant_hid_rows(const bf16* __restrict__ Hb, signed char* __restrict__ Hq, float* __restrict__ sa, int gw, int NGW, int lane) {
    const float s1 = (lane & 1) ? -1.f : 1.f, s2 = (lane & 2) ? -1.f : 1.f, s4 = (lane & 4) ? -1.f : 1.f;
    for (int m = gw; m < M; m += NGW) {
        const v2u* hr = (const v2u*)(Hb + (size_t)m * FF) + lane;
        v2u w[43]; float mx = 0.f;
#pragma unroll
        for (int i = 0; i < 43; ++i) w[i] = __builtin_nontemporal_load(hr + 64 * i);
#pragma unroll
        for (int i = 0; i < 43; ++i) { const f32x4 a = wht32_chunk(w[i], s1, s2, s4); mx = fmaxf(mx, fmaxf(fmaxf(fabsf(a.x), fabsf(a.y)), fmaxf(fabsf(a.z), fabsf(a.w))));
            w[i] = (v2u){pk_bf16(a.x, a.y), pk_bf16(a.z, a.w)}; }
#pragma unroll
        for (int o = 1; o < 64; o <<= 1) mx = fmaxf(mx, __shfl_xor(mx, o));
        const float inv = mx > 0.f ? 127.0f / mx : 0.f;
        if (lane == 0) sa[m] = mx * (1.0f / 127.0f);
        unsigned* qr = (unsigned*)(Hq + (size_t)m * FF) + lane;
#pragma unroll
        for (int i = 0; i < 43; ++i) { const int q0 = (int)__builtin_rintf(bf_lo(w[i].x) * inv), q1 = (int)__builtin_rintf(bf_hi(w[i].x) * inv), q2 = (int)__builtin_rintf(bf_lo(w[i].y) * inv), q3 = (int)__builtin_rintf(bf_hi(w[i].y) * inv);
            qr[64 * i] = (unsigned)(q0 & 255) | ((unsigned)(q1 & 255) << 8) | ((unsigned)(q2 & 255) << 16) | ((unsigned)(q3 & 255) << 24); }
    }
}
__device__ __forceinline__ void p2_norm_rows(const float* __restrict__ x, const float* __restrict__ mod, bf16* __restrict__ h, signed char* __restrict__ hq, float* __restrict__ sa, int gw, int NGW, int lane) {
    f32x4 nx[16];
    if (gw < M) { const f32x4* xr = (const f32x4*)(x + (size_t)gw * DM) + lane;
#pragma unroll
        for (int j = 0; j < 16; ++j) nx[j] = __builtin_nontemporal_load(xr + 64 * j); }
    for (int m = gw; m < M; m += NGW) {
        f32x4 v[16]; float ss = 0.f;
#pragma unroll
        for (int j = 0; j < 16; ++j) { v[j] = nx[j]; ss += (v[j].x * v[j].x + v[j].y * v[j].y) + (v[j].z * v[j].z + v[j].w * v[j].w); }
        { const int mn = (m + NGW < M) ? m + NGW : m; const f32x4* xr = (const f32x4*)(x + (size_t)mn * DM) + lane;
#pragma unroll
            for (int j = 0; j < 16; ++j) nx[j] = __builtin_nontemporal_load(xr + 64 * j); }
        const float rstd = 1.0f / sqrtf(wave_sum(ss) * (1.0f / DM) + RMS_EPS);
        const int b = m >> 12;
        const f32x4* sh = (const f32x4*)(mod + (size_t)b * NMOD + 0 * DM) + lane; const f32x4* ga = (const f32x4*)(mod + (size_t)b * NMOD + 1 * DM) + lane;
        v2u* o8 = (v2u*)(h + (size_t)m * DM) + lane; float mx = 0.f;
#pragma unroll
        for (int j = 0; j < 16; ++j) { const f32x4 o = (v[j] * rstd) * ga[64 * j] + sh[64 * j]; o8[64 * j] = (v2u){pk_bf16(o.x, o.y), pk_bf16(o.z, o.w)}; v[j] = o;
            mx = fmaxf(mx, fmaxf(fmaxf(fabsf(o.x), fabsf(o.y)), fmaxf(fabsf(o.z), fabsf(o.w))));
            if ((j & 3) == 3) asm volatile("" ::: "memory"); }
#pragma unroll
        for (int o = 1; o < 64; o <<= 1) mx = fmaxf(mx, __shfl_xor(mx, o));
        const float inv = mx > 0.f ? 127.0f / mx : 0.f;
        if (lane == 0) sa[m] = mx * (1.0f / 127.0f);
        unsigned* o4 = (unsigned*)(hq + (size_t)m * DM) + lane;
#pragma unroll
        for (int j = 0; j < 16; ++j) { const int q0 = (int)__builtin_rintf(v[j].x * inv), q1 = (int)__builtin_rintf(v[j].y * inv), q2 = (int)__builtin_rintf(v[j].z * inv), q3 = (int)__builtin_rintf(v[j].w * inv);
            o4[64 * j] = (unsigned)(q0 & 255) | ((unsigned)(q1 & 255) << 8) | ((unsigned)(q2 & 255) << 16) | ((unsigned)(q3 & 255) << 24); }
    }
}
__device__ __forceinline__ void p7_mid_rows(const float* __restrict__ x, const bf16* __restrict__ y, const float* __restrict__ ssq, const float* __restrict__ mod, float* __restrict__ x1, signed char* __restrict__ h2q, float* __restrict__ sa, int gw, int NGW, int lane) {
    for (int m = gw; m < M; m += NGW) {
        const float rstd1 = 1.0f / sqrtf(wave_sum(ssq[(size_t)m * 64 + lane]) * (1.0f / DM) + RMS_EPS);
        const int b = m >> 12;
        const v2u* yr = (const v2u*)(y + (size_t)m * DM) + lane; const f32x4* xr = (const f32x4*)(x + (size_t)m * DM) + lane;
        const f32x4* gp = (const f32x4*)(mod + (size_t)b * NMOD + 2 * DM) + lane;
        f32x4* x1r = (f32x4*)(x1 + (size_t)m * DM) + lane;
        f32x4 v[16]; float ss = 0.f;
#pragma unroll
        for (int j = 0; j < 16; ++j) { const v2u yw = __builtin_nontemporal_load(yr + 64 * j); const f32x4 yv = {bf_lo(yw.x), bf_hi(yw.x), bf_lo(yw.y), bf_hi(yw.y)};
            v[j] = __builtin_nontemporal_load(xr + 64 * j) + (yv * rstd1) * gp[64 * j]; x1r[64 * j] = v[j];
            ss += (v[j].x * v[j].x + v[j].y * v[j].y) + (v[j].z * v[j].z + v[j].w * v[j].w);
            if ((j & 3) == 3) asm volatile("" ::: "memory"); }
        const float rstd2 = 1.0f / sqrtf(wave_sum(ss) * (1.0f / DM) + RMS_EPS);
        const f32x4* sh = (const f32x4*)(mod + (size_t)b * NMOD + 3 * DM) + lane; const f32x4* ga = (const f32x4*)(mod + (size_t)b * NMOD + 4 * DM) + lane;
        float mx = 0.f;
#pragma unroll
        for (int j = 0; j < 16; ++j) { v[j] = (v[j] * rstd2) * ga[64 * j] + sh[64 * j];
            mx = fmaxf(mx, fmaxf(fmaxf(fabsf(v[j].x), fabsf(v[j].y)), fmaxf(fabsf(v[j].z), fabsf(v[j].w))));
            if ((j & 3) == 3) asm volatile("" ::: "memory"); }
#pragma unroll
        for (int o = 1; o < 64; o <<= 1) mx = fmaxf(mx, __shfl_xor(mx, o));
        const float inv = mx > 0.f ? 127.0f / mx : 0.f;
        if (lane == 0) sa[m] = mx * (1.0f / 127.0f);
        unsigned* o4 = (unsigned*)(h2q + (size_t)m * DM) + lane;
#pragma unroll
        for (int j = 0; j < 16; ++j) { const int q0 = (int)__builtin_rintf(v[j].x * inv), q1 = (int)__builtin_rintf(v[j].y * inv), q2 = (int)__builtin_rintf(v[j].z * inv), q3 = (int)__builtin_rintf(v[j].w * inv);
            o4[64 * j] = (unsigned)(q0 & 255) | ((unsigned)(q1 & 255) << 8) | ((unsigned)(q2 & 255) << 16) | ((unsigned)(q3 & 255) << 24); }
    }
}
__device__ __forceinline__ void p10_final_rows(const bf16* __restrict__ f, const float* __restrict__ ssq, const float* __restrict__ mod, float* out, float* dst, int gw, int NGW, int lane) {
    v2u nf[16];
    if (gw < M) { const v2u* fr = (const v2u*)(f + (size_t)gw * DM) + lane;
#pragma unroll
        for (int j = 0; j < 16; ++j) nf[j] = __builtin_nontemporal_load(fr + 64 * j); }
    for (int m = gw; m < M; m += NGW) {
        const float rstd = 1.0f / sqrtf(wave_sum(ssq[(size_t)m * 64 + lane]) * (1.0f / DM) + RMS_EPS);
        const int b = m >> 12;
        const f32x4* gp = (const f32x4*)(mod + (size_t)b * NMOD + 5 * DM) + lane;
        const f32x4* orow = (const f32x4*)(out + (size_t)m * DM) + lane; f32x4* drow = (f32x4*)(dst + (size_t)m * DM) + lane;
        f32x4 v[16];
#pragma unroll
        for (int j = 0; j < 16; ++j) { const v2u fw = nf[j]; const f32x4 fv = {bf_lo(fw.x), bf_hi(fw.x), bf_lo(fw.y), bf_hi(fw.y)}; v[j] = orow[64 * j] + (fv * rstd) * gp[64 * j];
            if ((j & 3) == 3) asm volatile("" ::: "memory"); }
        { const size_t mn = (size_t)((m + NGW < M) ? m + NGW : m); const v2u* fr = (const v2u*)(f + mn * DM) + lane;
#pragma unroll
            for (int j = 0; j < 16; ++j) nf[j] = __builtin_nontemporal_load(fr + 64 * j); }
#pragma unroll
        for (int j = 0; j < 16; ++j) __builtin_nontemporal_store(v[j], drow + 64 * j);
    }
}

namespace att {
constexpr int KSTR = 272, VSTR = 520, K_OFF = 0, V_OFF = 256 * KSTR, END_OFF = V_OFF + 128 * VSTR;
static_assert(END_OFF <= LDSCTL_OFF, "attention LDS");
__device__ __forceinline__ void attn_unit(LAS unsigned char* lds, const bf16* __restrict__ Z, bf16* __restrict__ AO, const float* __restrict__ sinks, int unit, int tid) {
    const int b = unit >> 7, rem = unit & 127, n = rem >> 2, kvh = rem & 3;
    const int m0 = b * SEQ + n * 128;
#pragma unroll
    for (int it = 0; it < 8; ++it) { const int kk = (tid >> 4) + 32 * it, dc = tid & 15;
        v4u v = {0u, 0u, 0u, 0u};
        if (n > 0 || kk >= 128) v = *(const v4u*)(Z + (size_t)(m0 - 128 + kk) * INW + pg8::ZO_K + kvh * 128 + dc * 8);
        *(LAS v4u*)(lds + K_OFF + kk * KSTR + dc * 16) = v; }
#pragma unroll
    for (int it = 0; it < 8; ++it) { const int kk = tid & 255, dc = (tid >> 8) + 2 * it;
        v4u v = {0u, 0u, 0u, 0u};
        if (n > 0 || kk >= 128) v = *(const v4u*)(Z + (size_t)(m0 - 128 + kk) * INW + pg8::ZO_V + kvh * 128 + dc * 8);
        LAS unsigned char* vp = lds + V_OFF + (dc * 8) * VSTR + kk * 2;
        *(LAS unsigned short*)(vp + 0 * VSTR) = (unsigned short)(v.x & 0xffffu); *(LAS unsigned short*)(vp + 1 * VSTR) = (unsigned short)(v.x >> 16);
        *(LAS unsigned short*)(vp + 2 * VSTR) = (unsigned short)(v.y & 0xffffu); *(LAS unsigned short*)(vp + 3 * VSTR) = (unsigned short)(v.y >> 16);
        *(LAS unsigned short*)(vp + 4 * VSTR) = (unsigned short)(v.z & 0xffffu); *(LAS unsigned short*)(vp + 5 * VSTR) = (unsigned short)(v.z >> 16);
        *(LAS unsigned short*)(vp + 6 * VSTR) = (unsigned short)(v.w & 0xffffu); *(LAS unsigned short*)(vp + 7 * VSTR) = (unsigned short)(v.w >> 16); }
    __syncthreads();
    const int wid = tid >> 6, lane = tid & 63, r = lane & 31, h = lane >> 5;
    const int hf = wid & 1, head = kvh * 4 + (wid >> 1);
    const float sink = sinks[head];
    constexpr float SCALE = 0.08838834764831845f, LOG2E = 1.4426950408889634f;
#pragma unroll 1
    for (int qt = 0; qt < 2; ++qt) {
        const int ql0 = hf * 64 + qt * 32;
        const size_t mq = (size_t)(m0 + ql0 + r);
        bf16x8 qf[8];
#pragma unroll
        for (int ks = 0; ks < 8; ++ks) qf[ks] = *(const bf16x8*)(Z + mq * INW + pg8::ZO_Q + head * 128 + ks * 16 + 8 * h);
        f32x16 S[5];
#pragma unroll
        for (int kt = 0; kt < 5; ++kt) {
#pragma unroll
            for (int i = 0; i < 16; ++i) S[kt][i] = 0.f;
#pragma unroll
            for (int ks = 0; ks < 8; ++ks) { const bf16x8 kf = *(const LAS bf16x8*)(lds + K_OFF + (ql0 + 32 * kt + r) * KSTR + (ks * 16 + 8 * h) * 2);
                S[kt] = __builtin_amdgcn_mfma_f32_32x32x16_bf16(kf, qf[ks], S[kt], 0, 0, 0); } }
        float mx = sink;
#pragma unroll
        for (int kt = 0; kt < 5; ++kt)
#pragma unroll
            for (int i = 0; i < 16; ++i) { const int cr = (i & 3) + 8 * (i >> 2) + 4 * h;
                const int diff = 128 + r - 32 * kt - cr;
                const bool valid = ((unsigned)diff < 128u) && (n > 0 || (ql0 + 32 * kt + cr) >= 128);
                const float s = valid ? S[kt][i] * SCALE : -__builtin_inff();
                S[kt][i] = s; mx = fmaxf(mx, s); }
        mx = fmaxf(mx, __shfl_xor(mx, 32));
        float sum = 0.f;
#pragma unroll
        for (int kt = 0; kt < 5; ++kt)
#pragma unroll
            for (int i = 0; i < 16; ++i) { const float p = __builtin_amdgcn_exp2f((S[kt][i] - mx) * LOG2E); S[kt][i] = p; sum += p; }
        sum += __shfl_xor(sum, 32);
        const float inv = 1.0f / (sum + __builtin_amdgcn_exp2f((sink - mx) * LOG2E));
        f32x16 O[4];
#pragma unroll
        for (int dt = 0; dt < 4; ++dt)
#pragma unroll
            for (int i = 0; i < 16; ++i) O[dt][i] = 0.f;
#pragma unroll
        for (int kt = 0; kt < 5; ++kt)
#pragma unroll
            for (int s = 0; s < 2; ++s) {
                v4u pw; pw.x = pk_bf16(S[kt][8 * s + 0], S[kt][8 * s + 1]); pw.y = pk_bf16(S[kt][8 * s + 2], S[kt][8 * s + 3]);
                pw.z = pk_bf16(S[kt][8 * s + 4], S[kt][8 * s + 5]); pw.w = pk_bf16(S[kt][8 * s + 6], S[kt][8 * s + 7]);
                const bf16x8 pf = __builtin_bit_cast(bf16x8, pw);
#pragma unroll
                for (int dt = 0; dt < 4; ++dt) { const LAS unsigned char* vp = lds + V_OFF + (dt * 32 + r) * VSTR + (ql0 + 32 * kt + 16 * s + 4 * h) * 2;
                    const s16x4 lo = *(const LAS s16x4*)vp, hi = *(const LAS s16x4*)(vp + 16);
                    const bf16x8 vf = __builtin_shufflevector(lo, hi, 0, 1, 2, 3, 4, 5, 6, 7);
                    O[dt] = __builtin_amdgcn_mfma_f32_32x32x16_bf16(vf, pf, O[dt], 0, 0, 0); } }
        bf16* op = AO + mq * 4096 + 2048 + head * 128 + 4 * h;
#pragma unroll
        for (int dt = 0; dt < 4; ++dt)
#pragma unroll
            for (int gq = 0; gq < 4; ++gq)
                *(v2u*)(op + dt * 32 + 8 * gq) = (v2u){pk_bf16(O[dt][4 * gq] * inv, O[dt][4 * gq + 1] * inv), pk_bf16(O[dt][4 * gq + 2] * inv, O[dt][4 * gq + 3] * inv)};
    }
    __syncthreads();
}
}

namespace sgu {
constexpr int VN_STR = 272, IMG = 128 * VN_STR, NU = 4, STAT_OFF = NU * IMG;
static_assert(STAT_OFF + 1024 <= LDSCTL_OFF, "sgu LDS");
__device__ __forceinline__ void sgu_batch(LAS unsigned char* lds, const bf16* __restrict__ Z, const float* __restrict__ svstat, const float* __restrict__ ln_g, const float* __restrict__ ln_b,
                                          const bf16* __restrict__ Wb, const float* __restrict__ bs, bf16* __restrict__ SO, int chunk, int g0, int tid) {
    const int m0 = chunk * 128;
    LAS float* st = (LAS float*)(lds + STAT_OFF);
    const int s = tid & 127, cq = tid >> 7;
    v4u sv[NU][4];
#pragma unroll
    for (int u = 0; u < NU; ++u)
#pragma unroll
        for (int it = 0; it < 4; ++it) sv[u][it] = *(const v4u*)(Z + (size_t)(m0 + s) * INW + pg8::ZO_SV + (g0 + u) * 128 + (cq + 4 * it) * 8);
    {
        const int row = tid >> 2, q = tid & 3; const f32x4* p = (const f32x4*)(svstat + (size_t)(m0 + row) * 64) + 4 * q; float s1 = 0.f, s2 = 0.f;
#pragma unroll
        for (int i = 0; i < 4; ++i) { const f32x4 v = p[i]; s1 += v.x + v.z; s2 += v.y + v.w; }
        s1 += __shfl_xor(s1, 1); s2 += __shfl_xor(s2, 1); s1 += __shfl_xor(s1, 2); s2 += __shfl_xor(s2, 2);
        const float mu = s1 * (1.0f / 2048.0f), var = fmaxf(s2 * (1.0f / 2048.0f) - mu * mu, 0.f);
        if (q == 0) { st[row] = mu; st[128 + row] = 1.0f / sqrtf(var + LN_EPS); }
    }
    __syncthreads();
    const float mu = st[s], rs = st[128 + s];
#pragma unroll
    for (int u = 0; u < NU; ++u)
#pragma unroll
        for (int it = 0; it < 4; ++it) { const int cc = cq + 4 * it; const v4u v = sv[u][it];
            const float* gp = ln_g + (g0 + u) * 128 + cc * 8; const float* bp = ln_b + (g0 + u) * 128 + cc * 8;
            LAS unsigned char* vp = lds + u * IMG + (cc * 8) * VN_STR + s * 2;
            const float x0 = bf_lo(v.x), x1 = bf_hi(v.x), x2 = bf_lo(v.y), x3 = bf_hi(v.y), x4 = bf_lo(v.z), x5 = bf_hi(v.z), x6 = bf_lo(v.w), x7 = bf_hi(v.w);
            *(LAS unsigned short*)(vp + 0 * VN_STR) = (unsigned short)(pk_bf16((x0 - mu) * rs * gp[0] + bp[0], 0.f) & 0xffffu);
            *(LAS unsigned short*)(vp + 1 * VN_STR) = (unsigned short)(pk_bf16((x1 - mu) * rs * gp[1] + bp[1], 0.f) & 0xffffu);
            *(LAS unsigned short*)(vp + 2 * VN_STR) = (unsigned short)(pk_bf16((x2 - mu) * rs * gp[2] + bp[2], 0.f) & 0xffffu);
            *(LAS unsigned short*)(vp + 3 * VN_STR) = (unsigned short)(pk_bf16((x3 - mu) * rs * gp[3] + bp[3], 0.f) & 0xffffu);
            *(LAS unsigned short*)(vp + 4 * VN_STR) = (unsigned short)(pk_bf16((x4 - mu) * rs * gp[4] + bp[4], 0.f) & 0xffffu);
            *(LAS unsigned short*)(vp + 5 * VN_STR) = (unsigned short)(pk_bf16((x5 - mu) * rs * gp[5] + bp[5], 0.f) & 0xffffu);
            *(LAS unsigned short*)(vp + 6 * VN_STR) = (unsigned short)(pk_bf16((x6 - mu) * rs * gp[6] + bp[6], 0.f) & 0xffffu);
            *(LAS unsigned short*)(vp + 7 * VN_STR) = (unsigned short)(pk_bf16((x7 - mu) * rs * gp[7] + bp[7], 0.f) & 0xffffu); }
    __syncthreads();
    const int wid = tid >> 6, lane = tid & 63, i = lane & 15, quad = lane >> 4, tb = 16 * wid;
    const int t = tb + i; const size_t row = (size_t)(m0 + t);
#pragma unroll 1
    for (int u = 0; u < NU; ++u) { const int g = g0 + u;
        v2u sw[8];
#pragma unroll
        for (int ct = 0; ct < 8; ++ct) sw[ct] = *(const v2u*)(Z + row * INW + pg8::ZO_SU + g * 128 + ct * 16 + quad * 4);
        const float bias = bs[g * 128 + t];
        f32x4 acc[8];
#pragma unroll
        for (int ct = 0; ct < 8; ++ct) acc[ct] = (f32x4){0.f, 0.f, 0.f, 0.f};
#pragma unroll
        for (int ks = 0; ks < 4; ++ks) {
            if (32 * ks <= tb + 15) {
                const bf16x8 wf = *(const bf16x8*)(Wb + (size_t)(g * 128 + tb + i) * 128 + ks * 32 + quad * 8);
#pragma unroll
                for (int ct = 0; ct < 8; ++ct) { const bf16x8 vf = *(const LAS bf16x8*)(lds + u * IMG + (ct * 16 + i) * VN_STR + (ks * 32 + quad * 8) * 2);
                    acc[ct] = __builtin_amdgcn_mfma_f32_16x16x32_bf16(vf, wf, acc[ct], 0, 0, 0); } } }
#pragma unroll
        for (int ct = 0; ct < 8; ++ct) { const int c = g * 128 + ct * 16 + quad * 4;
            const float o0 = bf_lo(sw[ct].x) * (acc[ct][0] + bias), o1 = bf_hi(sw[ct].x) * (acc[ct][1] + bias), o2 = bf_lo(sw[ct].y) * (acc[ct][2] + bias), o3 = bf_hi(sw[ct].y) * (acc[ct][3] + bias);
            *(v2u*)(SO + row * 4096 + c) = (v2u){pk_bf16(o0, o1), pk_bf16(o2, o3)}; }
    }
    __syncthreads();
}
}

#ifndef MK_N_LAUNCHES
#define MK_N_LAUNCHES 1
#endif
constexpr int N_PHASES = 11, N_LAUNCHES = MK_N_LAUNCHES;
struct Args { const void* in[21]; float* out; unsigned char* ws; int ph_lo, ph_hi; };
static_assert(sizeof(Args) == 21 * 8 + 8 + 8 + 8, "Args has no holes");

typedef const __attribute__((address_space(4))) unsigned char* kargp_t;
#define KP_REFRESH() kargp_t kp = C.kbase; asm volatile("" : "+s"(kp))
#define KIN(T, i) (*(T* const __attribute__((address_space(4)))*)(kp + 8 * (i)))
#define KOUT() (*(float* const __attribute__((address_space(4)))*)(kp + 8 * 21))
#define KWS() (*(unsigned char* const __attribute__((address_space(4)))*)(kp + 8 * 22))
struct Ctx { kargp_t kbase; LAS unsigned char* lds; int wave, G, bx, gw, NGW; };
#define TID_HERE() int lane_; asm volatile("v_mbcnt_lo_u32_b32 %0, -1, 0\n\tv_mbcnt_hi_u32_b32 %0, -1, %0" : "=v"(lane_)); const int tid_ = C.wave * 64 + lane_
__device__ __forceinline__ void phase0(const Ctx& C) { KP_REFRESH(); unsigned char* ws = KWS();
    P0Args A; A.c = KIN(const float, 1); A.w_ada = KIN(const float, 3); A.w_in = KIN(const float, 6); A.sgu_w = KIN(const float, 10); A.w_ps = KIN(const float, 12); A.w_pa = KIN(const float, 13);
    A.w_out = KIN(const float, 14); A.w_gate = KIN(const float, 17); A.w_up = KIN(const float, 18); A.w_down = KIN(const float, 19); A.positions = KIN(const int, 2);
    A.modp = (float*)(ws + WS_MODP); A.ropeC = (float*)(ws + WS_ROPEC); A.ropeS = (float*)(ws + WS_ROPES); A.sguw = (bf16*)(ws + WS_SGUW);
    A.win_t = (bf16*)(ws + WS_WIN); A.wps_t = (bf16*)(ws + WS_WPS); A.wpa_t = (bf16*)(ws + WS_WPA); A.wout_t = (bf16*)(ws + WS_WOUT); A.wgu_t = (bf16*)(ws + WS_WGU); A.wdn_t = (bf16*)(ws + WS_WDN);
    TID_HERE(); (void)tid_; p0_prologue(A, C.lds, C.gw, C.NGW, C.wave, lane_); }
__device__ __forceinline__ void phase1(const Ctx& C) { KP_REFRESH(); unsigned char* ws = KWS(); TID_HERE();
    p1_mod_reduce((const float*)(ws + WS_MODP), KIN(const float, 4), KIN(const float, 5), KIN(const float, 15), KIN(const float, 16), KIN(const float, 20), (float*)(ws + WS_MOD), C.bx * (NWAVES * 64) + tid_, C.G * NWAVES * 64);
    p1_quant_wrows((const bf16*)(ws + WS_WGU), (signed char*)(ws + WS_WQ), (float*)(ws + WS_SBW), NGU, C.gw, C.NGW, lane_);
    p1_quant_wrows((const bf16*)(ws + WS_WIN) + (size_t)7168 * DM, (signed char*)(ws + WS_WQIN + (size_t)2048 * DM), (float*)(ws + WS_SBWIN) + 2048, 8192, C.gw, C.NGW, lane_);
    p1_quant_wdown_h32((const bf16*)(ws + WS_WDN), (signed char*)(ws + WS_WDQ), (float*)(ws + WS_SBWD), C.gw, C.NGW, lane_); }
__device__ __forceinline__ void phase2(const Ctx& C) { KP_REFRESH(); unsigned char* ws = KWS(); TID_HERE(); (void)tid_; p2_norm_rows(KIN(const float, 0), (const float*)(ws + WS_MOD), (bf16*)(ws + WS_A), (signed char*)(ws + WS_HQ), (float*)(ws + WS_SA1), C.gw, C.NGW, lane_); }
__device__ __forceinline__ void phase3(const Ctx& C) {
    { KP_REFRESH(); unsigned char* ws = KWS();
      pg8::Gemm g{(const bf16*)(ws + WS_A), (const bf16*)(ws + WS_WIN), M, 7168, DM}; pg8::StaticOrder S; S.init(M, 7168, C.G, C.bx);
      pg8::EpiZ E{(bf16*)(ws + WS_Z), (const float*)(ws + WS_ROPEC), (const float*)(ws + WS_ROPES), (float*)(ws + WS_SVSTAT)};
      TID_HERE(); pg8::gemm_phase<pg8::EpiZ, pg8::StaticOrder, true, true>(C.lds, g, S, E, tid_); }
    { KP_REFRESH(); unsigned char* ws = KWS();
      pg8::Gemm g{(const bf16*)(ws + WS_HQ), (const bf16*)(ws + WS_WQIN + (size_t)2048 * DM), M, 8192, DM / 2}; pg8::StaticOrder S; S.init(M, 8192, C.G, C.bx);
      pg8::EpiGateI8 E{(bf16*)(ws + WS_Z), (const float*)(ws + WS_SA1), (const float*)(ws + WS_SBWIN) + 2048};
      TID_HERE(); pg8::gemm_phase<pg8::EpiGateI8, pg8::StaticOrder, true, true, true>(C.lds, g, S, E, tid_); } }
__device__ __forceinline__ void phase4(const Ctx& C) { KP_REFRESH(); unsigned char* ws = KWS(); TID_HERE();
    { const bf16* Zb = (const bf16*)(ws + WS_Z); bf16* AO = (bf16*)(ws + WS_B); const float* sinks = KIN(const float, 7);
      for (int u = C.bx; u < 512; u += C.G) att::attn_unit(C.lds, Zb, AO, sinks, u, tid_); }
    { const bf16* Zb = (const bf16*)(ws + WS_Z); bf16* SO = (bf16*)(ws + WS_B);
      const float* svstat = (const float*)(ws + WS_SVSTAT); const float* ln_g = KIN(const float, 8); const float* ln_b = KIN(const float, 9); const float* sb = KIN(const float, 11); const bf16* sguw = (const bf16*)(ws + WS_SGUW);
      for (int bt = C.bx; bt < 512; bt += C.G) sgu::sgu_batch(C.lds, Zb, svstat, ln_g, ln_b, sguw, sb, SO, bt >> 2, 4 * (bt & 3), tid_); } }
__device__ __forceinline__ void phase5(const Ctx& C) { KP_REFRESH(); unsigned char* ws = KWS();
    pg8::Gemm g{(const bf16*)(ws + WS_B), (const bf16*)(ws + WS_WPS), M, DM, DM}; pg8::StaticOrder S; S.init(M, DM, C.G, C.bx); pg8::EpiMerge E{(bf16*)(ws + WS_A), (const bf16*)(ws + WS_Z)};
    TID_HERE(); pg8::gemm_phase<pg8::EpiMerge, pg8::StaticOrder, true, true>(C.lds, g, S, E, tid_); }
__device__ __forceinline__ void phase6(const Ctx& C) { KP_REFRESH(); unsigned char* ws = KWS();
    pg8::Gemm g{(const bf16*)(ws + WS_A), (const bf16*)(ws + WS_WOUT), M, DM, DM}; pg8::StaticOrder S; S.init(M, DM, C.G, C.bx); pg8::EpiStats E{(bf16*)(ws + WS_B), (float*)(ws + WS_SSQ)};
    TID_HERE(); pg8::gemm_phase<pg8::EpiStats, pg8::StaticOrder, true, true>(C.lds, g, S, E, tid_); }
__device__ __forceinline__ void phase7(const Ctx& C) { KP_REFRESH(); unsigned char* ws = KWS(); TID_HERE(); (void)tid_;
    p7_mid_rows(KIN(const float, 0), (const bf16*)(ws + WS_B), (const float*)(ws + WS_SSQ), (const float*)(ws + WS_MOD), KOUT(), (signed char*)(ws + WS_A), (float*)(ws + WS_SA), C.gw, C.NGW, lane_); }
__device__ __forceinline__ void phase8(const Ctx& C) { KP_REFRESH(); unsigned char* ws = KWS();
    pg8::Gemm g{(const bf16*)(ws + WS_A), (const bf16*)(ws + WS_WQ), M, NGU, DM / 2}; pg8::StaticOrder S; S.init(M, NGU, C.G, C.bx);
    pg8::EpiSwiGLU_I8 E{(bf16*)(ws + WS_Z), (const float*)(ws + WS_SA), (const float*)(ws + WS_SBW)};
    TID_HERE(); pg8::gemm_phase<pg8::EpiSwiGLU_I8, pg8::StaticOrder, true, true, true>(C.lds, g, S, E, tid_); }
__device__ __forceinline__ void phase8b(const Ctx& C) { KP_REFRESH(); unsigned char* ws = KWS(); TID_HERE(); (void)tid_;
    p8b_quant_hid_rows((const bf16*)(ws + WS_Z), (signed char*)(ws + WS_HIDQ), (float*)(ws + WS_SA), C.gw, C.NGW, lane_); }
#ifndef PROBE_DELAY
#define PROBE_DELAY 0
#endif
__device__ __forceinline__ void phase9(const Ctx& C, unsigned long long& dcyc, unsigned long long& dreal) { KP_REFRESH(); unsigned char* ws = KWS();
    pg8::Gemm g{(const bf16*)(ws + WS_HIDQ), (const bf16*)(ws + WS_WDQ), M, DM, FF / 2}; pg8::StaticOrder S; S.init(M, DM, C.G, C.bx);
    pg8::EpiStatsI8 E{(bf16*)(ws + WS_Z), (float*)(ws + WS_SSQ), (const float*)(ws + WS_SA), (const float*)(ws + WS_SBWD)};
    const unsigned long long t0 = PROBE_DELAY ? __builtin_amdgcn_s_memtime() : 0ull, r0 = PROBE_DELAY ? __builtin_amdgcn_s_memrealtime() : 0ull;
    TID_HERE(); pg8::gemm_phase<pg8::EpiStatsI8, pg8::StaticOrder, true, true, true>(C.lds, g, S, E, tid_);
    if (PROBE_DELAY) { dcyc = __builtin_amdgcn_s_memtime() - t0; dreal = __builtin_amdgcn_s_memrealtime() - r0; } }
__device__ __forceinline__ void phase10(const Ctx& C) { KP_REFRESH(); unsigned char* ws = KWS(); TID_HERE(); (void)tid_;
    p10_final_rows((const bf16*)(ws + WS_Z), (const float*)(ws + WS_SSQ), (const float*)(ws + WS_MOD), KOUT(), KOUT(), C.gw, C.NGW, lane_); }
__device__ __forceinline__ void phase10_dry(const Ctx& C) { KP_REFRESH(); unsigned char* ws = KWS(); TID_HERE(); (void)tid_;
    p10_final_rows((const bf16*)(ws + WS_Z), (const float*)(ws + WS_SSQ), (const float*)(ws + WS_MOD), KOUT(), (float*)(ws + WS_Z) + (size_t)M * DM, C.gw, C.NGW, lane_); }
#ifndef PROBE_EXTRA
#define PROBE_EXTRA 0
#endif

#ifndef PROBE_REPEAT_MASK
#define PROBE_REPEAT_MASK 0u
#endif
__global__ void __launch_bounds__(NWAVES * 64, 2) fwd(Args args) {
    extern __shared__ __attribute__((aligned(16))) unsigned char lds_raw[];
    Ctx C; C.lds = (LAS unsigned char*)lds_raw; C.kbase = (kargp_t)__builtin_amdgcn_kernarg_segment_ptr();
    const int tid0 = threadIdx.x; C.wave = __builtin_amdgcn_readfirstlane(tid0 >> 6);
    C.G = gridDim.x; C.bx = blockIdx.x;
    const int vcu = (C.G % 8 == 0) ? (C.bx % 8) * (C.G / 8) + C.bx / 8 : C.bx;
    C.gw = vcu * NWAVES + C.wave; C.NGW = C.G * NWAVES;
    const unsigned long long rt_start = PROBE_DELAY ? __builtin_amdgcn_s_memrealtime() : 0ull; unsigned long long rt_p0 = 0ull;
    for (int u = tid0; u < (LDS_BYTES - LDSCTL_OFF) / 4; u += NWAVES * 64) ((LAS unsigned*)(C.lds + LDSCTL_OFF))[u] = 0u;
    __syncthreads();
    XcdBarrier bar; bar.bar = (unsigned*)(args.ws + WS_CTL) + CW_BAR; bar.x = 0; bar.st = nullptr;
    if (N_LAUNCHES == 1) bar = xcd_barrier_post((unsigned*)(args.ws + WS_CTL) + CW_BAR, (volatile LAS unsigned*)(C.lds + LDSCTL_OFF));
    const int lo = (N_LAUNCHES == 1) ? 0 : args.ph_lo, hi = (N_LAUNCHES == 1) ? N_PHASES : args.ph_hi;
#define IN(k) (lo <= (k) && (k) < hi)
#define RUN(k, call) do { if (IN(k)) { call; if (N_LAUNCHES == 1 && ((PROBE_REPEAT_MASK >> (k)) & 1u)) { xcd_barrier(bar); call; } } if (IN(k) && IN((k) + 1)) xcd_barrier(bar); } while (0)
#define STAMP(k) do { if (PROBE_DELAY == 10 + (k)) rt_p0 = __builtin_amdgcn_s_memrealtime() - rt_start; } while (0)
    RUN(0, phase0(C)); if (PROBE_DELAY == 4) rt_p0 = __builtin_amdgcn_s_memrealtime() - rt_start; STAMP(0);
    RUN(1, phase1(C)); STAMP(1); RUN(2, phase2(C)); STAMP(2); RUN(3, phase3(C)); STAMP(3); RUN(4, phase4(C)); STAMP(4); RUN(5, phase5(C)); STAMP(5);
    RUN(6, phase6(C)); STAMP(6); RUN(7, phase7(C)); STAMP(7);
    if (PROBE_EXTRA == 3) { const unsigned long long r0 = __builtin_amdgcn_s_memrealtime(); while (__builtin_amdgcn_s_memrealtime() - r0 < 40000ull) __builtin_amdgcn_s_sleep(32); }
    RUN(8, phase8(C)); STAMP(8); if (N_LAUNCHES == 1) { phase8b(C); xcd_barrier(bar); } unsigned long long dcyc = 0, dreal = 1; RUN(9, phase9(C, dcyc, dreal)); STAMP(9);
    if (PROBE_EXTRA == 1) { phase10_dry(C); xcd_barrier(bar); }
    if (PROBE_EXTRA == 2) { for (int i = 0; i < 10; ++i) xcd_barrier(bar); }
    RUN(10, phase10(C));
    if (PROBE_DELAY) {
        const unsigned long long r0 = __builtin_amdgcn_s_memrealtime();
        const unsigned long long ticks = (PROBE_DELAY == 1) ? (dcyc / 688ull) * 100ull : (PROBE_DELAY == 2) ? ((dcyc * 100ull) / dreal) * 100ull : (PROBE_DELAY == 3) ? (r0 - rt_start) : rt_p0;
        while (__builtin_amdgcn_s_memrealtime() - r0 < ticks && __builtin_amdgcn_s_memrealtime() - r0 < 2000000ull) __builtin_amdgcn_s_sleep(32);
    }
#undef IN
#undef RUN
}

extern "C" void kernel_launch(void* const* d_in, const int* in_sizes, int n_in, void* d_out, int out_size, void* d_ws, size_t ws_size, hipStream_t stream) {
    static int grid = 0;
    if (grid == 0) {
        if (n_in != 21 || in_sizes[0] != M * DM || out_size != M * DM || ws_size < WS_END) {
            fprintf(stderr, "kernel_launch: built for 21 inputs, x/out of %d floats, >= %zu bytes of workspace; got n_in %d, in0 %d, out %d, ws %zu; nothing launched\n", M * DM, (size_t)WS_END, n_in, n_in > 0 ? in_sizes[0] : -1, out_size, ws_size);
            grid = -1; return; }
        int dev = 0, cus = 0, per_cu = 0;
        if (hipGetDevice(&dev) != hipSuccess || hipDeviceGetAttribute(&cus, hipDeviceAttributeMultiprocessorCount, dev) != hipSuccess) { fprintf(stderr, "kernel_launch: device query failed\n"); grid = -1; return; }
        if (hipFuncSetAttribute((const void*)fwd, hipFuncAttributeMaxDynamicSharedMemorySize, LDS_BYTES) != hipSuccess) { fprintf(stderr, "kernel_launch: hipFuncSetAttribute failed\n"); grid = -1; return; }
        if (hipOccupancyMaxActiveBlocksPerMultiprocessor(&per_cu, (const void*)fwd, NWAVES * 64, LDS_BYTES) != hipSuccess || per_cu < 1)
            fprintf(stderr, "kernel_launch: note: occupancy query reports %d workgroups per CU\n", per_cu);
        (void)hipGetLastError();
        grid = cus;
    }
    if (grid < 0) return;
    if (hipMemsetAsync((char*)d_ws + WS_CTL, 0, CTL_ZERO_BYTES, stream) != hipSuccess) { fprintf(stderr, "kernel_launch: hipMemsetAsync failed\n"); return; }
    Args a{};
    for (int i = 0; i < 21; ++i) a.in[i] = d_in[i];
    a.out = (float*)d_out; a.ws = (unsigned char*)d_ws;
    if (N_LAUNCHES == 1) {
        a.ph_lo = 0; a.ph_hi = N_PHASES;
        hipLaunchKernelGGL(fwd, dim3(grid), dim3(NWAVES * 64), LDS_BYTES, stream, a);
    } else {
        for (int li = 0; li < N_PHASES; ++li) { a.ph_lo = li; a.ph_hi = li + 1; hipLaunchKernelGGL(fwd, dim3(grid), dim3(NWAVES * 64), LDS_BYTES, stream, a); }
    }
    const hipError_t le = hipPeekAtLastError();
    if (le != hipSuccess) fprintf(stderr, "kernel_launch: launch failed: %s (grid %d)\n", hipGetErrorName(le), grid);
}
```

```cpp
#include <hip/hip_runtime.h>
#include <cstdio>
#include <cstdint>
namespace pg8 {
#define PG8_LAS __attribute__((address_space(3)))
typedef unsigned short bf16_t;
typedef short bf16x8 __attribute__((ext_vector_type(8)));
typedef float f32x4 __attribute__((ext_vector_type(4)));
typedef unsigned u32x4 __attribute__((ext_vector_type(4)));
typedef unsigned u32x2 __attribute__((ext_vector_type(2)));
typedef int i32x4 __attribute__((ext_vector_type(4)));
constexpr int BM = 256, BK = 64, HALF = 128, HTB = HALF * BK * 2  , STAGE_BYTES = 8 * HTB, NXCD = 8, WGM = 8;

__host__ __device__ __forceinline__ int lds_byte(int r, int c) { const int st = (r >> 4) * 2 + (c >> 5), rr = r & 15, cc = c & 31, ob = rr * 64 + cc * 2; return st * 1024 + (ob ^ (((ob >> 9) & 1) << 5)); }
__host__ __device__ __forceinline__ void stage_rc(int b, int& R, int& C) { const int st = b / 1024, sb = b % 1024, swz = sb ^ (((sb >> 9) & 1) << 5); R = (st >> 1) * 16 + swz / 64; C = (st & 1) * 32 + (swz % 64) / 2; }
__host__ __device__ __forceinline__ int perm32(int rho) { const int n = rho >> 4, i = rho & 15; return 8 * (i >> 2) + 4 * n + (i & 3); }

struct Unit { int pm, pn; };
struct Gemm { const bf16_t* A; const bf16_t* Bt; int M, N, K; };

struct StaticOrder {
    int nM, nN, nwg, G, c;
    __host__ __device__ void init(int M, int N, int G_, int c_) { nM = M / BM; nN = N / BM; nwg = nM * nN; G = G_; c = c_; }
    __host__ __device__ bool next(int i, Unit& u) const {
        const long L = (long)i * G + c; if (L >= nwg) return false;
        int wgid = (int)L; { const int q = nwg / NXCD, r = nwg % NXCD, xcd = wgid % NXCD, off = wgid / NXCD; wgid = (xcd < r ? xcd * (q + 1) : r * (q + 1) + (xcd - r) * q) + off; }
        const int nig = WGM * nN, gid = wgid / nig, fm = gid * WGM, gsz = (nM - fm) < WGM ? (nM - fm) : WGM;
        u.pm = fm + ((wgid % nig) % gsz); u.pn = (wgid % nig) / gsz; return true;
    }
    __device__ __forceinline__ void a_ready(const Unit&) const {}
    __device__ __forceinline__ void done(const Unit&) const {}
};

__device__ __forceinline__ unsigned cvt_pk_bf16(float lo, float hi) { unsigned r; asm volatile("v_cvt_pk_bf16_f32 %0, %1, %2" : "=v"(r) : "v"(lo), "v"(hi)); return r; }
typedef float f32x2 __attribute__((ext_vector_type(2)));
__device__ __forceinline__ f32x2 gelu_pk(f32x2 v) {
    const f32x2 av = __builtin_elementwise_abs(v), d = av * 0.2316418882f + 1.0f;
    f32x2 t; t.x = __builtin_amdgcn_rcpf(d.x); t.y = __builtin_amdgcn_rcpf(d.y);
    f32x2 q = t * 0.5307027145f + (-0.7265760135f); q = q * t + 0.7107068705f; q = q * t + (-0.142248368f); q = q * t + 0.127414796f; q = q * t;
    const f32x2 s = (v * v) * (-0.72134752044f);
    f32x2 e; e.x = __builtin_amdgcn_exp2f(s.x); e.y = __builtin_amdgcn_exp2f(s.y);
    const f32x2 m = v * (q * e), r = v - m;
    f32x2 o; o.x = v.x < 0.f ? m.x : r.x; o.y = v.y < 0.f ? m.y : r.y; return o;
}

typedef float f32x2t __attribute__((ext_vector_type(2)));
typedef __bf16 bf16x2t __attribute__((ext_vector_type(2)));
__device__ __forceinline__ unsigned pk_bf16(float lo, float hi) { f32x2t v = {lo, hi}; bf16x2t b = __builtin_convertvector(v, bf16x2t); return __builtin_bit_cast(unsigned, b); }
__device__ __forceinline__ float bf_lo(unsigned w) { return __builtin_bit_cast(float, w << 16); }
__device__ __forceinline__ float bf_hi(unsigned w) { return __builtin_bit_cast(float, w & 0xffff0000u); }
__device__ __forceinline__ float sigmoid_f(float x) { return __builtin_amdgcn_rcpf(1.0f + __builtin_amdgcn_exp2f(-1.4426950408889634f * x)); }
__device__ __forceinline__ u32x4 pack8(const f32x4& a, const f32x4& b) { u32x4 w; w.x = pk_bf16(a[0], a[1]); w.y = pk_bf16(a[2], a[3]); w.z = pk_bf16(b[0], b[1]); w.w = pk_bf16(b[2], b[3]); return w; }
__device__ __forceinline__ void unpack8(const u32x4& w, f32x4& a, f32x4& b) { a = (f32x4){bf_lo(w.x), bf_hi(w.x), bf_lo(w.y), bf_hi(w.y)}; b = (f32x4){bf_lo(w.z), bf_hi(w.z), bf_lo(w.w), bf_hi(w.w)}; }

constexpr int Z_LD = 15360, ZO_Q = 0, ZO_K = 2048, ZO_V = 2560, ZO_SU = 3072, ZO_SV = 5120, ZO_GA = 7168, ZO_GB = 11264;

struct EpiZ {
    static constexpr bool PERM = true, AFTER_DRAIN = false, HAS_MID = false;
    bf16_t* Z; const float* ropeC; const float* ropeS; float* svstat;
    __device__ __forceinline__ void operator()(const f32x4 (&acc)[2][2][4][2], const Unit& u, int wr, int wc, int fr, int fq) const {
        const int pn = u.pn;
        const int mode = pn < 10 ? 0 : (pn < 12 ? 1 : (pn < 20 ? 2 : (pn < 28 ? 3 : 4)));
        const int row0 = u.pm * BM + wr * 64 + fr, col0 = pn * BM + wc * 32 + 8 * fq;
        const bool rot = (mode == 0) && (wc == 0);
        const float sgn = fq < 2 ? -1.0f : 1.0f;
#pragma unroll
        for (int aim = 0; aim < 4; ++aim) { const int ai = aim >> 1;
            f32x4 cs[4][4];
            if (rot) {
#pragma unroll
                for (int m = 2 * (aim & 1); m < 2 * (aim & 1) + 2; ++m) { const size_t ro = (size_t)(row0 + ai * HALF + m * 16) * 16 + 8 * (fq & 1);
                    cs[m][0] = *(const f32x4*)(ropeC + ro); cs[m][1] = *(const f32x4*)(ropeC + ro + 4); cs[m][2] = *(const f32x4*)(ropeS + ro); cs[m][3] = *(const f32x4*)(ropeS + ro + 4); }
                asm volatile("" ::: "memory");
            }
#pragma unroll
            for (int m = 2 * (aim & 1); m < 2 * (aim & 1) + 2; ++m) {
                const int row = row0 + ai * HALF + m * 16;
                bf16_t* rowp = Z + (size_t)row * Z_LD + col0;
                f32x4 c0 = {1.f, 1.f, 1.f, 1.f}, c1 = c0, s0 = {0.f, 0.f, 0.f, 0.f}, s1 = s0;
                if (rot) { c0 = cs[m][0]; c1 = cs[m][1]; s0 = cs[m][2]; s1 = cs[m][3]; }
                float t1 = 0.f, t2 = 0.f;
#pragma unroll
                for (int bj = 0; bj < 2; ++bj) {
                    f32x4 v0 = acc[ai][bj][m][0], v1 = acc[ai][bj][m][1];
                    if (rot) {
                        f32x4 o0, o1;
#pragma unroll
                        for (int j = 0; j < 4; ++j) { o0[j] = __shfl_xor(v0[j], 32); o1[j] = __shfl_xor(v1[j], 32); }
                        v0 = v0 * c0 + (o0 * s0) * sgn; v1 = v1 * c1 + (o1 * s1) * sgn;
                    } else if (mode == 2 || mode == 3) {
                        f32x2 a = gelu_pk((f32x2){v0[0], v0[1]}), b = gelu_pk((f32x2){v0[2], v0[3]}), c = gelu_pk((f32x2){v1[0], v1[1]}), d = gelu_pk((f32x2){v1[2], v1[3]});
                        v0 = (f32x4){a.x, a.y, b.x, b.y}; v1 = (f32x4){c.x, c.y, d.x, d.y};
                        if (mode == 3) {
#pragma unroll
                            for (int j = 0; j < 4; ++j) { t1 += v0[j] + v1[j]; t2 += v0[j] * v0[j] + v1[j] * v1[j]; } }
                    } else if (mode == 4) {
#pragma unroll
                        for (int j = 0; j < 4; ++j) { v0[j] = sigmoid_f(v0[j]); v1[j] = sigmoid_f(v1[j]); }
                    }
                    *(u32x4*)(rowp + bj * HALF) = pack8(v0, v1);
                }
                if (mode == 3) {
                    t1 += __shfl_xor(t1, 16); t1 += __shfl_xor(t1, 32); t2 += __shfl_xor(t2, 16); t2 += __shfl_xor(t2, 32);
                    if (fq == 0) *(f32x2*)(svstat + ((size_t)row * 32 + (pn - 20) * 4 + wc) * 2) = (f32x2){t1, t2};
                }
            }
        }
    }
};
struct EpiMerge {
    static constexpr bool PERM = true, AFTER_DRAIN = false, HAS_MID = true;
    bf16_t* T; const bf16_t* Z;
    __device__ __forceinline__ void mid(f32x4 (&acc)[2][2][4][2], const Unit& u, int wr, int wc, int fr, int fq) const {
        int row0 = u.pm * BM + wr * 64 + fr, col0 = u.pn * BM + wc * 32 + 8 * fq;
        asm volatile("" : "+v"(row0), "+v"(col0));
#pragma unroll
        for (int ai = 0; ai < 2; ++ai)
#pragma unroll
            for (int mp = 0; mp < 2; ++mp) {
                u32x4 aw[2][2], bw[2][2];
#pragma unroll
                for (int mm = 0; mm < 2; ++mm)
#pragma unroll
                    for (int bj = 0; bj < 2; ++bj) { const bf16_t* zp = Z + (size_t)(row0 + ai * HALF + (2 * mp + mm) * 16) * Z_LD + col0 + bj * HALF;
                        aw[mm][bj] = *(const u32x4*)(zp + ZO_GA); bw[mm][bj] = *(const u32x4*)(zp + ZO_GB); }
                asm volatile("" ::: "memory");
#pragma unroll
                for (int mm = 0; mm < 2; ++mm)
#pragma unroll
                    for (int bj = 0; bj < 2; ++bj) { f32x4 a0, a1, b0, b1; unpack8(aw[mm][bj], a0, a1); unpack8(bw[mm][bj], b0, b1); const int m = 2 * mp + mm;
#pragma unroll
                        for (int j = 0; j < 4; ++j) { acc[ai][bj][m][0][j] *= a0[j] * __builtin_amdgcn_rcpf(b0[j]); acc[ai][bj][m][1][j] *= a1[j] * __builtin_amdgcn_rcpf(b1[j]); } }
            }
    }
    __device__ __forceinline__ void operator()(const f32x4 (&acc)[2][2][4][2], const Unit& u, int wr, int wc, int fr, int fq) const {
        const int row0 = u.pm * BM + wr * 64 + fr, col0 = u.pn * BM + wc * 32 + 8 * fq;
#pragma unroll
        for (int ai = 0; ai < 2; ++ai) {
            u32x4 gw[4][2];
#pragma unroll
            for (int m = 0; m < 4; ++m)
#pragma unroll
                for (int bj = 0; bj < 2; ++bj) gw[m][bj] = *(const u32x4*)(Z + (size_t)(row0 + ai * HALF + m * 16) * Z_LD + ZO_GB + col0 + bj * HALF);
            asm volatile("" ::: "memory");
#pragma unroll
            for (int m = 0; m < 4; ++m)
#pragma unroll
                for (int bj = 0; bj < 2; ++bj) { f32x4 g0, g1; unpack8(gw[m][bj], g0, g1);
                    *(u32x4*)(T + (size_t)(row0 + ai * HALF + m * 16) * 4096 + col0 + bj * HALF) = pack8(acc[ai][bj][m][0] * g0, acc[ai][bj][m][1] * g1); }
            asm volatile("" ::: "memory");
        }
    }
};
struct EpiStats {
    static constexpr bool PERM = true, AFTER_DRAIN = false, HAS_MID = false;
    bf16_t* Y; float* ssq;
    __device__ __forceinline__ void operator()(const f32x4 (&acc)[2][2][4][2], const Unit& u, int wr, int wc, int fr, int fq) const {
        const int row0 = u.pm * BM + wr * 64 + fr, col0 = u.pn * BM + wc * 32 + 8 * fq;
#pragma unroll
        for (int ai = 0; ai < 2; ++ai)
#pragma unroll
            for (int m = 0; m < 4; ++m) { const int row = row0 + ai * HALF + m * 16; float t2 = 0.f;
#pragma unroll
                for (int bj = 0; bj < 2; ++bj) { const f32x4 v0 = acc[ai][bj][m][0], v1 = acc[ai][bj][m][1];
#pragma unroll
                    for (int j = 0; j < 4; ++j) t2 += v0[j] * v0[j] + v1[j] * v1[j];
                    *(u32x4*)(Y + (size_t)row * 4096 + col0 + bj * HALF) = pack8(v0, v1); }
                t2 += __shfl_xor(t2, 16); t2 += __shfl_xor(t2, 32);
                if (fq == 0) ssq[(size_t)row * 64 + u.pn * 4 + wc] = t2; }
    }
};
struct EpiStatsI8 {
    static constexpr bool PERM = true, AFTER_DRAIN = false, HAS_MID = false;
    bf16_t* Y; float* ssq; const float* sa; const float* sbw;
    __device__ __forceinline__ void operator()(const f32x4 (&acc)[2][2][4][2], const Unit& u, int wr, int wc, int fr, int fq) const {
        const int row0 = u.pm * BM + wr * 64 + fr, col0 = u.pn * BM + wc * 32 + 8 * fq;
        float sr[2][4]; f32x4 sc[2][2];
#pragma unroll
        for (int ai = 0; ai < 2; ++ai)
#pragma unroll
            for (int m = 0; m < 4; ++m) sr[ai][m] = sa[row0 + ai * HALF + m * 16];
#pragma unroll
        for (int bj = 0; bj < 2; ++bj)
#pragma unroll
            for (int n = 0; n < 2; ++n) sc[bj][n] = *(const f32x4*)(sbw + col0 + bj * HALF + 4 * n);
        asm volatile("" ::: "memory");
#pragma unroll
        for (int ai = 0; ai < 2; ++ai)
#pragma unroll
            for (int m = 0; m < 4; ++m) { const int row = row0 + ai * HALF + m * 16; const float s = sr[ai][m]; float t2 = 0.f;
#pragma unroll
                for (int bj = 0; bj < 2; ++bj) { f32x4 v0, v1; const i32x4 i0 = __builtin_bit_cast(i32x4, acc[ai][bj][m][0]), i1 = __builtin_bit_cast(i32x4, acc[ai][bj][m][1]);
#pragma unroll
                    for (int j = 0; j < 4; ++j) { v0[j] = (float)i0[j] * (s * sc[bj][0][j]); v1[j] = (float)i1[j] * (s * sc[bj][1][j]); t2 += v0[j] * v0[j] + v1[j] * v1[j]; }
                    *(u32x4*)(Y + (size_t)row * 4096 + col0 + bj * HALF) = pack8(v0, v1); }
                t2 += __shfl_xor(t2, 16); t2 += __shfl_xor(t2, 32);
                if (fq == 0) ssq[(size_t)row * 64 + u.pn * 4 + wc] = t2; }
    }
};
struct EpiSwiGLU_I8 {
    static constexpr bool PERM = true, AFTER_DRAIN = false, HAS_MID = false;
    bf16_t* H; const float* sa; const float* sbw;
    __device__ __forceinline__ void operator()(const f32x4 (&acc)[2][2][4][2], const Unit& u, int wr, int wc, int fr, int fq) const {
        const int row0 = u.pm * BM + wr * 64 + fr, col0 = u.pn * HALF + wc * 32 + 8 * fq, wrow0 = u.pn * BM + wc * 32 + 8 * fq;
        float sr[2][4]; f32x4 sg[2], su[2];
#pragma unroll
        for (int ai = 0; ai < 2; ++ai)
#pragma unroll
            for (int m = 0; m < 4; ++m) sr[ai][m] = sa[row0 + ai * HALF + m * 16];
#pragma unroll
        for (int n = 0; n < 2; ++n) { sg[n] = *(const f32x4*)(sbw + wrow0 + 4 * n); su[n] = *(const f32x4*)(sbw + wrow0 + HALF + 4 * n); }
        asm volatile("" ::: "memory");
#pragma unroll
        for (int ai = 0; ai < 2; ++ai)
#pragma unroll
            for (int m = 0; m < 4; ++m) { const int row = row0 + ai * HALF + m * 16; const float s = sr[ai][m];
                f32x4 h[2];
#pragma unroll
                for (int n = 0; n < 2; ++n) { const i32x4 gi = __builtin_bit_cast(i32x4, acc[ai][0][m][n]), ui = __builtin_bit_cast(i32x4, acc[ai][1][m][n]);
#pragma unroll
                    for (int j = 0; j < 4; ++j) { const float g = (float)gi[j] * (s * sg[n][j]), uu = (float)ui[j] * (s * su[n][j]); h[n][j] = g * sigmoid_f(g) * uu; } }
                *(u32x4*)(H + (size_t)row * 11008 + col0) = pack8(h[0], h[1]); }
    }
};

struct EpiSwiGLU_I8H {
    static constexpr bool PERM = true, AFTER_DRAIN = false, HAS_MID = false;
    bf16_t* H; const float* sa; const float* sbw;
    __device__ __forceinline__ void operator()(const f32x4 (&acc)[2][2][4][2], const Unit& u, int wr, int wc, int fr, int fq) const {
        const int row0 = u.pm * BM + wr * 64 + fr, col0 = u.pn * HALF + wc * 32 + 8 * fq, wrow0 = u.pn * BM + wc * 32 + 8 * fq;
        float sr[2][4]; f32x4 sg[2], su[2];
#pragma unroll
        for (int ai = 0; ai < 2; ++ai)
#pragma unroll
            for (int m = 0; m < 4; ++m) sr[ai][m] = sa[row0 + ai * HALF + m * 16];
#pragma unroll
        for (int n = 0; n < 2; ++n) { sg[n] = *(const f32x4*)(sbw + wrow0 + 4 * n); su[n] = *(const f32x4*)(sbw + wrow0 + HALF + 4 * n) * 0.17677669529663687f; }
        bf16x8 hf[2];
#pragma unroll
        for (int f = 0; f < 2; ++f) { const int co = 8 * (fr >> 2) + 4 * f + (fr & 3); u32x4 w;
#pragma unroll
            for (int q = 0; q < 4; ++q) { const unsigned lo = (__builtin_popcount((8 * fq + 2 * q) & co) & 1) ? 0xBF80u : 0x3F80u, hi = (__builtin_popcount((8 * fq + 2 * q + 1) & co) & 1) ? 0xBF80u : 0x3F80u; w[q] = lo | (hi << 16); }
            hf[f] = __builtin_bit_cast(bf16x8, w); }
        asm volatile("" ::: "memory");
#pragma unroll
        for (int ai = 0; ai < 2; ++ai)
#pragma unroll
            for (int m = 0; m < 4; ++m) { const int row = row0 + ai * HALF + m * 16; const float s = sr[ai][m];
                f32x4 h[2];
#pragma unroll
                for (int n = 0; n < 2; ++n) { const i32x4 gi = __builtin_bit_cast(i32x4, acc[ai][0][m][n]), ui = __builtin_bit_cast(i32x4, acc[ai][1][m][n]);
#pragma unroll
                    for (int j = 0; j < 4; ++j) { const float g = (float)gi[j] * (s * sg[n][j]), uu = (float)ui[j] * (s * su[n][j]); h[n][j] = g * sigmoid_f(g) * uu; } }
                const bf16x8 hb = __builtin_bit_cast(bf16x8, pack8(h[0], h[1]));
                const f32x4 z = {0.f, 0.f, 0.f, 0.f};
                const f32x4 d0 = __builtin_amdgcn_mfma_f32_16x16x32_bf16(hf[0], hb, z, 0, 0, 0), d1 = __builtin_amdgcn_mfma_f32_16x16x32_bf16(hf[1], hb, z, 0, 0, 0);
                *(u32x4*)(H + (size_t)row * 11008 + col0) = pack8(d0, d1); }
    }
};

struct EpiGateI8 {
    static constexpr bool PERM = true, AFTER_DRAIN = false, HAS_MID = false;
    bf16_t* Z; const float* sa; const float* sbw;
    __device__ __forceinline__ void operator()(const f32x4 (&acc)[2][2][4][2], const Unit& u, int wr, int wc, int fr, int fq) const {
        const int row0 = u.pm * BM + wr * 64 + fr, col0 = u.pn * BM + wc * 32 + 8 * fq;
        float sr[2][4]; f32x4 sc[2][2];
#pragma unroll
        for (int ai = 0; ai < 2; ++ai)
#pragma unroll
            for (int m = 0; m < 4; ++m) sr[ai][m] = sa[row0 + ai * HALF + m * 16];
#pragma unroll
        for (int bj = 0; bj < 2; ++bj)
#pragma unroll
            for (int n = 0; n < 2; ++n) sc[bj][n] = *(const f32x4*)(sbw + col0 + bj * HALF + 4 * n);
        asm volatile("" ::: "memory");
#pragma unroll
        for (int ai = 0; ai < 2; ++ai)
#pragma unroll
            for (int m = 0; m < 4; ++m) { const int row = row0 + ai * HALF + m * 16; const float s = sr[ai][m];
#pragma unroll
                for (int bj = 0; bj < 2; ++bj) { f32x4 v[2];
#pragma unroll
                    for (int n = 0; n < 2; ++n) { const i32x4 gi = __builtin_bit_cast(i32x4, acc[ai][bj][m][n]);
#pragma unroll
                        for (int j = 0; j < 4; ++j) v[n][j] = sigmoid_f((float)gi[j] * (s * sc[bj][n][j])); }
                    *(u32x4*)(Z + (size_t)row * Z_LD + ZO_GA + col0 + bj * HALF) = pack8(v[0], v[1]); } }
    }
};

struct EpiSvGateI8 {
    static constexpr bool PERM = true, AFTER_DRAIN = false, HAS_MID = false;
    bf16_t* Z; const float* sa; const float* sbw; float* svstat;
    __device__ __forceinline__ void operator()(const f32x4 (&acc)[2][2][4][2], const Unit& u, int wr, int wc, int fr, int fq) const {
        const int row0 = u.pm * BM + wr * 64 + fr, col0 = u.pn * BM + wc * 32 + 8 * fq; const bool issv = u.pn < 8;
        float sr[2][4]; f32x4 sc[2][2];
#pragma unroll
        for (int ai = 0; ai < 2; ++ai)
#pragma unroll
            for (int m = 0; m < 4; ++m) sr[ai][m] = sa[row0 + ai * HALF + m * 16];
#pragma unroll
        for (int bj = 0; bj < 2; ++bj)
#pragma unroll
            for (int n = 0; n < 2; ++n) sc[bj][n] = *(const f32x4*)(sbw + col0 + bj * HALF + 4 * n);
        asm volatile("" ::: "memory");
#pragma unroll
        for (int ai = 0; ai < 2; ++ai)
#pragma unroll
            for (int m = 0; m < 4; ++m) { const int row = row0 + ai * HALF + m * 16; const float s = sr[ai][m]; float t1 = 0.f, t2 = 0.f;
#pragma unroll
                for (int bj = 0; bj < 2; ++bj) { f32x4 v0, v1; const i32x4 i0 = __builtin_bit_cast(i32x4, acc[ai][bj][m][0]), i1 = __builtin_bit_cast(i32x4, acc[ai][bj][m][1]);
#pragma unroll
                    for (int j = 0; j < 4; ++j) { v0[j] = (float)i0[j] * (s * sc[bj][0][j]); v1[j] = (float)i1[j] * (s * sc[bj][1][j]); }
                    if (issv) {
                        f32x2 a = gelu_pk((f32x2){v0[0], v0[1]}), b = gelu_pk((f32x2){v0[2], v0[3]}), c = gelu_pk((f32x2){v1[0], v1[1]}), d = gelu_pk((f32x2){v1[2], v1[3]});
                        v0 = (f32x4){a.x, a.y, b.x, b.y}; v1 = (f32x4){c.x, c.y, d.x, d.y};
#pragma unroll
                        for (int j = 0; j < 4; ++j) { t1 += v0[j] + v1[j]; t2 += v0[j] * v0[j] + v1[j] * v1[j]; }
                    } else {
#pragma unroll
                        for (int j = 0; j < 4; ++j) { v0[j] = sigmoid_f(v0[j]); v1[j] = sigmoid_f(v1[j]); }
                    }
                    *(u32x4*)(Z + (size_t)row * Z_LD + ZO_SV + col0 + bj * HALF) = pack8(v0, v1); }
                if (issv) {
                    t1 += __shfl_xor(t1, 16); t1 += __shfl_xor(t1, 32); t2 += __shfl_xor(t2, 16); t2 += __shfl_xor(t2, 32);
                    if (fq == 0) *(f32x2*)(svstat + ((size_t)row * 32 + u.pn * 4 + wc) * 2) = (f32x2){t1, t2}; }
            }
    }
};
template <class Epi, class Sched, bool ALIGN_EPI = false, bool SP2 = false, bool I8 = false>
__device__ __forceinline__ void gemm_phase(PG8_LAS unsigned char* lds, const Gemm g, const Sched& S, const Epi& E, const int tid_in) {
    const int tid = tid_in, wid = __builtin_amdgcn_readfirstlane(tid >> 6), lane = tid & 63, wr = wid >> 2, wc = wid & 3, fr = lane & 15, fq = lane >> 4;
    const int K = g.K, nt = K / BK;
    unsigned voffA[2], voffB[2];
#pragma unroll
    for (int i = 0; i < 2; ++i) { int R, C; stage_rc(tid * 16 + i * 8192, R, C); const int Rb = Epi::PERM ? ((R & ~31) + perm32(R & 31)) : R;
        voffA[i] = (unsigned)(R * K + C) * 2u; voffB[i] = (unsigned)(Rb * K + C) * 2u; }
    const size_t kstep = (size_t)(BK * 2);
    const size_t hstep = (size_t)HALF * K * 2;
    const size_t tstep = 2 * hstep;
    const unsigned ldsw = (unsigned)wid * 1024u;
    const int aoff = lds_byte(wr * 64 + fr, fq * 8), boff = lds_byte(wc * 32 + fr, fq * 8);
#define PG8_SA(b, h) (((b) * 2 + (h)) * HTB)
#define PG8_SB(b, h) ((4 + (b) * 2 + (h)) * HTB)
#define PG8_STAGE(bufoff, gbase, voff) do { _Pragma("unroll") for (int _i = 0; _i < 2; ++_i) \
        __builtin_amdgcn_global_load_lds((const unsigned*)((const char*)(gbase) + (voff)[_i]), (PG8_LAS unsigned*)(lds + (bufoff) + ldsw + _i * 8192), 16, 0, 0); } while (0)
#define PG8_LDA(dst, b, h) do { _Pragma("unroll") for (int m = 0; m < 4; ++m) _Pragma("unroll") for (int k = 0; k < 2; ++k) dst[m][k] = *(const PG8_LAS bf16x8*)(lds + PG8_SA(b, h) + aoff + m * 2048 + k * 1024); } while (0)
#define PG8_LDB(dst, b, h) do { _Pragma("unroll") for (int n = 0; n < 2; ++n) _Pragma("unroll") for (int k = 0; k < 2; ++k) dst[n][k] = *(const PG8_LAS bf16x8*)(lds + PG8_SB(b, h) + boff + n * 2048 + k * 1024); } while (0)
#define PG8_MMA(ai, bj, At, Bt) do { __builtin_amdgcn_s_setprio(1); _Pragma("unroll") for (int m = 0; m < 4; ++m) _Pragma("unroll") for (int n = 0; n < 2; ++n) _Pragma("unroll") for (int k = 0; k < 2; ++k) \
        { if constexpr (I8) acc[ai][bj][m][n] = __builtin_bit_cast(f32x4, __builtin_amdgcn_mfma_i32_16x16x64_i8(__builtin_bit_cast(i32x4, Bt[n][k]), __builtin_bit_cast(i32x4, At[m][k]), __builtin_bit_cast(i32x4, acc[ai][bj][m][n]), 0, 0, 0)); \
          else acc[ai][bj][m][n] = __builtin_amdgcn_mfma_f32_16x16x32_bf16(Bt[n][k], At[m][k], acc[ai][bj][m][n], 0, 0, 0); } __builtin_amdgcn_s_setprio(0); } while (0)
#define PG8_WAIT_V(n) asm volatile("s_waitcnt vmcnt(" #n ")" ::: "memory")
#define PG8_WAIT_L(n) asm volatile("s_waitcnt lgkmcnt(" #n ")" ::: "memory")
#define PG8_BAR __builtin_amdgcn_s_barrier()
#define PG8_SCHED __builtin_amdgcn_sched_barrier(0)
    Unit cur, nxt; int ui = 0;
    if (!S.next(0, cur)) return;
    f32x4 acc[2][2][4][2];
#pragma unroll
    for (int a = 0; a < 2; ++a)
#pragma unroll
        for (int b = 0; b < 2; ++b)
#pragma unroll
            for (int m = 0; m < 4; ++m)
#pragma unroll
                for (int n = 0; n < 2; ++n) acc[a][b][m][n] = (f32x4){0.f, 0.f, 0.f, 0.f};
    bf16x8 At[4][2], B0[2][2], B1[2][2];
    const char* cA = (const char*)g.A + (size_t)cur.pm * tstep; const char* cB = (const char*)g.Bt + (size_t)cur.pn * tstep;
    S.a_ready(cur);
    if constexpr (SP2) {
        PG8_STAGE(PG8_SB(0, 0), cB, voffB); PG8_STAGE(PG8_SB(0, 1), cB + hstep, voffB); PG8_STAGE(PG8_SA(0, 0), cA, voffA); PG8_STAGE(PG8_SA(0, 1), cA + hstep, voffA);
        if (wr == 1) PG8_BAR;
        PG8_WAIT_V(2); PG8_BAR;
        PG8_STAGE(PG8_SB(1, 0), cB + kstep, voffB); PG8_STAGE(PG8_SA(1, 0), cA + kstep, voffA); PG8_STAGE(PG8_SB(1, 1), cB + hstep + kstep, voffB);
        PG8_WAIT_V(6); PG8_BAR;
    } else {
        PG8_STAGE(PG8_SB(0, 0), cB, voffB); PG8_STAGE(PG8_SA(0, 0), cA, voffA); PG8_STAGE(PG8_SB(0, 1), cB + hstep, voffB); PG8_STAGE(PG8_SA(0, 1), cA + hstep, voffA);
        if (wr == 1) PG8_BAR;
        PG8_WAIT_V(4); PG8_BAR;
        PG8_STAGE(PG8_SB(1, 0), cB + kstep, voffB); PG8_STAGE(PG8_SA(1, 0), cA + kstep, voffA); PG8_STAGE(PG8_SB(1, 1), cB + hstep + kstep, voffB);
        PG8_WAIT_V(6); PG8_BAR;
    }
    for (;;) {
        const bool has_next = S.next(ui + 1, nxt);
        const char* nA = has_next ? (const char*)g.A + (size_t)nxt.pm * tstep : cA; const char* nB = has_next ? (const char*)g.Bt + (size_t)nxt.pn * tstep : cB;
        for (int t = 0; t < nt; t += 2) {
            const bool last = (t == nt - 2);
            const char* a1 = cA + (size_t)(t + 1) * kstep;
            const char* a2 = last ? nA : cA + (size_t)(t + 2) * kstep; const char* b2 = last ? nB : cB + (size_t)(t + 2) * kstep;
            const char* a3 = a2 + kstep; const char* b3 = b2 + kstep;
            if constexpr (Epi::HAS_MID) { if (t == nt / 2) E.mid(acc, cur, wr, wc, fr, fq); }
            if (last && has_next) S.a_ready(nxt);
            if constexpr (SP2) {
            PG8_LDB(B0, 0, 0); PG8_LDB(B1, 0, 1); PG8_SCHED; PG8_LDA(At, 0, 0); PG8_STAGE(PG8_SA(1, 1), a1 + hstep, voffA);
            PG8_WAIT_V(8); PG8_WAIT_L(0); PG8_BAR; PG8_MMA(0, 0, At, B0); PG8_MMA(0, 1, At, B1); PG8_BAR; PG8_SCHED;
            PG8_LDA(At, 0, 1); PG8_STAGE(PG8_SB(0, 0), b2, voffB); PG8_STAGE(PG8_SB(0, 1), b2 + hstep, voffB); PG8_STAGE(PG8_SA(0, 0), a2, voffA);
            PG8_WAIT_V(8); PG8_WAIT_L(0); PG8_BAR; PG8_MMA(1, 0, At, B0); PG8_MMA(1, 1, At, B1); PG8_BAR; PG8_SCHED;
            PG8_LDB(B0, 1, 0); PG8_LDB(B1, 1, 1); PG8_SCHED; PG8_LDA(At, 1, 0); PG8_STAGE(PG8_SA(0, 1), a2 + hstep, voffA);
            PG8_WAIT_V(8); PG8_WAIT_L(0); PG8_BAR; PG8_MMA(0, 0, At, B0); PG8_MMA(0, 1, At, B1); PG8_BAR; PG8_SCHED;
            PG8_LDA(At, 1, 1); PG8_STAGE(PG8_SB(1, 0), b3, voffB); PG8_STAGE(PG8_SB(1, 1), b3 + hstep, voffB); PG8_STAGE(PG8_SA(1, 0), a3, voffA);
            PG8_WAIT_V(8); PG8_WAIT_L(0); PG8_BAR; PG8_MMA(1, 0, At, B0); PG8_MMA(1, 1, At, B1); PG8_BAR; PG8_SCHED;
            } else {
            PG8_LDB(B0, 0, 0); PG8_SCHED; PG8_LDA(At, 0, 0); PG8_STAGE(PG8_SA(1, 1), a1 + hstep, voffA);
            PG8_WAIT_L(8); PG8_BAR; PG8_WAIT_L(0); PG8_MMA(0, 0, At, B0); PG8_BAR; PG8_SCHED;
            PG8_LDB(B1, 0, 1); PG8_STAGE(PG8_SB(0, 0), b2, voffB);
            PG8_BAR; PG8_WAIT_L(0); PG8_MMA(0, 1, At, B1); PG8_BAR;
            PG8_LDA(At, 0, 1); PG8_STAGE(PG8_SA(0, 0), a2, voffA);
            PG8_BAR; PG8_WAIT_L(0); PG8_MMA(1, 0, At, B0); PG8_BAR; PG8_SCHED;
            PG8_STAGE(PG8_SB(0, 1), b2 + hstep, voffB);
            PG8_WAIT_V(6); PG8_BAR; PG8_MMA(1, 1, At, B1); PG8_BAR;
            PG8_LDB(B0, 1, 0); PG8_SCHED; PG8_LDA(At, 1, 0); PG8_STAGE(PG8_SA(0, 1), a2 + hstep, voffA);
            PG8_WAIT_L(8); PG8_BAR; PG8_WAIT_L(0); PG8_MMA(0, 0, At, B0); PG8_BAR; PG8_SCHED;
            PG8_LDB(B1, 1, 1); PG8_STAGE(PG8_SB(1, 0), b3, voffB);
            PG8_BAR; PG8_WAIT_L(0); PG8_MMA(0, 1, At, B1); PG8_BAR;
            PG8_LDA(At, 1, 1); PG8_STAGE(PG8_SA(1, 0), a3, voffA);
            PG8_BAR; PG8_WAIT_L(0); PG8_MMA(1, 0, At, B0); PG8_BAR; PG8_SCHED;
            PG8_STAGE(PG8_SB(1, 1), b3 + hstep, voffB);
            PG8_WAIT_V(6); PG8_BAR; PG8_MMA(1, 1, At, B1); PG8_BAR;
            }
        }
        if constexpr (ALIGN_EPI) { if (wr == 0) PG8_BAR; }
        if constexpr (!Epi::AFTER_DRAIN) { E(acc, cur, wr, wc, fr, fq); S.done(cur); }
        if (!has_next) break;
#pragma unroll
        for (int a = 0; a < 2; ++a)
#pragma unroll
            for (int b = 0; b < 2; ++b)
#pragma unroll
                for (int m = 0; m < 4; ++m)
#pragma unroll
                    for (int n = 0; n < 2; ++n) acc[a][b][m][n] = (f32x4){0.f, 0.f, 0.f, 0.f};
        cur = nxt; cA = nA; cB = nB; ++ui;
        if constexpr (ALIGN_EPI) { if (wr == 1) PG8_BAR; }
    }
    PG8_WAIT_V(0);
    if constexpr (!ALIGN_EPI) { if (wr == 0) PG8_BAR; }
    PG8_BAR;
    if constexpr (Epi::AFTER_DRAIN) { E.fused(acc, cur, wr, wc, fr, fq, lds, wid, lane); S.done(cur); }
#undef PG8_SA
#undef PG8_SB
#undef PG8_STAGE
#undef PG8_LDA
#undef PG8_LDB
#undef PG8_MMA
#undef PG8_WAIT_V
#undef PG8_WAIT_L
#undef PG8_BAR
#undef PG8_SCHED
}
}

constexpr int NWAVES = 8;
constexpr int NB = 4, SEQ = 4096, DM = 4096, M = NB * SEQ;
constexpr int INW = 15360, FF = 11008, NGU = 2 * FF, NMOD = 6 * DM;
constexpr float RMS_EPS = 1e-6f, LN_EPS = 1e-5f;

constexpr size_t MiB = 1u << 20;
constexpr size_t WS_CTL = 0, CTL_ZERO_BYTES = 1 * MiB;
constexpr size_t WS_MODP = 1 * MiB;
constexpr size_t WS_MOD = 25 * MiB;
constexpr size_t WS_ROPEC = 26 * MiB, WS_ROPES = 27 * MiB;
constexpr size_t WS_SGUW = 28 * MiB;
constexpr size_t WS_SVSTAT = 29 * MiB;
constexpr size_t WS_SSQ = 33 * MiB;
constexpr size_t WS_WIN = 64 * MiB, WS_WPS = 184 * MiB, WS_WPA = 200 * MiB, WS_WOUT = 216 * MiB, WS_WGU = 248 * MiB, WS_WDN = 420 * MiB;
constexpr size_t WS_Z = 512 * MiB;
constexpr size_t WS_A = 992 * MiB;
constexpr size_t WS_B = 1120 * MiB;
constexpr size_t WS_WQ = 1248 * MiB;
constexpr size_t WS_SBW = 37 * MiB;
constexpr size_t WS_SA = 38 * MiB;
constexpr size_t WS_HQ = 1334 * MiB;
constexpr size_t WS_WQIN = 1398 * MiB;
constexpr size_t WS_SA1 = 39 * MiB, WS_SBWIN = 40 * MiB;
constexpr size_t WS_WDQ = 1438 * MiB;
constexpr size_t WS_SBWD = 41 * MiB;
constexpr size_t WS_HIDQ = WS_A;
constexpr size_t WS_END = 1481 * MiB;
static_assert(WS_WQIN + (size_t)10240 * 4096 <= WS_WDQ && WS_WDQ + (size_t)4096 * 11008 <= WS_END && WS_HIDQ + (size_t)16384 * 11008 <= WS_WQ && WS_SBWIN + 10240 * 4 <= WS_SBWD && WS_SBWD + 4096 * 4 <= 64 * MiB, "d_ws map (down-proj int8)");
static_assert(WS_WIN + (size_t)INW * DM * 2 <= WS_WPS && WS_WPS + (size_t)DM * 2048 * 2 <= WS_WPA && WS_WPA + (size_t)DM * 2048 * 2 <= WS_WOUT && WS_WOUT + (size_t)DM * DM * 2 <= WS_WGU &&
              WS_WGU + (size_t)NGU * DM * 2 <= WS_WDN && WS_WDN + (size_t)DM * FF * 2 <= WS_Z && WS_Z + (size_t)M * INW * 2 <= WS_A && WS_A + (size_t)M * DM * 2 <= WS_B && WS_B + (size_t)M * DM * 2 <= WS_WQ && WS_WQ + (size_t)NGU * DM <= WS_HQ && WS_HQ + (size_t)M * DM <= WS_WQIN && WS_WQIN + (size_t)10240 * DM <= WS_END, "d_ws map");
static_assert(WS_MODP + (size_t)64 * 4 * NMOD * 4 <= WS_MOD && WS_SVSTAT + (size_t)M * 64 * 4 <= WS_SSQ && WS_SSQ + (size_t)M * 64 * 4 <= WS_WIN, "d_ws map (small)");
constexpr int CW_BAR = 4096;

constexpr int LDS_BYTES = 147456;
constexpr int LDSCTL_OFF = LDS_BYTES - 256;

#define GAS __attribute__((address_space(1)))
#define LAS __attribute__((address_space(3)))
typedef unsigned short bf16;
typedef unsigned v4u __attribute__((ext_vector_type(4)));
typedef unsigned v2u __attribute__((ext_vector_type(2)));
typedef float f32x4 __attribute__((ext_vector_type(4)));
typedef float f32x2 __attribute__((ext_vector_type(2)));
typedef float f32x16 __attribute__((ext_vector_type(16)));
typedef short bf16x8 __attribute__((ext_vector_type(8)));
typedef short s16x4 __attribute__((ext_vector_type(4)));
typedef GAS unsigned gu32;
#define RLX_AGENT __ATOMIC_RELAXED, __HIP_MEMORY_SCOPE_AGENT
#define LDS_WAIT() asm volatile("s_waitcnt lgkmcnt(0)" ::: "memory")
using pg8::pk_bf16; using pg8::bf_lo; using pg8::bf_hi;

__device__ __forceinline__ float wave_sum(float v) {
#pragma unroll
    for (int o = 1; o < 64; o <<= 1) v += __shfl_xor(v, o);
    return v;
}
#define XB_TMO      128
#define XB_XCNT(j)  (256  + 64 * (j))
#define XB_XSUB(j)  (1280 + 64 * (j))
#define XB_XGEN(j)  (2304 + 64 * (j))
#define XB_TOP      3328
#define XB_TOPGEN   3392
#define XCD_BAR_WORDS 3456
#define XB_SPIN_CAP (1u << 18)

__device__ __forceinline__ unsigned xb_ld(unsigned* p)              { return __hip_atomic_load(p, __ATOMIC_RELAXED, __HIP_MEMORY_SCOPE_AGENT); }
__device__ __forceinline__ unsigned xb_add(unsigned* p, unsigned v) { return __hip_atomic_fetch_add(p, v, __ATOMIC_RELAXED, __HIP_MEMORY_SCOPE_AGENT); }
__device__ __forceinline__ unsigned xb_xcc_id() { return (unsigned)__builtin_amdgcn_s_getreg((3 << 11) | 20) & 0xFu; }
#define XB_SPIN(cond, bar) do { unsigned _sp = 0; while (cond) { __builtin_amdgcn_s_sleep(1); \
    if ((++_sp & 255u) == 0u) { if (xb_ld(&(bar)[XB_TMO])) break; if (_sp > XB_SPIN_CAP) { atomicAdd(&(bar)[XB_TMO], 1u); break; } } } } while (0)

struct XcdBarrier {
    unsigned* bar; unsigned x;
    volatile LAS unsigned* st;
};

__device__ __forceinline__ XcdBarrier xcd_barrier_post(unsigned* bar, volatile LAS unsigned* st) {
    XcdBarrier b; b.bar = bar; b.x = xb_xcc_id(); b.st = st;
    if (threadIdx.x == 0) (void)xb_add(&bar[XB_XCNT(b.x)], 1u);
    return b;
}
__device__ __forceinline__ void xcd_barrier_complete(unsigned* bar, unsigned x, unsigned& nloc, unsigned& nx) {
    const unsigned G = gridDim.x * gridDim.y * gridDim.z;
    unsigned sum, cnt, mine, sp = 0u;
    for (;;) {
        sum = 0u; cnt = 0u; mine = 0u;
#pragma unroll
        for (unsigned j = 0; j < 16; ++j) { const unsigned c = xb_ld(&bar[XB_XCNT(j)]); sum += c; cnt += (c > 0u) ? 1u : 0u; mine = (j == x) ? c : mine; }
        if (sum == G) break;
        __builtin_amdgcn_s_sleep(1);
        if ((++sp & 255u) == 0u) { if (xb_ld(&bar[XB_TMO])) break; if (sp > XB_SPIN_CAP) { atomicAdd(&bar[XB_TMO], 1u); break; } }
    }
    nloc = mine > 0u ? mine : 1u; nx = cnt > 0u ? cnt : 1u;
}

__device__ __forceinline__ void xcd_barrier(const XcdBarrier& b) {
    asm volatile("s_waitcnt vmcnt(0)" ::: "memory");
    __syncthreads();
    if (threadIdx.x == 0) {
        unsigned* bar = b.bar;
        __builtin_amdgcn_s_waitcnt(0);
        unsigned nloc = b.st[0], nx = b.st[1];
        if (nloc == 0u) { xcd_barrier_complete(bar, b.x, nloc, nx); b.st[0] = nloc; b.st[1] = nx; }
        const unsigned old = xb_add(&bar[XB_XSUB(b.x)], 1u);
        const unsigned gen = old / nloc;
        if (old + 1u == (gen + 1u) * nloc) {
            __builtin_amdgcn_fence(__ATOMIC_RELEASE, "agent");
            asm volatile("s_waitcnt vmcnt(0)" ::: "memory");
            const unsigned og = xb_add(&bar[XB_TOP], 1u);
            const unsigned tg = og / nx;
            if (og + 1u == (tg + 1u) * nx) xb_add(&bar[XB_TOPGEN], 1u);
            else XB_SPIN(xb_ld(&bar[XB_TOPGEN]) == tg, bar);
            __builtin_amdgcn_fence(__ATOMIC_ACQUIRE, "agent");
            xb_add(&bar[XB_XGEN(b.x)], 1u);
            asm volatile("s_waitcnt vmcnt(0)" ::: "memory");
        } else {
            XB_SPIN(xb_ld(&bar[XB_XGEN(b.x)]) == gen, bar);
            __builtin_amdgcn_fence(__ATOMIC_ACQUIRE, "agent");
            asm volatile("s_waitcnt vmcnt(0)" ::: "memory");
        }
    }
    __syncthreads();
}

__device__ const float ROPE_INVF[16] = {1.0f, 0.44036659598350525f, 0.1939227432012558f, 0.08539710193872452f, 0.03760603070259094f, 0.016560440883040428f, 0.007292664609849453f, 0.0032114461064338684f,
                                        0.0014142135623842478f, 0.0006227724370546639f, 0.00027424818836152554f, 0.00012076973507646471f, 5.3182957344688475e-05f, 2.34199997066753e-05f, 1.0313385246263351e-05f, 4.541670477919979e-06f};

__device__ __forceinline__ void p0_transpose_item(const float* __restrict__ W, int K, int N, bf16* __restrict__ WT, int k0, int n0, int dst_row0, LAS float* scr, int lane, int dstK = 0, int dk0 = 0) {
    if (dstK == 0) dstK = K;
    const int sub = lane >> 4, c4 = lane & 15;
    f32x4 v[16];
#pragma unroll
    for (int i = 0; i < 16; ++i) v[i] = __builtin_nontemporal_load((const f32x4*)(W + (size_t)(k0 + 4 * i + sub) * N + n0 + 4 * c4));
#pragma unroll
    for (int i = 0; i < 16; ++i) { LAS float* p = scr + (4 * i + sub) * 65 + 4 * c4; p[0] = v[i][0]; p[1] = v[i][1]; p[2] = v[i][2]; p[3] = v[i][3]; }
    LDS_WAIT();
    const int c8 = lane & 7;
#pragma unroll
    for (int it = 0; it < 8; ++it) { const int nn = (lane >> 3) + 8 * it; const LAS float* s = scr + (8 * c8) * 65 + nn;
        v4u o; o.x = pk_bf16(s[0 * 65], s[1 * 65]); o.y = pk_bf16(s[2 * 65], s[3 * 65]); o.z = pk_bf16(s[4 * 65], s[5 * 65]); o.w = pk_bf16(s[6 * 65], s[7 * 65]);
        *(v4u*)(WT + (size_t)(dst_row0 + nn) * dstK + dk0 + k0 + 8 * c8) = o; }
    LDS_WAIT();
}
__device__ __forceinline__ void p0_gemv_item(const float* __restrict__ c, const float* __restrict__ w_ada, float* __restrict__ part, int cg, int kc, LAS float* scr, int lane) {
    const int k0 = kc * 64;
#pragma unroll
    for (int b = 0; b < 4; ++b) { const float cv = c[b * DM + k0 + lane]; scr[b * 64 + lane] = cv / (1.0f + __expf(-cv)); }
    LDS_WAIT();
    f32x4 a0 = {0.f, 0.f, 0.f, 0.f}, a1 = a0, a2 = a0, a3 = a0;
    const float* wp = w_ada + (size_t)k0 * NMOD + cg * 256 + 4 * lane;
#pragma unroll 16
    for (int kk = 0; kk < 64; ++kk) { const f32x4 w = __builtin_nontemporal_load((const f32x4*)(wp + (size_t)kk * NMOD));
        a0 += w * scr[kk]; a1 += w * scr[64 + kk]; a2 += w * scr[128 + kk]; a3 += w * scr[192 + kk]; }
    float* pp = part + (size_t)(kc * 4) * NMOD + cg * 256 + 4 * lane;
    *(f32x4*)(pp) = a0; *(f32x4*)(pp + NMOD) = a1; *(f32x4*)(pp + 2 * NMOD) = a2; *(f32x4*)(pp + 3 * NMOD) = a3;
    LDS_WAIT();
}
struct P0Args { const float *c, *w_ada, *w_in, *sgu_w, *w_ps, *w_pa, *w_out, *w_gate, *w_up, *w_down; const int* positions;
                float *modp, *ropeC, *ropeS; bf16 *sguw, *win_t, *wps_t, *wpa_t, *wout_t, *wgu_t, *wdn_t; };
__device__ __forceinline__ void p0_prologue(const P0Args& A, LAS unsigned char* lds, int gw, int NGW, int wave, int lane) {
    LAS float* scr = (LAS float*)(lds + wave * 16640);
    constexpr int I_GEMV = 96 * 64;
    constexpr int I_IN = (DM / 64) * (INW / 64), I_PS = (2048 / 64) * (DM / 64), I_OUT = (DM / 64) * (DM / 64), I_G = (DM / 64) * (FF / 64), I_DN = (FF / 64) * (DM / 64);
    constexpr int I_ROPE = M / 64, I_SW = 64;
    constexpr int NITEMS = I_GEMV + I_IN + 2 * I_PS + I_OUT + 2 * I_G + I_DN + I_ROPE + I_SW;
    for (int it = gw; it < NITEMS; it += NGW) {
        int r = it;
        if (r < I_GEMV) { p0_gemv_item(A.c, A.w_ada, A.modp, r % 96, r / 96, scr, lane); continue; } r -= I_GEMV;
        if (r < I_IN) { const int nnb = INW / 64, kb = r / nnb, nb = r % nnb; p0_transpose_item(A.w_in, DM, INW, A.win_t, 64 * kb, 64 * nb, 64 * nb, scr, lane); continue; } r -= I_IN;
        if (r < I_PS) { const int nnb = DM / 64, kb = r / nnb, nb = r % nnb; p0_transpose_item(A.w_ps, 2048, DM, A.wps_t, 64 * kb, 64 * nb, 64 * nb, scr, lane, 4096, 0); continue; } r -= I_PS;
        if (r < I_PS) { const int nnb = DM / 64, kb = r / nnb, nb = r % nnb; p0_transpose_item(A.w_pa, 2048, DM, A.wps_t, 64 * kb, 64 * nb, 64 * nb, scr, lane, 4096, 2048); continue; } r -= I_PS;
        if (r < I_OUT) { const int nnb = DM / 64, kb = r / nnb, nb = r % nnb; p0_transpose_item(A.w_out, DM, DM, A.wout_t, 64 * kb, 64 * nb, 64 * nb, scr, lane); continue; } r -= I_OUT;
        if (r < I_G) { const int nnb = FF / 64, kb = r / nnb, nb = r % nnb, n0 = 64 * nb;
            p0_transpose_item(A.w_gate, DM, FF, A.wgu_t, 64 * kb, n0, 256 * (n0 >> 7) + (n0 & 127), scr, lane); continue; } r -= I_G;
        if (r < I_G) { const int nnb = FF / 64, kb = r / nnb, nb = r % nnb, n0 = 64 * nb;
            p0_transpose_item(A.w_up, DM, FF, A.wgu_t, 64 * kb, n0, 256 * (n0 >> 7) + 128 + (n0 & 127), scr, lane); continue; } r -= I_G;
        if (r < I_DN) { const int nnb = DM / 64, kb = r / nnb, nb = r % nnb; p0_transpose_item(A.w_down, FF, DM, A.wdn_t, 64 * kb, 64 * nb, 64 * nb, scr, lane); continue; } r -= I_DN;
        if (r < I_ROPE) {
#pragma unroll 4
            for (int e = 0; e < 16; ++e) { const int idx = r * 1024 + e * 64 + lane, mrow = idx >> 4, i = idx & 15;
                const float ang = (float)A.positions[mrow] * ROPE_INVF[i];
                const double rev = (double)ang * 0.15915494309189535; const float fr = (float)(rev - __builtin_rint(rev));
                A.ropeC[idx] = __builtin_amdgcn_cosf(fr); A.ropeS[idx] = __builtin_amdgcn_sinf(fr); }
            continue; } r -= I_ROPE;
        {
#pragma unroll 4
            for (int e = 0; e < 64; ++e) { const int idx = r * 4096 + e * 64 + lane, t = (idx >> 7) & 127, s = idx & 127;
                const float w = (s <= t) ? A.sgu_w[idx] : 0.0f; A.sguw[idx] = (bf16)(pk_bf16(w, 0.f) & 0xffffu); }
        }
    }
}
__device__ __forceinline__ void p1_mod_reduce(const float* __restrict__ modp, const float* __restrict__ b_ada, const float* g_pre_mix, const float* g_post_mix, const float* g_pre_ffn, const float* g_post_ffn,
                                              float* __restrict__ mod, int gtid, int gthreads) {
    for (int idx = gtid; idx < 4 * (NMOD / 4); idx += gthreads) {
        const int b = idx / (NMOD / 4), j = 4 * (idx % (NMOD / 4));
        f32x4 s = *(const f32x4*)(b_ada + j);
#pragma unroll 32
        for (int kc = 0; kc < 64; ++kc) s += *(const f32x4*)(modp + (size_t)(kc * 4 + b) * NMOD + j);
        const int chunk = j >> 12, e = j & 4095;
        if (chunk == 1) s = *(const f32x4*)(g_pre_mix + e) * (s + 1.0f);
        else if (chunk == 2) s = s * *(const f32x4*)(g_post_mix + e);
        else if (chunk == 4) s = *(const f32x4*)(g_pre_ffn + e) * (s + 1.0f);
        else if (chunk == 5) s = s * *(const f32x4*)(g_post_ffn + e);
        *(f32x4*)(mod + (size_t)b * NMOD + j) = s;
    }
}
__device__ __forceinline__ void p1_quant_wrows(const bf16* __restrict__ W, signed char* __restrict__ WQ, float* __restrict__ sbw, int nrows, int gw, int NGW, int lane) {
    for (int r = gw; r < nrows; r += NGW) {
        const v4u* wr = (const v4u*)(W + (size_t)r * DM) + lane;
        v4u w[8]; float mx = 0.f;
#pragma unroll
        for (int j = 0; j < 8; ++j) { w[j] = __builtin_nontemporal_load(wr + 64 * j);
            mx = fmaxf(mx, fmaxf(fmaxf(fabsf(bf_lo(w[j].x)), fabsf(bf_hi(w[j].x))), fmaxf(fabsf(bf_lo(w[j].y)), fabsf(bf_hi(w[j].y)))));
            mx = fmaxf(mx, fmaxf(fmaxf(fabsf(bf_lo(w[j].z)), fabsf(bf_hi(w[j].z))), fmaxf(fabsf(bf_lo(w[j].w)), fabsf(bf_hi(w[j].w))))); }
#pragma unroll
        for (int o = 1; o < 64; o <<= 1) mx = fmaxf(mx, __shfl_xor(mx, o));
        const float inv = mx > 0.f ? 127.0f / mx : 0.f;
        if (lane == 0) sbw[r] = mx * (1.0f / 127.0f);
        v2u* qr = (v2u*)(WQ + (size_t)r * DM) + lane;
#pragma unroll
        for (int j = 0; j < 8; ++j) {
            const int q0 = (int)__builtin_rintf(bf_lo(w[j].x) * inv), q1 = (int)__builtin_rintf(bf_hi(w[j].x) * inv), q2 = (int)__builtin_rintf(bf_lo(w[j].y) * inv), q3 = (int)__builtin_rintf(bf_hi(w[j].y) * inv);
            const int q4 = (int)__builtin_rintf(bf_lo(w[j].z) * inv), q5 = (int)__builtin_rintf(bf_hi(w[j].z) * inv), q6 = (int)__builtin_rintf(bf_lo(w[j].w) * inv), q7 = (int)__builtin_rintf(bf_hi(w[j].w) * inv);
            v2u o; o.x = (unsigned)(q0 & 255) | ((unsigned)(q1 & 255) << 8) | ((unsigned)(q2 & 255) << 16) | ((unsigned)(q3 & 255) << 24);
            o.y = (unsigned)(q4 & 255) | ((unsigned)(q5 & 255) << 8) | ((unsigned)(q6 & 255) << 16) | ((unsigned)(q7 & 255) << 24);
            qr[64 * j] = o; }
    }
}
template <int CTRL> __device__ __forceinline__ float dpp_mov(float x) { return __builtin_bit_cast(float, __builtin_amdgcn_mov_dpp(__builtin_bit_cast(int, x), CTRL, 0xf, 0xf, true)); }
__device__ __forceinline__ f32x4 wht32_chunk(v2u w, float s1, float s2, float s4) {
    f32x4 a = {bf_lo(w.x), bf_hi(w.x), bf_lo(w.y), bf_hi(w.y)};
    { const f32x4 t = {a.x + a.y, a.x - a.y, a.z + a.w, a.z - a.w}; a = (f32x4){t.x + t.z, t.y + t.w, t.x - t.z, t.y - t.w}; }
    { f32x4 o; o.x = dpp_mov<0xB1>(a.x); o.y = dpp_mov<0xB1>(a.y); o.z = dpp_mov<0xB1>(a.z); o.w = dpp_mov<0xB1>(a.w); a = a * s1 + o; }
    { f32x4 o; o.x = dpp_mov<0x4E>(a.x); o.y = dpp_mov<0x4E>(a.y); o.z = dpp_mov<0x4E>(a.z); o.w = dpp_mov<0x4E>(a.w); a = a * s2 + o; }
    { f32x4 o; o.x = dpp_mov<0x1B>(dpp_mov<0x141>(a.x)); o.y = dpp_mov<0x1B>(dpp_mov<0x141>(a.y)); o.z = dpp_mov<0x1B>(dpp_mov<0x141>(a.z)); o.w = dpp_mov<0x1B>(dpp_mov<0x141>(a.w)); a = a * s4 + o; }
    return a * 0.17677669529663687f;
}
__device__ __forceinline__ void p1_quant_wdown_h32(const bf16* __restrict__ W, signed char* __restrict__ WQ, float* __restrict__ sbw, int gw, int NGW, int lane) {
    const float s1 = (lane & 1) ? -1.f : 1.f, s2 = (lane & 2) ? -1.f : 1.f, s4 = (lane & 4) ? -1.f : 1.f;
    for (int r = gw; r < DM; r += NGW) {
        const v2u* wr = (const v2u*)(W + (size_t)r * FF) + lane;
        float mx = 0.f;
#pragma unroll 1
        for (int i0 = 0; i0 < 43; i0 += 8) { v2u w[8];
#pragma unroll
            for (int k = 0; k < 8; ++k) { const int i = (i0 + k < 43) ? i0 + k : 42; w[k] = wr[64 * i]; }
#pragma unroll
            for (int k = 0; k < 8; ++k) { const f32x4 a = wht32_chunk(w[k], s1, s2, s4); mx = fmaxf(mx, fmaxf(fmaxf(fabsf(a.x), fabsf(a.y)), fmaxf(fabsf(a.z), fabsf(a.w)))); } }
#pragma unroll
        for (int o = 1; o < 64; o <<= 1) mx = fmaxf(mx, __shfl_xor(mx, o));
        const float inv = mx > 0.f ? 127.0f / mx : 0.f;
        if (lane == 0) sbw[r] = mx * (1.0f / 127.0f);
        unsigned* qr = (unsigned*)(WQ + (size_t)r * FF) + lane;
#pragma unroll 1
        for (int i0 = 0; i0 < 43; i0 += 8) { v2u w[8];
#pragma unroll
            for (int k = 0; k < 8; ++k) { const int i = (i0 + k < 43) ? i0 + k : 42; w[k] = wr[64 * i]; }
#pragma unroll
            for (int k = 0; k < 8; ++k) { const int i = (i0 + k < 43) ? i0 + k : 42; const f32x4 a = wht32_chunk(w[k], s1, s2, s4);
                const int q0 = (int)__builtin_rintf(a.x * inv), q1 = (int)__builtin_rintf(a.y * inv), q2 = (int)__builtin_rintf(a.z * inv), q3 = (int)__builtin_rintf(a.w * inv);
                qr[64 * i] = (unsigned)(q0 & 255) | ((unsigned)(q1 & 255) << 8) | ((unsigned)(q2 & 255) << 16) | ((unsigned)(q3 & 255) << 24); } }
    }
}
__device__ __forceinline__ void p8b_quant_hid_rows(const bf16* __restrict__ Hb, signed char* __restrict__ Hq, float* __restrict__ sa, int gw, int NGW, int lane) {
    for (int m = gw; m < M; m += NGW) {
        const v2u* hr = (const v2u*)(Hb + (size_t)m * FF) + lane;
        v2u w[43]; float mx = 0.f;
#pragma unroll
        for (int i = 0; i < 43; ++i) w[i] = __builtin_nontemporal_load(hr + 64 * i);
#pragma unroll
        for (int i = 0; i < 43; ++i) mx = fmaxf(mx, fmaxf(fmaxf(fabsf(bf_lo(w[i].x)), fabsf(bf_hi(w[i].x))), fmaxf(fabsf(bf_lo(w[i].y)), fabsf(bf_hi(w[i].y)))));
#pragma unroll
        for (int o = 1; o < 64; o <<= 1) mx = fmaxf(mx, __shfl_xor(mx, o));
        const float inv = mx > 0.f ? 127.0f / mx : 0.f;
        if (lane == 0) sa[m] = mx * (1.0f / 127.0f);
        unsigned* qr = (unsigned*)(Hq + (size_t)m * FF) + lane;
#pragma unroll
        for (int i = 0; i < 43; ++i) { const int q0 = (int)__builtin_rintf(bf_lo(w[i].x) * inv), q1 = (int)__builtin_rintf(bf_hi(w[i].x) * inv), q2 = (int)__builtin_rintf(bf_lo(w[i].y) * inv), q3 = (int)__builtin_rintf(bf_hi(w[i].y) * inv);
            qr[64 * i] = (unsigned)(q0 & 255) | ((unsigned)(q1 & 255) << 8) | ((unsigned)(q2 & 255) << 16) | ((unsigned)(q3 & 255) << 24); }
    }
}
__device__ __forceinline__ void p2_norm_rows(const float* __restrict__ x, const float* __restrict__ mod, bf16* __restrict__ h, signed char* __restrict__ hq, float* __restrict__ sa, int gw, int NGW, int lane) {
    f32x4 nx[16];
    if (gw < M) { const f32x4* xr = (const f32x4*)(x + (size_t)gw * DM) + lane;
#pragma unroll
        for (int j = 0; j < 16; ++j) nx[j] = __builtin_nontemporal_load(xr + 64 * j); }
    for (int m = gw; m < M; m += NGW) {
        f32x4 v[16]; float ss = 0.f;
#pragma unroll
        for (int j = 0; j < 16; ++j) { v[j] = nx[j]; ss += (v[j].x * v[j].x + v[j].y * v[j].y) + (v[j].z * v[j].z + v[j].w * v[j].w); }
        { const int mn = (m + NGW < M) ? m + NGW : m; const f32x4* xr = (const f32x4*)(x + (size_t)mn * DM) + lane;
#pragma unroll
            for (int j = 0; j < 16; ++j) nx[j] = __builtin_nontemporal_load(xr + 64 * j); }
        const float rstd = 1.0f / sqrtf(wave_sum(ss) * (1.0f / DM) + RMS_EPS);
        const int b = m >> 12;
        const f32x4* sh = (const f32x4*)(mod + (size_t)b * NMOD + 0 * DM) + lane; const f32x4* ga = (const f32x4*)(mod + (size_t)b * NMOD + 1 * DM) + lane;
        v2u* o8 = (v2u*)(h + (size_t)m * DM) + lane; float mx = 0.f;
#pragma unroll
        for (int j = 0; j < 16; ++j) { const f32x4 o = (v[j] * rstd) * ga[64 * j] + sh[64 * j]; o8[64 * j] = (v2u){pk_bf16(o.x, o.y), pk_bf16(o.z, o.w)}; v[j] = o;
            mx = fmaxf(mx, fmaxf(fmaxf(fabsf(o.x), fabsf(o.y)), fmaxf(fabsf(o.z), fabsf(o.w))));
            if ((j & 3) == 3) asm volatile("" ::: "memory"); }
#pragma unroll
        for (int o = 1; o < 64; o <<= 1) mx = fmaxf(mx, __shfl_xor(mx, o));
        const float inv = mx > 0.f ? 127.0f / mx : 0.f;
        if (lane == 0) sa[m] = mx * (1.0f / 127.0f);
        unsigned* o4 = (unsigned*)(hq + (size_t)m * DM) + lane;
#pragma unroll
        for (int j = 0; j < 16; ++j) { const int q0 = (int)__builtin_rintf(v[j].x * inv), q1 = (int)__builtin_rintf(v[j].y * inv), q2 = (int)__builtin_rintf(v[j].z * inv), q3 = (int)__builtin_rintf(v[j].w * inv);
            o4[64 * j] = (unsigned)(q0 & 255) | ((unsigned)(q1 & 255) << 8) | ((unsigned)(q2 & 255) << 16) | ((unsigned)(q3 & 255) << 24); }
    }
}
__device__ __forceinline__ void p7_mid_rows(const float* __restrict__ x, const bf16* __restrict__ y, const float* __restrict__ ssq, const float* __restrict__ mod, float* __restrict__ x1, signed char* __restrict__ h2q, float* __restrict__ sa, int gw, int NGW, int lane) {
    for (int m = gw; m < M; m += NGW) {
        const float rstd1 = 1.0f / sqrtf(wave_sum(ssq[(size_t)m * 64 + lane]) * (1.0f / DM) + RMS_EPS);
        const int b = m >> 12;
        const v2u* yr = (const v2u*)(y + (size_t)m * DM) + lane; const f32x4* xr = (const f32x4*)(x + (size_t)m * DM) + lane;
        const f32x4* gp = (const f32x4*)(mod + (size_t)b * NMOD + 2 * DM) + lane;
        f32x4* x1r = (f32x4*)(x1 + (size_t)m * DM) + lane;
        f32x4 v[16]; float ss = 0.f;
#pragma unroll
        for (int j = 0; j < 16; ++j) { const v2u yw = __builtin_nontemporal_load(yr + 64 * j); const f32x4 yv = {bf_lo(yw.x), bf_hi(yw.x), bf_lo(yw.y), bf_hi(yw.y)};
            v[j] = __builtin_nontemporal_load(xr + 64 * j) + (yv * rstd1) * gp[64 * j]; x1r[64 * j] = v[j];
            ss += (v[j].x * v[j].x + v[j].y * v[j].y) + (v[j].z * v[j].z + v[j].w * v[j].w);
            if ((j & 3) == 3) asm volatile("" ::: "memory"); }
        const float rstd2 = 1.0f / sqrtf(wave_sum(ss) * (1.0f / DM) + RMS_EPS);
        const f32x4* sh = (const f32x4*)(mod + (size_t)b * NMOD + 3 * DM) + lane; const f32x4* ga = (const f32x4*)(mod + (size_t)b * NMOD + 4 * DM) + lane;
        float mx = 0.f;
#pragma unroll
        for (int j = 0; j < 16; ++j) { v[j] = (v[j] * rstd2) * ga[64 * j] + sh[64 * j];
            mx = fmaxf(mx, fmaxf(fmaxf(fabsf(v[j].x), fabsf(v[j].y)), fmaxf(fabsf(v[j].z), fabsf(v[j].w))));
            if ((j & 3) == 3) asm volatile("" ::: "memory"); }
#pragma unroll
        for (int o = 1; o < 64; o <<= 1) mx = fmaxf(mx, __shfl_xor(mx, o));
        const float inv = mx > 0.f ? 127.0f / mx : 0.f;
        if (lane == 0) sa[m] = mx * (1.0f / 127.0f);
        unsigned* o4 = (unsigned*)(h2q + (size_t)m * DM) + lane;
#pragma unroll
        for (int j = 0; j < 16; ++j) { const int q0 = (int)__builtin_rintf(v[j].x * inv), q1 = (int)__builtin_rintf(v[j].y * inv), q2 = (int)__builtin_rintf(v[j].z * inv), q3 = (int)__builtin_rintf(v[j].w * inv);
            o4[64 * j] = (unsigned)(q0 & 255) | ((unsigned)(q1 & 255) << 8) | ((unsigned)(q2 & 255) << 16) | ((unsigned)(q3 & 255) << 24); }
    }
}
__device__ __forceinline__ void p10_final_rows(const bf16* __restrict__ f, const float* __restrict__ ssq, const float* __restrict__ mod, float* out, float* dst, int gw, int NGW, int lane) {
    v2u nf[16];
    if (gw < M) { const v2u* fr = (const v2u*)(f + (size_t)gw * DM) + lane;
#pragma unroll
        for (int j = 0; j < 16; ++j) nf[j] = __builtin_nontemporal_load(fr + 64 * j); }
    for (int m = gw; m < M; m += NGW) {
        const float rstd = 1.0f / sqrtf(wave_sum(ssq[(size_t)m * 64 + lane]) * (1.0f / DM) + RMS_EPS);
        const int b = m >> 12;
        const f32x4* gp = (const f32x4*)(mod + (size_t)b * NMOD + 5 * DM) + lane;
        const f32x4* orow = (const f32x4*)(out + (size_t)m * DM) + lane; f32x4* drow = (f32x4*)(dst + (size_t)m * DM) + lane;
        f32x4 v[16];
#pragma unroll
        for (int j = 0; j < 16; ++j) { const v2u fw = nf[j]; const f32x4 fv = {bf_lo(fw.x), bf_hi(fw.x), bf_lo(fw.y), bf_hi(fw.y)}; v[j] = orow[64 * j] + (fv * rstd) * gp[64 * j];
            if ((j & 3) == 3) asm volatile("" ::: "memory"); }
        { const size_t mn = (size_t)((m + NGW < M) ? m + NGW : m); const v2u* fr = (const v2u*)(f + mn * DM) + lane;
#pragma unroll
            for (int j = 0; j < 16; ++j) nf[j] = __builtin_nontemporal_load(fr + 64 * j); }
#pragma unroll
        for (int j = 0; j < 16; ++j) __builtin_nontemporal_store(v[j], drow + 64 * j);
    }
}

namespace att {
constexpr int KSTR = 272, VSTR = 520, K_OFF = 0, V_OFF = 256 * KSTR, END_OFF = V_OFF + 128 * VSTR;
static_assert(END_OFF <= LDSCTL_OFF, "attention LDS");
__device__ __forceinline__ void attn_unit(LAS unsigned char* lds, const bf16* __restrict__ Z, bf16* __restrict__ AO, const float* __restrict__ sinks, int unit, int tid) {
    const int b = unit >> 7, rem = unit & 127, n = rem >> 2, kvh = rem & 3;
    const int m0 = b * SEQ + n * 128;
#pragma unroll
    for (int it = 0; it < 8; ++it) { const int kk = (tid >> 4) + 32 * it, dc = tid & 15;
        v4u v = {0u, 0u, 0u, 0u};
        if (n > 0 || kk >= 128) v = *(const v4u*)(Z + (size_t)(m0 - 128 + kk) * INW + pg8::ZO_K + kvh * 128 + dc * 8);
        *(LAS v4u*)(lds + K_OFF + kk * KSTR + dc * 16) = v; }
#pragma unroll
    for (int it = 0; it < 8; ++it) { const int kk = tid & 255, dc = (tid >> 8) + 2 * it;
        v4u v = {0u, 0u, 0u, 0u};
        if (n > 0 || kk >= 128) v = *(const v4u*)(Z + (size_t)(m0 - 128 + kk) * INW + pg8::ZO_V + kvh * 128 + dc * 8);
        LAS unsigned char* vp = lds + V_OFF + (dc * 8) * VSTR + kk * 2;
        *(LAS unsigned short*)(vp + 0 * VSTR) = (unsigned short)(v.x & 0xffffu); *(LAS unsigned short*)(vp + 1 * VSTR) = (unsigned short)(v.x >> 16);
        *(LAS unsigned short*)(vp + 2 * VSTR) = (unsigned short)(v.y & 0xffffu); *(LAS unsigned short*)(vp + 3 * VSTR) = (unsigned short)(v.y >> 16);
        *(LAS unsigned short*)(vp + 4 * VSTR) = (unsigned short)(v.z & 0xffffu); *(LAS unsigned short*)(vp + 5 * VSTR) = (unsigned short)(v.z >> 16);
        *(LAS unsigned short*)(vp + 6 * VSTR) = (unsigned short)(v.w & 0xffffu); *(LAS unsigned short*)(vp + 7 * VSTR) = (unsigned short)(v.w >> 16); }
    __syncthreads();
    const int wid = tid >> 6, lane = tid & 63, r = lane & 31, h = lane >> 5;
    const int hf = wid & 1, head = kvh * 4 + (wid >> 1);
    const float sink = sinks[head];
    constexpr float SCALE = 0.08838834764831845f, LOG2E = 1.4426950408889634f;
#pragma unroll 1
    for (int qt = 0; qt < 2; ++qt) {
        const int ql0 = hf * 64 + qt * 32;
        const size_t mq = (size_t)(m0 + ql0 + r);
        bf16x8 qf[8];
#pragma unroll
        for (int ks = 0; ks < 8; ++ks) qf[ks] = *(const bf16x8*)(Z + mq * INW + pg8::ZO_Q + head * 128 + ks * 16 + 8 * h);
        f32x16 S[5];
#pragma unroll
        for (int kt = 0; kt < 5; ++kt) {
#pragma unroll
            for (int i = 0; i < 16; ++i) S[kt][i] = 0.f;
#pragma unroll
            for (int ks = 0; ks < 8; ++ks) { const bf16x8 kf = *(const LAS bf16x8*)(lds + K_OFF + (ql0 + 32 * kt + r) * KSTR + (ks * 16 + 8 * h) * 2);
                S[kt] = __builtin_amdgcn_mfma_f32_32x32x16_bf16(kf, qf[ks], S[kt], 0, 0, 0); } }
        float mx = sink;
#pragma unroll
        for (int kt = 0; kt < 5; ++kt)
#pragma unroll
            for (int i = 0; i < 16; ++i) { const int cr = (i & 3) + 8 * (i >> 2) + 4 * h;
                const int diff = 128 + r - 32 * kt - cr;
                const bool valid = ((unsigned)diff < 128u) && (n > 0 || (ql0 + 32 * kt + cr) >= 128);
                const float s = valid ? S[kt][i] * SCALE : -__builtin_inff();
                S[kt][i] = s; mx = fmaxf(mx, s); }
        mx = fmaxf(mx, __shfl_xor(mx, 32));
        float sum = 0.f;
#pragma unroll
        for (int kt = 0; kt < 5; ++kt)
#pragma unroll
            for (int i = 0; i < 16; ++i) { const float p = __builtin_amdgcn_exp2f((S[kt][i] - mx) * LOG2E); S[kt][i] = p; sum += p; }
        sum += __shfl_xor(sum, 32);
        const float inv = 1.0f / (sum + __builtin_amdgcn_exp2f((sink - mx) * LOG2E));
        f32x16 O[4];
#pragma unroll
        for (int dt = 0; dt < 4; ++dt)
#pragma unroll
            for (int i = 0; i < 16; ++i) O[dt][i] = 0.f;
#pragma unroll
        for (int kt = 0; kt < 5; ++kt)
#pragma unroll
            for (int s = 0; s < 2; ++s) {
                v4u pw; pw.x = pk_bf16(S[kt][8 * s + 0], S[kt][8 * s + 1]); pw.y = pk_bf16(S[kt][8 * s + 2], S[kt][8 * s + 3]);
                pw.z = pk_bf16(S[kt][8 * s + 4], S[kt][8 * s + 5]); pw.w = pk_bf16(S[kt][8 * s + 6], S[kt][8 * s + 7]);
                const bf16x8 pf = __builtin_bit_cast(bf16x8, pw);
#pragma unroll
                for (int dt = 0; dt < 4; ++dt) { const LAS unsigned char* vp = lds + V_OFF + (dt * 32 + r) * VSTR + (ql0 + 32 * kt + 16 * s + 4 * h) * 2;
                    const s16x4 lo = *(const LAS s16x4*)vp, hi = *(const LAS s16x4*)(vp + 16);
                    const bf16x8 vf = __builtin_shufflevector(lo, hi, 0, 1, 2, 3, 4, 5, 6, 7);
                    O[dt] = __builtin_amdgcn_mfma_f32_32x32x16_bf16(vf, pf, O[dt], 0, 0, 0); } }
        bf16* op = AO + mq * 4096 + 2048 + head * 128 + 4 * h;
#pragma unroll
        for (int dt = 0; dt < 4; ++dt)
#pragma unroll
            for (int gq = 0; gq < 4; ++gq)
                *(v2u*)(op + dt * 32 + 8 * gq) = (v2u){pk_bf16(O[dt][4 * gq] * inv, O[dt][4 * gq + 1] * inv), pk_bf16(O[dt][4 * gq + 2] * inv, O[dt][4 * gq + 3] * inv)};
    }
    __syncthreads();
}
}

namespace sgu {
constexpr int VN_STR = 272, IMG = 128 * VN_STR, NU = 4, STAT_OFF = NU * IMG;
static_assert(STAT_OFF + 1024 <= LDSCTL_OFF, "sgu LDS");
__device__ __forceinline__ void sgu_batch(LAS unsigned char* lds, const bf16* __restrict__ Z, const float* __restrict__ svstat, const float* __restrict__ ln_g, const float* __restrict__ ln_b,
                                          const bf16* __restrict__ Wb, const float* __restrict__ bs, bf16* __restrict__ SO, int chunk, int g0, int tid) {
    const int m0 = chunk * 128;
    LAS float* st = (LAS float*)(lds + STAT_OFF);
    const int s = tid & 127, cq = tid >> 7;
    v4u sv[NU][4];
#pragma unroll
    for (int u = 0; u < NU; ++u)
#pragma unroll
        for (int it = 0; it < 4; ++it) sv[u][it] = *(const v4u*)(Z + (size_t)(m0 + s) * INW + pg8::ZO_SV + (g0 + u) * 128 + (cq + 4 * it) * 8);
    {
        const int row = tid >> 2, q = tid & 3; const f32x4* p = (const f32x4*)(svstat + (size_t)(m0 + row) * 64) + 4 * q; float s1 = 0.f, s2 = 0.f;
#pragma unroll
        for (int i = 0; i < 4; ++i) { const f32x4 v = p[i]; s1 += v.x + v.z; s2 += v.y + v.w; }
        s1 += __shfl_xor(s1, 1); s2 += __shfl_xor(s2, 1); s1 += __shfl_xor(s1, 2); s2 += __shfl_xor(s2, 2);
        const float mu = s1 * (1.0f / 2048.0f), var = fmaxf(s2 * (1.0f / 2048.0f) - mu * mu, 0.f);
        if (q == 0) { st[row] = mu; st[128 + row] = 1.0f / sqrtf(var + LN_EPS); }
    }
    __syncthreads();
    const float mu = st[s], rs = st[128 + s];
#pragma unroll
    for (int u = 0; u < NU; ++u)
#pragma unroll
        for (int it = 0; it < 4; ++it) { const int cc = cq + 4 * it; const v4u v = sv[u][it];
            const float* gp = ln_g + (g0 + u) * 128 + cc * 8; const float* bp = ln_b + (g0 + u) * 128 + cc * 8;
            LAS unsigned char* vp = lds + u * IMG + (cc * 8) * VN_STR + s * 2;
            const float x0 = bf_lo(v.x), x1 = bf_hi(v.x), x2 = bf_lo(v.y), x3 = bf_hi(v.y), x4 = bf_lo(v.z), x5 = bf_hi(v.z), x6 = bf_lo(v.w), x7 = bf_hi(v.w);
            *(LAS unsigned short*)(vp + 0 * VN_STR) = (unsigned short)(pk_bf16((x0 - mu) * rs * gp[0] + bp[0], 0.f) & 0xffffu);
            *(LAS unsigned short*)(vp + 1 * VN_STR) = (unsigned short)(pk_bf16((x1 - mu) * rs * gp[1] + bp[1], 0.f) & 0xffffu);
            *(LAS unsigned short*)(vp + 2 * VN_STR) = (unsigned short)(pk_bf16((x2 - mu) * rs * gp[2] + bp[2], 0.f) & 0xffffu);
            *(LAS unsigned short*)(vp + 3 * VN_STR) = (unsigned short)(pk_bf16((x3 - mu) * rs * gp[3] + bp[3], 0.f) & 0xffffu);
            *(LAS unsigned short*)(vp + 4 * VN_STR) = (unsigned short)(pk_bf16((x4 - mu) * rs * gp[4] + bp[4], 0.f) & 0xffffu);
            *(LAS unsigned short*)(vp + 5 * VN_STR) = (unsigned short)(pk_bf16((x5 - mu) * rs * gp[5] + bp[5], 0.f) & 0xffffu);
            *(LAS unsigned short*)(vp + 6 * VN_STR) = (unsigned short)(pk_bf16((x6 - mu) * rs * gp[6] + bp[6], 0.f) & 0xffffu);
            *(LAS unsigned short*)(vp + 7 * VN_STR) = (unsigned short)(pk_bf16((x7 - mu) * rs * gp[7] + bp[7], 0.f) & 0xffffu); }
    __syncthreads();
    const int wid = tid >> 6, lane = tid & 63, i = lane & 15, quad = lane >> 4, tb = 16 * wid;
    const int t = tb + i; const size_t row = (size_t)(m0 + t);
#pragma unroll 1
    for (int u = 0; u < NU; ++u) { const int g = g0 + u;
        v2u sw[8];
#pragma unroll
        for (int ct = 0; ct < 8; ++ct) sw[ct] = *(const v2u*)(Z + row * INW + pg8::ZO_SU + g * 128 + ct * 16 + quad * 4);
        const float bias = bs[g * 128 + t];
        f32x4 acc[8];
#pragma unroll
        for (int ct = 0; ct < 8; ++ct) acc[ct] = (f32x4){0.f, 0.f, 0.f, 0.f};
#pragma unroll
        for (int ks = 0; ks < 4; ++ks) {
            if (32 * ks <= tb + 15) {
                const bf16x8 wf = *(const bf16x8*)(Wb + (size_t)(g * 128 + tb + i) * 128 + ks * 32 + quad * 8);
#pragma unroll
                for (int ct = 0; ct < 8; ++ct) { const bf16x8 vf = *(const LAS bf16x8*)(lds + u * IMG + (ct * 16 + i) * VN_STR + (ks * 32 + quad * 8) * 2);
                    acc[ct] = __builtin_amdgcn_mfma_f32_16x16x32_bf16(vf, wf, acc[ct], 0, 0, 0); } } }
#pragma unroll
        for (int ct = 0; ct < 8; ++ct) { const int c = g * 128 + ct * 16 + quad * 4;
            const float o0 = bf_lo(sw[ct].x) * (acc[ct][0] + bias), o1 = bf_hi(sw[ct].x) * (acc[ct][1] + bias), o2 = bf_lo(sw[ct].y) * (acc[ct][2] + bias), o3 = bf_hi(sw[ct].y) * (acc[ct][3] + bias);
            *(v2u*)(SO + row * 4096 + c) = (v2u){pk_bf16(o0, o1), pk_bf16(o2, o3)}; }
    }
    __syncthreads();
}
}

#ifndef MK_N_LAUNCHES
#define MK_N_LAUNCHES 1
#endif
constexpr int N_PHASES = 11, N_LAUNCHES = MK_N_LAUNCHES;
struct Args { const void* in[21]; float* out; unsigned char* ws; int ph_lo, ph_hi; };
static_assert(sizeof(Args) == 21 * 8 + 8 + 8 + 8, "Args has no holes");

typedef const __attribute__((address_space(4))) unsigned char* kargp_t;
#define KP_REFRESH() kargp_t kp = C.kbase; asm volatile("" : "+s"(kp))
#define KIN(T, i) (*(T* const __attribute__((address_space(4)))*)(kp + 8 * (i)))
#define KOUT() (*(float* const __attribute__((address_space(4)))*)(kp + 8 * 21))
#define KWS() (*(unsigned char* const __attribute__((address_space(4)))*)(kp + 8 * 22))
struct Ctx { kargp_t kbase; LAS unsigned char* lds; int wave, G, bx, gw, NGW; };
#define TID_HERE() int lane_; asm volatile("v_mbcnt_lo_u32_b32 %0, -1, 0\n\tv_mbcnt_hi_u32_b32 %0, -1, %0" : "=v"(lane_)); const int tid_ = C.wave * 64 + lane_
__device__ __forceinline__ void phase0(const Ctx& C) { KP_REFRESH(); unsigned char* ws = KWS();
    P0Args A; A.c = KIN(const float, 1); A.w_ada = KIN(const float, 3); A.w_in = KIN(const float, 6); A.sgu_w = KIN(const float, 10); A.w_ps = KIN(const float, 12); A.w_pa = KIN(const float, 13);
    A.w_out = KIN(const float, 14); A.w_gate = KIN(const float, 17); A.w_up = KIN(const float, 18); A.w_down = KIN(const float, 19); A.positions = KIN(const int, 2);
    A.modp = (float*)(ws + WS_MODP); A.ropeC = (float*)(ws + WS_ROPEC); A.ropeS = (float*)(ws + WS_ROPES); A.sguw = (bf16*)(ws + WS_SGUW);
    A.win_t = (bf16*)(ws + WS_WIN); A.wps_t = (bf16*)(ws + WS_WPS); A.wpa_t = (bf16*)(ws + WS_WPA); A.wout_t = (bf16*)(ws + WS_WOUT); A.wgu_t = (bf16*)(ws + WS_WGU); A.wdn_t = (bf16*)(ws + WS_WDN);
    TID_HERE(); (void)tid_; p0_prologue(A, C.lds, C.gw, C.NGW, C.wave, lane_); }
__device__ __forceinline__ void phase1(const Ctx& C) { KP_REFRESH(); unsigned char* ws = KWS(); TID_HERE();
    p1_mod_reduce((const float*)(ws + WS_MODP), KIN(const float, 4), KIN(const float, 5), KIN(const float, 15), KIN(const float, 16), KIN(const float, 20), (float*)(ws + WS_MOD), C.bx * (NWAVES * 64) + tid_, C.G * NWAVES * 64);
    p1_quant_wrows((const bf16*)(ws + WS_WGU), (signed char*)(ws + WS_WQ), (float*)(ws + WS_SBW), NGU, C.gw, C.NGW, lane_);
    p1_quant_wrows((const bf16*)(ws + WS_WIN) + (size_t)7168 * DM, (signed char*)(ws + WS_WQIN + (size_t)2048 * DM), (float*)(ws + WS_SBWIN) + 2048, 8192, C.gw, C.NGW, lane_);
    p1_quant_wdown_h32((const bf16*)(ws + WS_WDN), (signed char*)(ws + WS_WDQ), (float*)(ws + WS_SBWD), C.gw, C.NGW, lane_); }
__device__ __forceinline__ void phase2(const Ctx& C) { KP_REFRESH(); unsigned char* ws = KWS(); TID_HERE(); (void)tid_; p2_norm_rows(KIN(const float, 0), (const float*)(ws + WS_MOD), (bf16*)(ws + WS_A), (signed char*)(ws + WS_HQ), (float*)(ws + WS_SA1), C.gw, C.NGW, lane_); }
__device__ __forceinline__ void phase3(const Ctx& C) {
    { KP_REFRESH(); unsigned char* ws = KWS();
      pg8::Gemm g{(const bf16*)(ws + WS_A), (const bf16*)(ws + WS_WIN), M, 7168, DM}; pg8::StaticOrder S; S.init(M, 7168, C.G, C.bx);
      pg8::EpiZ E{(bf16*)(ws + WS_Z), (const float*)(ws + WS_ROPEC), (const float*)(ws + WS_ROPES), (float*)(ws + WS_SVSTAT)};
      TID_HERE(); pg8::gemm_phase<pg8::EpiZ, pg8::StaticOrder, true, true>(C.lds, g, S, E, tid_); }
    { KP_REFRESH(); unsigned char* ws = KWS();
      pg8::Gemm g{(const bf16*)(ws + WS_HQ), (const bf16*)(ws + WS_WQIN + (size_t)2048 * DM), M, 8192, DM / 2}; pg8::StaticOrder S; S.init(M, 8192, C.G, C.bx);
      pg8::EpiGateI8 E{(bf16*)(ws + WS_Z), (const float*)(ws + WS_SA1), (const float*)(ws + WS_SBWIN) + 2048};
      TID_HERE(); pg8::gemm_phase<pg8::EpiGateI8, pg8::StaticOrder, true, true, true>(C.lds, g, S, E, tid_); } }
__device__ __forceinline__ void phase4(const Ctx& C) { KP_REFRESH(); unsigned char* ws = KWS(); TID_HERE();
    { const bf16* Zb = (const bf16*)(ws + WS_Z); bf16* AO = (bf16*)(ws + WS_B); const float* sinks = KIN(const float, 7);
      for (int u = C.bx; u < 512; u += C.G) att::attn_unit(C.lds, Zb, AO, sinks, u, tid_); }
    { const bf16* Zb = (const bf16*)(ws + WS_Z); bf16* SO = (bf16*)(ws + WS_B);
      const float* svstat = (const float*)(ws + WS_SVSTAT); const float* ln_g = KIN(const float, 8); const float* ln_b = KIN(const float, 9); const float* sb = KIN(const float, 11); const bf16* sguw = (const bf16*)(ws + WS_SGUW);
      for (int bt = C.bx; bt < 512; bt += C.G) sgu::sgu_batch(C.lds, Zb, svstat, ln_g, ln_b, sguw, sb, SO, bt >> 2, 4 * (bt & 3), tid_); } }
__device__ __forceinline__ void phase5(const Ctx& C) { KP_REFRESH(); unsigned char* ws = KWS();
    pg8::Gemm g{(const bf16*)(ws + WS_B), (const bf16*)(ws + WS_WPS), M, DM, DM}; pg8::StaticOrder S; S.init(M, DM, C.G, C.bx); pg8::EpiMerge E{(bf16*)(ws + WS_A), (const bf16*)(ws + WS_Z)};
    TID_HERE(); pg8::gemm_phase<pg8::EpiMerge, pg8::StaticOrder, true, true>(C.lds, g, S, E, tid_); }
__device__ __forceinline__ void phase6(const Ctx& C) { KP_REFRESH(); unsigned char* ws = KWS();
    pg8::Gemm g{(const bf16*)(ws + WS_A), (const bf16*)(ws + WS_WOUT), M, DM, DM}; pg8::StaticOrder S; S.init(M, DM, C.G, C.bx); pg8::EpiStats E{(bf16*)(ws + WS_B), (float*)(ws + WS_SSQ)};
    TID_HERE(); pg8::gemm_phase<pg8::EpiStats, pg8::StaticOrder, true, true>(C.lds, g, S, E, tid_); }
__device__ __forceinline__ void phase7(const Ctx& C) { KP_REFRESH(); unsigned char* ws = KWS(); TID_HERE(); (void)tid_;
    p7_mid_rows(KIN(const float, 0), (const bf16*)(ws + WS_B), (const float*)(ws + WS_SSQ), (const float*)(ws + WS_MOD), KOUT(), (signed char*)(ws + WS_A), (float*)(ws + WS_SA), C.gw, C.NGW, lane_); }
__device__ __forceinline__ void phase8(const Ctx& C) { KP_REFRESH(); unsigned char* ws = KWS();
    pg8::Gemm g{(const bf16*)(ws + WS_A), (const bf16*)(ws + WS_WQ), M, NGU, DM / 2}; pg8::StaticOrder S; S.init(M, NGU, C.G, C.bx);
    pg8::EpiSwiGLU_I8H E{(bf16*)(ws + WS_Z), (const float*)(ws + WS_SA), (const float*)(ws + WS_SBW)};
    TID_HERE(); pg8::gemm_phase<pg8::EpiSwiGLU_I8H, pg8::StaticOrder, true, true, true>(C.lds, g, S, E, tid_); }
__device__ __forceinline__ void phase8b(const Ctx& C) { KP_REFRESH(); unsigned char* ws = KWS(); TID_HERE(); (void)tid_;
    p8b_quant_hid_rows((const bf16*)(ws + WS_Z), (signed char*)(ws + WS_HIDQ), (float*)(ws + WS_SA), C.gw, C.NGW, lane_); }
#ifndef PROBE_DELAY
#define PROBE_DELAY 0
#endif
__device__ __forceinline__ void phase9(const Ctx& C, unsigned long long& dcyc, unsigned long long& dreal) { KP_REFRESH(); unsigned char* ws = KWS();
    pg8::Gemm g{(const bf16*)(ws + WS_HIDQ), (const bf16*)(ws + WS_WDQ), M, DM, FF / 2}; pg8::StaticOrder S; S.init(M, DM, C.G, C.bx);
    pg8::EpiStatsI8 E{(bf16*)(ws + WS_Z), (float*)(ws + WS_SSQ), (const float*)(ws + WS_SA), (const float*)(ws + WS_SBWD)};
    const unsigned long long t0 = PROBE_DELAY ? __builtin_amdgcn_s_memtime() : 0ull, r0 = PROBE_DELAY ? __builtin_amdgcn_s_memrealtime() : 0ull;
    TID_HERE(); pg8::gemm_phase<pg8::EpiStatsI8, pg8::StaticOrder, true, true, true>(C.lds, g, S, E, tid_);
    if (PROBE_DELAY) { dcyc = __builtin_amdgcn_s_memtime() - t0; dreal = __builtin_amdgcn_s_memrealtime() - r0; } }
__device__ __forceinline__ void phase10(const Ctx& C) { KP_REFRESH(); unsigned char* ws = KWS(); TID_HERE(); (void)tid_;
    p10_final_rows((const bf16*)(ws + WS_Z), (const float*)(ws + WS_SSQ), (const float*)(ws + WS_MOD), KOUT(), KOUT(), C.gw, C.NGW, lane_); }
__device__ __forceinline__ void phase10_dry(const Ctx& C) { KP_REFRESH(); unsigned char* ws = KWS(); TID_HERE(); (void)tid_;
    p10_final_rows((const bf16*)(ws + WS_Z), (const float*)(ws + WS_SSQ), (const float*)(ws + WS_MOD), KOUT(), (float*)(ws + WS_Z) + (size_t)M * DM, C.gw, C.NGW, lane_); }
#ifndef PROBE_EXTRA
#define PROBE_EXTRA 0
#endif

#ifndef PROBE_REPEAT_MASK
#define PROBE_REPEAT_MASK 0u
#endif
__global__ void __launch_bounds__(NWAVES * 64, 2) fwd(Args args) {
    extern __shared__ __attribute__((aligned(16))) unsigned char lds_raw[];
    Ctx C; C.lds = (LAS unsigned char*)lds_raw; C.kbase = (kargp_t)__builtin_amdgcn_kernarg_segment_ptr();
    const int tid0 = threadIdx.x; C.wave = __builtin_amdgcn_readfirstlane(tid0 >> 6);
    C.G = gridDim.x; C.bx = blockIdx.x;
    const int vcu = (C.G % 8 == 0) ? (C.bx % 8) * (C.G / 8) + C.bx / 8 : C.bx;
    C.gw = vcu * NWAVES + C.wave; C.NGW = C.G * NWAVES;
    const unsigned long long rt_start = PROBE_DELAY ? __builtin_amdgcn_s_memrealtime() : 0ull; unsigned long long rt_p0 = 0ull;
    for (int u = tid0; u < (LDS_BYTES - LDSCTL_OFF) / 4; u += NWAVES * 64) ((LAS unsigned*)(C.lds + LDSCTL_OFF))[u] = 0u;
    __syncthreads();
    XcdBarrier bar; bar.bar = (unsigned*)(args.ws + WS_CTL) + CW_BAR; bar.x = 0; bar.st = nullptr;
    if (N_LAUNCHES == 1) bar = xcd_barrier_post((unsigned*)(args.ws + WS_CTL) + CW_BAR, (volatile LAS unsigned*)(C.lds + LDSCTL_OFF));
    const int lo = (N_LAUNCHES == 1) ? 0 : args.ph_lo, hi = (N_LAUNCHES == 1) ? N_PHASES : args.ph_hi;
#define IN(k) (lo <= (k) && (k) < hi)
#define RUN(k, call) do { if (IN(k)) { call; if (N_LAUNCHES == 1 && ((PROBE_REPEAT_MASK >> (k)) & 1u)) { xcd_barrier(bar); call; } } if (IN(k) && IN((k) + 1)) xcd_barrier(bar); } while (0)
#define STAMP(k) do { if (PROBE_DELAY == 10 + (k)) rt_p0 = __builtin_amdgcn_s_memrealtime() - rt_start; } while (0)
    RUN(0, phase0(C)); if (PROBE_DELAY == 4) rt_p0 = __builtin_amdgcn_s_memrealtime() - rt_start; STAMP(0);
    RUN(1, phase1(C)); STAMP(1); RUN(2, phase2(C)); STAMP(2); RUN(3, phase3(C)); STAMP(3); RUN(4, phase4(C)); STAMP(4); RUN(5, phase5(C)); STAMP(5);
    RUN(6, phase6(C)); STAMP(6); RUN(7, phase7(C)); STAMP(7);
    if (PROBE_EXTRA == 3) { const unsigned long long r0 = __builtin_amdgcn_s_memrealtime(); while (__builtin_amdgcn_s_memrealtime() - r0 < 40000ull) __builtin_amdgcn_s_sleep(32); }
    RUN(8, phase8(C)); STAMP(8); if (N_LAUNCHES == 1) { phase8b(C); xcd_barrier(bar); } unsigned long long dcyc = 0, dreal = 1; RUN(9, phase9(C, dcyc, dreal)); STAMP(9);
    if (PROBE_EXTRA == 1) { phase10_dry(C); xcd_barrier(bar); }
    if (PROBE_EXTRA == 2) { for (int i = 0; i < 10; ++i) xcd_barrier(bar); }
    RUN(10, phase10(C));
    if (PROBE_DELAY) {
        const unsigned long long r0 = __builtin_amdgcn_s_memrealtime();
        const unsigned long long ticks = (PROBE_DELAY == 1) ? (dcyc / 688ull) * 100ull : (PROBE_DELAY == 2) ? ((dcyc * 100ull) / dreal) * 100ull : (PROBE_DELAY == 3) ? (r0 - rt_start) : rt_p0;
        while (__builtin_amdgcn_s_memrealtime() - r0 < ticks && __builtin_amdgcn_s_memrealtime() - r0 < 2000000ull) __builtin_amdgcn_s_sleep(32);
    }
#undef IN
#undef RUN
}

extern "C" void kernel_launch(void* const* d_in, const int* in_sizes, int n_in, void* d_out, int out_size, void* d_ws, size_t ws_size, hipStream_t stream) {
    static int grid = 0;
    if (grid == 0) {
        if (n_in != 21 || in_sizes[0] != M * DM || out_size != M * DM || ws_size < WS_END) {
            fprintf(stderr, "kernel_launch: built for 21 inputs, x/out of %d floats, >= %zu bytes of workspace; got n_in %d, in0 %d, out %d, ws %zu; nothing launched\n", M * DM, (size_t)WS_END, n_in, n_in > 0 ? in_sizes[0] : -1, out_size, ws_size);
            grid = -1; return; }
        int dev = 0, cus = 0, per_cu = 0;
        if (hipGetDevice(&dev) != hipSuccess || hipDeviceGetAttribute(&cus, hipDeviceAttributeMultiprocessorCount, dev) != hipSuccess) { fprintf(stderr, "kernel_launch: device query failed\n"); grid = -1; return; }
        if (hipFuncSetAttribute((const void*)fwd, hipFuncAttributeMaxDynamicSharedMemorySize, LDS_BYTES) != hipSuccess) { fprintf(stderr, "kernel_launch: hipFuncSetAttribute failed\n"); grid = -1; return; }
        if (hipOccupancyMaxActiveBlocksPerMultiprocessor(&per_cu, (const void*)fwd, NWAVES * 64, LDS_BYTES) != hipSuccess || per_cu < 1)
            fprintf(stderr, "kernel_launch: note: occupancy query reports %d workgroups per CU\n", per_cu);
        (void)hipGetLastError();
        grid = cus;
    }
    if (grid < 0) return;
    if (hipMemsetAsync((char*)d_ws + WS_CTL, 0, CTL_ZERO_BYTES, stream) != hipSuccess) { fprintf(stderr, "kernel_launch: hipMemsetAsync failed\n"); return; }
    Args a{};
    for (int i = 0; i < 21; ++i) a.in[i] = d_in[i];
    a.out = (float*)d_out; a.ws = (unsigned char*)d_ws;
    if (N_LAUNCHES == 1) {
        a.ph_lo = 0; a.ph_hi = N_PHASES;
        hipLaunchKernelGGL(fwd, dim3(grid), dim3(NWAVES * 64), LDS_BYTES, stream, a);
    } else {
        for (int li = 0; li < N_PHASES; ++li) { a.ph_lo = li; a.ph_hi = li + 1; hipLaunchKernelGGL(fwd, dim3(grid), dim3(NWAVES * 64), LDS_BYTES, stream, a); }
    }
    const hipError_t le = hipPeekAtLastError();
    if (le != hipSuccess) fprintf(stderr, "kernel_launch: launch failed: %s (grid %d)\n", hipGetErrorName(le), grid);
}
```

```cpp
#include <hip/hip_runtime.h>
#include <cstdio>
#include <cstdint>
namespace pg8 {
#define PG8_LAS __attribute__((address_space(3)))
typedef unsigned short bf16_t;
typedef short bf16x8 __attribute__((ext_vector_type(8)));
typedef float f32x4 __attribute__((ext_vector_type(4)));
typedef unsigned u32x4 __attribute__((ext_vector_type(4)));
typedef unsigned u32x2 __attribute__((ext_vector_type(2)));
typedef int i32x4 __attribute__((ext_vector_type(4)));
constexpr int BM = 256, BK = 64, HALF = 128, HTB = HALF * BK * 2  , STAGE_BYTES = 8 * HTB, NXCD = 8, WGM = 8;

__host__ __device__ __forceinline__ int lds_byte(int r, int c) { const int st = (r >> 4) * 2 + (c >> 5), rr = r & 15, cc = c & 31, ob = rr * 64 + cc * 2; return st * 1024 + (ob ^ (((ob >> 9) & 1) << 5)); }
__host__ __device__ __forceinline__ void stage_rc(int b, int& R, int& C) { const int st = b / 1024, sb = b % 1024, swz = sb ^ (((sb >> 9) & 1) << 5); R = (st >> 1) * 16 + swz / 64; C = (st & 1) * 32 + (swz % 64) / 2; }
__host__ __device__ __forceinline__ int perm32(int rho) { const int n = rho >> 4, i = rho & 15; return 8 * (i >> 2) + 4 * n + (i & 3); }

struct Unit { int pm, pn; };
struct Gemm { const bf16_t* A; const bf16_t* Bt; int M, N, K; };

struct StaticOrder {
    int nM, nN, nwg, G, c;
    __host__ __device__ void init(int M, int N, int G_, int c_) { nM = M / BM; nN = N / BM; nwg = nM * nN; G = G_; c = c_; }
    __host__ __device__ bool next(int i, Unit& u) const {
        const long L = (long)i * G + c; if (L >= nwg) return false;
        int wgid = (int)L; { const int q = nwg / NXCD, r = nwg % NXCD, xcd = wgid % NXCD, off = wgid / NXCD; wgid = (xcd < r ? xcd * (q + 1) : r * (q + 1) + (xcd - r) * q) + off; }
        const int nig = WGM * nN, gid = wgid / nig, fm = gid * WGM, gsz = (nM - fm) < WGM ? (nM - fm) : WGM;
        u.pm = fm + ((wgid % nig) % gsz); u.pn = (wgid % nig) / gsz; return true;
    }
    __device__ __forceinline__ void a_ready(const Unit&) const {}
    __device__ __forceinline__ void done(const Unit&) const {}
};

__device__ __forceinline__ unsigned cvt_pk_bf16(float lo, float hi) { unsigned r; asm volatile("v_cvt_pk_bf16_f32 %0, %1, %2" : "=v"(r) : "v"(lo), "v"(hi)); return r; }
typedef float f32x2 __attribute__((ext_vector_type(2)));
__device__ __forceinline__ f32x2 gelu_pk(f32x2 v) {
    const f32x2 av = __builtin_elementwise_abs(v), d = av * 0.2316418882f + 1.0f;
    f32x2 t; t.x = __builtin_amdgcn_rcpf(d.x); t.y = __builtin_amdgcn_rcpf(d.y);
    f32x2 q = t * 0.5307027145f + (-0.7265760135f); q = q * t + 0.7107068705f; q = q * t + (-0.142248368f); q = q * t + 0.127414796f; q = q * t;
    const f32x2 s = (v * v) * (-0.72134752044f);
    f32x2 e; e.x = __builtin_amdgcn_exp2f(s.x); e.y = __builtin_amdgcn_exp2f(s.y);
    const f32x2 m = v * (q * e), r = v - m;
    f32x2 o; o.x = v.x < 0.f ? m.x : r.x; o.y = v.y < 0.f ? m.y : r.y; return o;
}

typedef float f32x2t __attribute__((ext_vector_type(2)));
typedef __bf16 bf16x2t __attribute__((ext_vector_type(2)));
__device__ __forceinline__ unsigned pk_bf16(float lo, float hi) { f32x2t v = {lo, hi}; bf16x2t b = __builtin_convertvector(v, bf16x2t); return __builtin_bit_cast(unsigned, b); }
__device__ __forceinline__ float bf_lo(unsigned w) { return __builtin_bit_cast(float, w << 16); }
__device__ __forceinline__ float bf_hi(unsigned w) { return __builtin_bit_cast(float, w & 0xffff0000u); }
__device__ __forceinline__ float sigmoid_f(float x) { return __builtin_amdgcn_rcpf(1.0f + __builtin_amdgcn_exp2f(-1.4426950408889634f * x)); }
__device__ __forceinline__ u32x4 pack8(const f32x4& a, const f32x4& b) { u32x4 w; w.x = pk_bf16(a[0], a[1]); w.y = pk_bf16(a[2], a[3]); w.z = pk_bf16(b[0], b[1]); w.w = pk_bf16(b[2], b[3]); return w; }
__device__ __forceinline__ void unpack8(const u32x4& w, f32x4& a, f32x4& b) { a = (f32x4){bf_lo(w.x), bf_hi(w.x), bf_lo(w.y), bf_hi(w.y)}; b = (f32x4){bf_lo(w.z), bf_hi(w.z), bf_lo(w.w), bf_hi(w.w)}; }

constexpr int Z_LD = 15360, ZO_Q = 0, ZO_K = 2048, ZO_V = 2560, ZO_SU = 3072, ZO_SV = 5120, ZO_GA = 7168, ZO_GB = 11264;

struct EpiZ {
    static constexpr bool PERM = true, AFTER_DRAIN = false, HAS_MID = false;
    bf16_t* Z; const float* ropeC; const float* ropeS; float* svstat;
    __device__ __forceinline__ void operator()(const f32x4 (&acc)[2][2][4][2], const Unit& u, int wr, int wc, int fr, int fq) const {
        const int pn = u.pn;
        const int mode = pn < 10 ? 0 : (pn < 12 ? 1 : (pn < 20 ? 2 : (pn < 28 ? 3 : 4)));
        const int row0 = u.pm * BM + wr * 64 + fr, col0 = pn * BM + wc * 32 + 8 * fq;
        const bool rot = (mode == 0) && (wc == 0);
        const float sgn = fq < 2 ? -1.0f : 1.0f;
#pragma unroll
        for (int aim = 0; aim < 4; ++aim) { const int ai = aim >> 1;
            f32x4 cs[4][4];
            if (rot) {
#pragma unroll
                for (int m = 2 * (aim & 1); m < 2 * (aim & 1) + 2; ++m) { const size_t ro = (size_t)(row0 + ai * HALF + m * 16) * 16 + 8 * (fq & 1);
                    cs[m][0] = *(const f32x4*)(ropeC + ro); cs[m][1] = *(const f32x4*)(ropeC + ro + 4); cs[m][2] = *(const f32x4*)(ropeS + ro); cs[m][3] = *(const f32x4*)(ropeS + ro + 4); }
                asm volatile("" ::: "memory");
            }
#pragma unroll
            for (int m = 2 * (aim & 1); m < 2 * (aim & 1) + 2; ++m) {
                const int row = row0 + ai * HALF + m * 16;
                bf16_t* rowp = Z + (size_t)row * Z_LD + col0;
                f32x4 c0 = {1.f, 1.f, 1.f, 1.f}, c1 = c0, s0 = {0.f, 0.f, 0.f, 0.f}, s1 = s0;
                if (rot) { c0 = cs[m][0]; c1 = cs[m][1]; s0 = cs[m][2]; s1 = cs[m][3]; }
                float t1 = 0.f, t2 = 0.f;
#pragma unroll
                for (int bj = 0; bj < 2; ++bj) {
                    f32x4 v0 = acc[ai][bj][m][0], v1 = acc[ai][bj][m][1];
                    if (rot) {
                        f32x4 o0, o1;
#pragma unroll
                        for (int j = 0; j < 4; ++j) { o0[j] = __shfl_xor(v0[j], 32); o1[j] = __shfl_xor(v1[j], 32); }
                        v0 = v0 * c0 + (o0 * s0) * sgn; v1 = v1 * c1 + (o1 * s1) * sgn;
                    } else if (mode == 2 || mode == 3) {
                        f32x2 a = gelu_pk((f32x2){v0[0], v0[1]}), b = gelu_pk((f32x2){v0[2], v0[3]}), c = gelu_pk((f32x2){v1[0], v1[1]}), d = gelu_pk((f32x2){v1[2], v1[3]});
                        v0 = (f32x4){a.x, a.y, b.x, b.y}; v1 = (f32x4){c.x, c.y, d.x, d.y};
                        if (mode == 3) {
#pragma unroll
                            for (int j = 0; j < 4; ++j) { t1 += v0[j] + v1[j]; t2 += v0[j] * v0[j] + v1[j] * v1[j]; } }
                    } else if (mode == 4) {
#pragma unroll
                        for (int j = 0; j < 4; ++j) { v0[j] = sigmoid_f(v0[j]); v1[j] = sigmoid_f(v1[j]); }
                    }
                    *(u32x4*)(rowp + bj * HALF) = pack8(v0, v1);
                }
                if (mode == 3) {
                    t1 += __shfl_xor(t1, 16); t1 += __shfl_xor(t1, 32); t2 += __shfl_xor(t2, 16); t2 += __shfl_xor(t2, 32);
                    if (fq == 0) *(f32x2*)(svstat + ((size_t)row * 32 + (pn - 20) * 4 + wc) * 2) = (f32x2){t1, t2};
                }
            }
        }
    }
};
struct EpiMerge {
    static constexpr bool PERM = true, AFTER_DRAIN = false, HAS_MID = true;
    bf16_t* T; const bf16_t* Z;
    __device__ __forceinline__ void mid(f32x4 (&acc)[2][2][4][2], const Unit& u, int wr, int wc, int fr, int fq) const {
        int row0 = u.pm * BM + wr * 64 + fr, col0 = u.pn * BM + wc * 32 + 8 * fq;
        asm volatile("" : "+v"(row0), "+v"(col0));
#pragma unroll
        for (int ai = 0; ai < 2; ++ai)
#pragma unroll
            for (int mp = 0; mp < 2; ++mp) {
                u32x4 aw[2][2], bw[2][2];
#pragma unroll
                for (int mm = 0; mm < 2; ++mm)
#pragma unroll
                    for (int bj = 0; bj < 2; ++bj) { const bf16_t* zp = Z + (size_t)(row0 + ai * HALF + (2 * mp + mm) * 16) * Z_LD + col0 + bj * HALF;
                        aw[mm][bj] = *(const u32x4*)(zp + ZO_GA); bw[mm][bj] = *(const u32x4*)(zp + ZO_GB); }
                asm volatile("" ::: "memory");
#pragma unroll
                for (int mm = 0; mm < 2; ++mm)
#pragma unroll
                    for (int bj = 0; bj < 2; ++bj) { f32x4 a0, a1, b0, b1; unpack8(aw[mm][bj], a0, a1); unpack8(bw[mm][bj], b0, b1); const int m = 2 * mp + mm;
#pragma unroll
                        for (int j = 0; j < 4; ++j) { acc[ai][bj][m][0][j] *= a0[j] * __builtin_amdgcn_rcpf(b0[j]); acc[ai][bj][m][1][j] *= a1[j] * __builtin_amdgcn_rcpf(b1[j]); } }
            }
    }
    __device__ __forceinline__ void operator()(const f32x4 (&acc)[2][2][4][2], const Unit& u, int wr, int wc, int fr, int fq) const {
        const int row0 = u.pm * BM + wr * 64 + fr, col0 = u.pn * BM + wc * 32 + 8 * fq;
#pragma unroll
        for (int ai = 0; ai < 2; ++ai) {
            u32x4 gw[4][2];
#pragma unroll
            for (int m = 0; m < 4; ++m)
#pragma unroll
                for (int bj = 0; bj < 2; ++bj) gw[m][bj] = *(const u32x4*)(Z + (size_t)(row0 + ai * HALF + m * 16) * Z_LD + ZO_GB + col0 + bj * HALF);
            asm volatile("" ::: "memory");
#pragma unroll
            for (int m = 0; m < 4; ++m)
#pragma unroll
                for (int bj = 0; bj < 2; ++bj) { f32x4 g0, g1; unpack8(gw[m][bj], g0, g1);
                    *(u32x4*)(T + (size_t)(row0 + ai * HALF + m * 16) * 4096 + col0 + bj * HALF) = pack8(acc[ai][bj][m][0] * g0, acc[ai][bj][m][1] * g1); }
            asm volatile("" ::: "memory");
        }
    }
};
struct EpiStats {
    static constexpr bool PERM = true, AFTER_DRAIN = false, HAS_MID = false;
    bf16_t* Y; float* ssq;
    __device__ __forceinline__ void operator()(const f32x4 (&acc)[2][2][4][2], const Unit& u, int wr, int wc, int fr, int fq) const {
        const int row0 = u.pm * BM + wr * 64 + fr, col0 = u.pn * BM + wc * 32 + 8 * fq;
#pragma unroll
        for (int ai = 0; ai < 2; ++ai)
#pragma unroll
            for (int m = 0; m < 4; ++m) { const int row = row0 + ai * HALF + m * 16; float t2 = 0.f;
#pragma unroll
                for (int bj = 0; bj < 2; ++bj) { const f32x4 v0 = acc[ai][bj][m][0], v1 = acc[ai][bj][m][1];
#pragma unroll
                    for (int j = 0; j < 4; ++j) t2 += v0[j] * v0[j] + v1[j] * v1[j];
                    *(u32x4*)(Y + (size_t)row * 4096 + col0 + bj * HALF) = pack8(v0, v1); }
                t2 += __shfl_xor(t2, 16); t2 += __shfl_xor(t2, 32);
                if (fq == 0) ssq[(size_t)row * 64 + u.pn * 4 + wc] = t2; }
    }
};
struct EpiStatsI8 {
    static constexpr bool PERM = true, AFTER_DRAIN = false, HAS_MID = false;
    bf16_t* Y; float* ssq; const float* sa; const float* sbw;
    __device__ __forceinline__ void operator()(const f32x4 (&acc)[2][2][4][2], const Unit& u, int wr, int wc, int fr, int fq) const {
        const int row0 = u.pm * BM + wr * 64 + fr, col0 = u.pn * BM + wc * 32 + 8 * fq;
        float sr[2][4]; f32x4 sc[2][2];
#pragma unroll
        for (int ai = 0; ai < 2; ++ai)
#pragma unroll
            for (int m = 0; m < 4; ++m) sr[ai][m] = sa[row0 + ai * HALF + m * 16];
#pragma unroll
        for (int bj = 0; bj < 2; ++bj)
#pragma unroll
            for (int n = 0; n < 2; ++n) sc[bj][n] = *(const f32x4*)(sbw + col0 + bj * HALF + 4 * n);
        asm volatile("" ::: "memory");
#pragma unroll
        for (int ai = 0; ai < 2; ++ai)
#pragma unroll
            for (int m = 0; m < 4; ++m) { const int row = row0 + ai * HALF + m * 16; const float s = sr[ai][m]; float t2 = 0.f;
#pragma unroll
                for (int bj = 0; bj < 2; ++bj) { f32x4 v0, v1; const i32x4 i0 = __builtin_bit_cast(i32x4, acc[ai][bj][m][0]), i1 = __builtin_bit_cast(i32x4, acc[ai][bj][m][1]);
#pragma unroll
                    for (int j = 0; j < 4; ++j) { v0[j] = (float)i0[j] * (s * sc[bj][0][j]); v1[j] = (float)i1[j] * (s * sc[bj][1][j]); t2 += v0[j] * v0[j] + v1[j] * v1[j]; }
                    *(u32x4*)(Y + (size_t)row * 4096 + col0 + bj * HALF) = pack8(v0, v1); }
                t2 += __shfl_xor(t2, 16); t2 += __shfl_xor(t2, 32);
                if (fq == 0) ssq[(size_t)row * 64 + u.pn * 4 + wc] = t2; }
    }
};
struct EpiSwiGLU_I8 {
    static constexpr bool PERM = true, AFTER_DRAIN = false, HAS_MID = false;
    bf16_t* H; const float* sa; const float* sbw;
    __device__ __forceinline__ void operator()(const f32x4 (&acc)[2][2][4][2], const Unit& u, int wr, int wc, int fr, int fq) const {
        const int row0 = u.pm * BM + wr * 64 + fr, col0 = u.pn * HALF + wc * 32 + 8 * fq, wrow0 = u.pn * BM + wc * 32 + 8 * fq;
        float sr[2][4]; f32x4 sg[2], su[2];
#pragma unroll
        for (int ai = 0; ai < 2; ++ai)
#pragma unroll
            for (int m = 0; m < 4; ++m) sr[ai][m] = sa[row0 + ai * HALF + m * 16];
#pragma unroll
        for (int n = 0; n < 2; ++n) { sg[n] = *(const f32x4*)(sbw + wrow0 + 4 * n); su[n] = *(const f32x4*)(sbw + wrow0 + HALF + 4 * n); }
        asm volatile("" ::: "memory");
#pragma unroll
        for (int ai = 0; ai < 2; ++ai)
#pragma unroll
            for (int m = 0; m < 4; ++m) { const int row = row0 + ai * HALF + m * 16; const float s = sr[ai][m];
                f32x4 h[2];
#pragma unroll
                for (int n = 0; n < 2; ++n) { const i32x4 gi = __builtin_bit_cast(i32x4, acc[ai][0][m][n]), ui = __builtin_bit_cast(i32x4, acc[ai][1][m][n]);
#pragma unroll
                    for (int j = 0; j < 4; ++j) { const float g = (float)gi[j] * (s * sg[n][j]), uu = (float)ui[j] * (s * su[n][j]); h[n][j] = g * sigmoid_f(g) * uu; } }
                *(u32x4*)(H + (size_t)row * 11008 + col0) = pack8(h[0], h[1]); }
    }
};

struct EpiSwiGLU_I8H {
    static constexpr bool PERM = true, AFTER_DRAIN = false, HAS_MID = false;
    bf16_t* H; const float* sa; const float* sbw;
    __device__ __forceinline__ void operator()(const f32x4 (&acc)[2][2][4][2], const Unit& u, int wr, int wc, int fr, int fq) const {
        const int row0 = u.pm * BM + wr * 64 + fr, col0 = u.pn * HALF + wc * 32 + 8 * fq, wrow0 = u.pn * BM + wc * 32 + 8 * fq;
        float sr[2][4]; f32x4 sg[2], su[2];
#pragma unroll
        for (int ai = 0; ai < 2; ++ai)
#pragma unroll
            for (int m = 0; m < 4; ++m) sr[ai][m] = sa[row0 + ai * HALF + m * 16];
#pragma unroll
        for (int n = 0; n < 2; ++n) { sg[n] = *(const f32x4*)(sbw + wrow0 + 4 * n); su[n] = *(const f32x4*)(sbw + wrow0 + HALF + 4 * n) * 0.17677669529663687f; }
        bf16x8 hf[2];
#pragma unroll
        for (int f = 0; f < 2; ++f) { const int co = 8 * (fr >> 2) + 4 * f + (fr & 3); u32x4 w;
#pragma unroll
            for (int q = 0; q < 4; ++q) { const unsigned lo = (__builtin_popcount((8 * fq + 2 * q) & co) & 1) ? 0xBF80u : 0x3F80u, hi = (__builtin_popcount((8 * fq + 2 * q + 1) & co) & 1) ? 0xBF80u : 0x3F80u; w[q] = lo | (hi << 16); }
            hf[f] = __builtin_bit_cast(bf16x8, w); }
        asm volatile("" ::: "memory");
#pragma unroll
        for (int ai = 0; ai < 2; ++ai)
#pragma unroll
            for (int m = 0; m < 4; ++m) { const int row = row0 + ai * HALF + m * 16; const float s = sr[ai][m];
                f32x4 h[2];
#pragma unroll
                for (int n = 0; n < 2; ++n) { const i32x4 gi = __builtin_bit_cast(i32x4, acc[ai][0][m][n]), ui = __builtin_bit_cast(i32x4, acc[ai][1][m][n]);
#pragma unroll
                    for (int j = 0; j < 4; ++j) { const float g = (float)gi[j] * (s * sg[n][j]), uu = (float)ui[j] * (s * su[n][j]); h[n][j] = g * sigmoid_f(g) * uu; } }
                const bf16x8 hb = __builtin_bit_cast(bf16x8, pack8(h[0], h[1]));
                const f32x4 z = {0.f, 0.f, 0.f, 0.f};
                const f32x4 d0 = __builtin_amdgcn_mfma_f32_16x16x32_bf16(hf[0], hb, z, 0, 0, 0), d1 = __builtin_amdgcn_mfma_f32_16x16x32_bf16(hf[1], hb, z, 0, 0, 0);
                *(u32x4*)(H + (size_t)row * 11008 + col0) = pack8(d0, d1); }
    }
};

struct EpiGateI8 {
    static constexpr bool PERM = true, AFTER_DRAIN = false, HAS_MID = false;
    bf16_t* Z; const float* sa; const float* sbw;
    __device__ __forceinline__ void operator()(const f32x4 (&acc)[2][2][4][2], const Unit& u, int wr, int wc, int fr, int fq) const {
        const int row0 = u.pm * BM + wr * 64 + fr, col0 = u.pn * BM + wc * 32 + 8 * fq;
        float sr[2][4]; f32x4 sc[2][2];
#pragma unroll
        for (int ai = 0; ai < 2; ++ai)
#pragma unroll
            for (int m = 0; m < 4; ++m) sr[ai][m] = sa[row0 + ai * HALF + m * 16];
#pragma unroll
        for (int bj = 0; bj < 2; ++bj)
#pragma unroll
            for (int n = 0; n < 2; ++n) sc[bj][n] = *(const f32x4*)(sbw + col0 + bj * HALF + 4 * n);
        asm volatile("" ::: "memory");
#pragma unroll
        for (int ai = 0; ai < 2; ++ai)
#pragma unroll
            for (int m = 0; m < 4; ++m) { const int row = row0 + ai * HALF + m * 16; const float s = sr[ai][m];
#pragma unroll
                for (int bj = 0; bj < 2; ++bj) { f32x4 v[2];
#pragma unroll
                    for (int n = 0; n < 2; ++n) { const i32x4 gi = __builtin_bit_cast(i32x4, acc[ai][bj][m][n]);
#pragma unroll
                        for (int j = 0; j < 4; ++j) v[n][j] = sigmoid_f((float)gi[j] * (s * sc[bj][n][j])); }
                    *(u32x4*)(Z + (size_t)row * Z_LD + ZO_GA + col0 + bj * HALF) = pack8(v[0], v[1]); } }
    }
};

struct EpiSvGateI8 {
    static constexpr bool PERM = true, AFTER_DRAIN = false, HAS_MID = false;
    bf16_t* Z; const float* sa; const float* sbw; float* svstat;
    __device__ __forceinline__ void operator()(const f32x4 (&acc)[2][2][4][2], const Unit& u, int wr, int wc, int fr, int fq) const {
        const int row0 = u.pm * BM + wr * 64 + fr, col0 = u.pn * BM + wc * 32 + 8 * fq; const bool issv = u.pn < 8;
        float sr[2][4]; f32x4 sc[2][2];
#pragma unroll
        for (int ai = 0; ai < 2; ++ai)
#pragma unroll
            for (int m = 0; m < 4; ++m) sr[ai][m] = sa[row0 + ai * HALF + m * 16];
#pragma unroll
        for (int bj = 0; bj < 2; ++bj)
#pragma unroll
            for (int n = 0; n < 2; ++n) sc[bj][n] = *(const f32x4*)(sbw + col0 + bj * HALF + 4 * n);
        asm volatile("" ::: "memory");
#pragma unroll
        for (int ai = 0; ai < 2; ++ai)
#pragma unroll
            for (int m = 0; m < 4; ++m) { const int row = row0 + ai * HALF + m * 16; const float s = sr[ai][m]; float t1 = 0.f, t2 = 0.f;
#pragma unroll
                for (int bj = 0; bj < 2; ++bj) { f32x4 v0, v1; const i32x4 i0 = __builtin_bit_cast(i32x4, acc[ai][bj][m][0]), i1 = __builtin_bit_cast(i32x4, acc[ai][bj][m][1]);
#pragma unroll
                    for (int j = 0; j < 4; ++j) { v0[j] = (float)i0[j] * (s * sc[bj][0][j]); v1[j] = (float)i1[j] * (s * sc[bj][1][j]); }
                    if (issv) {
                        f32x2 a = gelu_pk((f32x2){v0[0], v0[1]}), b = gelu_pk((f32x2){v0[2], v0[3]}), c = gelu_pk((f32x2){v1[0], v1[1]}), d = gelu_pk((f32x2){v1[2], v1[3]});
                        v0 = (f32x4){a.x, a.y, b.x, b.y}; v1 = (f32x4){c.x, c.y, d.x, d.y};
#pragma unroll
                        for (int j = 0; j < 4; ++j) { t1 += v0[j] + v1[j]; t2 += v0[j] * v0[j] + v1[j] * v1[j]; }
                    } else {
#pragma unroll
                        for (int j = 0; j < 4; ++j) { v0[j] = sigmoid_f(v0[j]); v1[j] = sigmoid_f(v1[j]); }
                    }
                    *(u32x4*)(Z + (size_t)row * Z_LD + ZO_SV + col0 + bj * HALF) = pack8(v0, v1); }
                if (issv) {
                    t1 += __shfl_xor(t1, 16); t1 += __shfl_xor(t1, 32); t2 += __shfl_xor(t2, 16); t2 += __shfl_xor(t2, 32);
                    if (fq == 0) *(f32x2*)(svstat + ((size_t)row * 32 + u.pn * 4 + wc) * 2) = (f32x2){t1, t2}; }
            }
    }
};
template <class Epi, class Sched, bool ALIGN_EPI = false, bool SP2 = false, bool I8 = false>
__device__ __forceinline__ void gemm_phase(PG8_LAS unsigned char* lds, const Gemm g, const Sched& S, const Epi& E, const int tid_in) {
    const int tid = tid_in, wid = __builtin_amdgcn_readfirstlane(tid >> 6), lane = tid & 63, wr = wid >> 2, wc = wid & 3, fr = lane & 15, fq = lane >> 4;
    const int K = g.K, nt = K / BK;
    unsigned voffA[2], voffB[2];
#pragma unroll
    for (int i = 0; i < 2; ++i) { int R, C; stage_rc(tid * 16 + i * 8192, R, C); const int Rb = Epi::PERM ? ((R & ~31) + perm32(R & 31)) : R;
        voffA[i] = (unsigned)(R * K + C) * 2u; voffB[i] = (unsigned)(Rb * K + C) * 2u; }
    const size_t kstep = (size_t)(BK * 2);
    const size_t hstep = (size_t)HALF * K * 2;
    const size_t tstep = 2 * hstep;
    const unsigned ldsw = (unsigned)wid * 1024u;
    const int aoff = lds_byte(wr * 64 + fr, fq * 8), boff = lds_byte(wc * 32 + fr, fq * 8);
#define PG8_SA(b, h) (((b) * 2 + (h)) * HTB)
#define PG8_SB(b, h) ((4 + (b) * 2 + (h)) * HTB)
#define PG8_STAGE(bufoff, gbase, voff) do { _Pragma("unroll") for (int _i = 0; _i < 2; ++_i) \
        __builtin_amdgcn_global_load_lds((const unsigned*)((const char*)(gbase) + (voff)[_i]), (PG8_LAS unsigned*)(lds + (bufoff) + ldsw + _i * 8192), 16, 0, 0); } while (0)
#define PG8_LDA(dst, b, h) do { _Pragma("unroll") for (int m = 0; m < 4; ++m) _Pragma("unroll") for (int k = 0; k < 2; ++k) dst[m][k] = *(const PG8_LAS bf16x8*)(lds + PG8_SA(b, h) + aoff + m * 2048 + k * 1024); } while (0)
#define PG8_LDB(dst, b, h) do { _Pragma("unroll") for (int n = 0; n < 2; ++n) _Pragma("unroll") for (int k = 0; k < 2; ++k) dst[n][k] = *(const PG8_LAS bf16x8*)(lds + PG8_SB(b, h) + boff + n * 2048 + k * 1024); } while (0)
#define PG8_MMA(ai, bj, At, Bt) do { __builtin_amdgcn_s_setprio(1); _Pragma("unroll") for (int m = 0; m < 4; ++m) _Pragma("unroll") for (int n = 0; n < 2; ++n) _Pragma("unroll") for (int k = 0; k < 2; ++k) \
        { if constexpr (I8) acc[ai][bj][m][n] = __builtin_bit_cast(f32x4, __builtin_amdgcn_mfma_i32_16x16x64_i8(__builtin_bit_cast(i32x4, Bt[n][k]), __builtin_bit_cast(i32x4, At[m][k]), __builtin_bit_cast(i32x4, acc[ai][bj][m][n]), 0, 0, 0)); \
          else acc[ai][bj][m][n] = __builtin_amdgcn_mfma_f32_16x16x32_bf16(Bt[n][k], At[m][k], acc[ai][bj][m][n], 0, 0, 0); } __builtin_amdgcn_s_setprio(0); } while (0)
#define PG8_WAIT_V(n) asm volatile("s_waitcnt vmcnt(" #n ")" ::: "memory")
#define PG8_WAIT_L(n) asm volatile("s_waitcnt lgkmcnt(" #n ")" ::: "memory")
#define PG8_BAR __builtin_amdgcn_s_barrier()
#define PG8_SCHED __builtin_amdgcn_sched_barrier(0)
    Unit cur, nxt; int ui = 0;
    if (!S.next(0, cur)) return;
    f32x4 acc[2][2][4][2];
#pragma unroll
    for (int a = 0; a < 2; ++a)
#pragma unroll
        for (int b = 0; b < 2; ++b)
#pragma unroll
            for (int m = 0; m < 4; ++m)
#pragma unroll
                for (int n = 0; n < 2; ++n) acc[a][b][m][n] = (f32x4){0.f, 0.f, 0.f, 0.f};
    bf16x8 At[4][2], B0[2][2], B1[2][2];
    const char* cA = (const char*)g.A + (size_t)cur.pm * tstep; const char* cB = (const char*)g.Bt + (size_t)cur.pn * tstep;
    S.a_ready(cur);
    if constexpr (SP2) {
        PG8_STAGE(PG8_SB(0, 0), cB, voffB); PG8_STAGE(PG8_SB(0, 1), cB + hstep, voffB); PG8_STAGE(PG8_SA(0, 0), cA, voffA); PG8_STAGE(PG8_SA(0, 1), cA + hstep, voffA);
        if (wr == 1) PG8_BAR;
        PG8_WAIT_V(2); PG8_BAR;
        PG8_STAGE(PG8_SB(1, 0), cB + kstep, voffB); PG8_STAGE(PG8_SA(1, 0), cA + kstep, voffA); PG8_STAGE(PG8_SB(1, 1), cB + hstep + kstep, voffB);
        PG8_WAIT_V(6); PG8_BAR;
    } else {
        PG8_STAGE(PG8_SB(0, 0), cB, voffB); PG8_STAGE(PG8_SA(0, 0), cA, voffA); PG8_STAGE(PG8_SB(0, 1), cB + hstep, voffB); PG8_STAGE(PG8_SA(0, 1), cA + hstep, voffA);
        if (wr == 1) PG8_BAR;
        PG8_WAIT_V(4); PG8_BAR;
        PG8_STAGE(PG8_SB(1, 0), cB + kstep, voffB); PG8_STAGE(PG8_SA(1, 0), cA + kstep, voffA); PG8_STAGE(PG8_SB(1, 1), cB + hstep + kstep, voffB);
        PG8_WAIT_V(6); PG8_BAR;
    }
    for (;;) {
        const bool has_next = S.next(ui + 1, nxt);
        const char* nA = has_next ? (const char*)g.A + (size_t)nxt.pm * tstep : cA; const char* nB = has_next ? (const char*)g.Bt + (size_t)nxt.pn * tstep : cB;
        for (int t = 0; t < nt; t += 2) {
            const bool last = (t == nt - 2);
            const char* a1 = cA + (size_t)(t + 1) * kstep;
            const char* a2 = last ? nA : cA + (size_t)(t + 2) * kstep; const char* b2 = last ? nB : cB + (size_t)(t + 2) * kstep;
            const char* a3 = a2 + kstep; const char* b3 = b2 + kstep;
            if constexpr (Epi::HAS_MID) { if (t == nt / 2) E.mid(acc, cur, wr, wc, fr, fq); }
            if (last && has_next) S.a_ready(nxt);
            if constexpr (SP2) {
            PG8_LDB(B0, 0, 0); PG8_LDB(B1, 0, 1); PG8_SCHED; PG8_LDA(At, 0, 0); PG8_STAGE(PG8_SA(1, 1), a1 + hstep, voffA);
            PG8_WAIT_V(8); PG8_WAIT_L(0); PG8_BAR; PG8_MMA(0, 0, At, B0); PG8_MMA(0, 1, At, B1); PG8_BAR; PG8_SCHED;
            PG8_LDA(At, 0, 1); PG8_STAGE(PG8_SB(0, 0), b2, voffB); PG8_STAGE(PG8_SB(0, 1), b2 + hstep, voffB); PG8_STAGE(PG8_SA(0, 0), a2, voffA);
            PG8_WAIT_V(8); PG8_WAIT_L(0); PG8_BAR; PG8_MMA(1, 0, At, B0); PG8_MMA(1, 1, At, B1); PG8_BAR; PG8_SCHED;
            PG8_LDB(B0, 1, 0); PG8_LDB(B1, 1, 1); PG8_SCHED; PG8_LDA(At, 1, 0); PG8_STAGE(PG8_SA(0, 1), a2 + hstep, voffA);
            PG8_WAIT_V(8); PG8_WAIT_L(0); PG8_BAR; PG8_MMA(0, 0, At, B0); PG8_MMA(0, 1, At, B1); PG8_BAR; PG8_SCHED;
            PG8_LDA(At, 1, 1); PG8_STAGE(PG8_SB(1, 0), b3, voffB); PG8_STAGE(PG8_SB(1, 1), b3 + hstep, voffB); PG8_STAGE(PG8_SA(1, 0), a3, voffA);
            PG8_WAIT_V(8); PG8_WAIT_L(0); PG8_BAR; PG8_MMA(1, 0, At, B0); PG8_MMA(1, 1, At, B1); PG8_BAR; PG8_SCHED;
            } else {
            PG8_LDB(B0, 0, 0); PG8_SCHED; PG8_LDA(At, 0, 0); PG8_STAGE(PG8_SA(1, 1), a1 + hstep, voffA);
            PG8_WAIT_L(8); PG8_BAR; PG8_WAIT_L(0); PG8_MMA(0, 0, At, B0); PG8_BAR; PG8_SCHED;
            PG8_LDB(B1, 0, 1); PG8_STAGE(PG8_SB(0, 0), b2, voffB);
            PG8_BAR; PG8_WAIT_L(0); PG8_MMA(0, 1, At, B1); PG8_BAR;
            PG8_LDA(At, 0, 1); PG8_STAGE(PG8_SA(0, 0), a2, voffA);
            PG8_BAR; PG8_WAIT_L(0); PG8_MMA(1, 0, At, B0); PG8_BAR; PG8_SCHED;
            PG8_STAGE(PG8_SB(0, 1), b2 + hstep, voffB);
            PG8_WAIT_V(6); PG8_BAR; PG8_MMA(1, 1, At, B1); PG8_BAR;
            PG8_LDB(B0, 1, 0); PG8_SCHED; PG8_LDA(At, 1, 0); PG8_STAGE(PG8_SA(0, 1), a2 + hstep, voffA);
            PG8_WAIT_L(8); PG8_BAR; PG8_WAIT_L(0); PG8_MMA(0, 0, At, B0); PG8_BAR; PG8_SCHED;
            PG8_LDB(B1, 1, 1); PG8_STAGE(PG8_SB(1, 0), b3, voffB);
            PG8_BAR; PG8_WAIT_L(0); PG8_MMA(0, 1, At, B1); PG8_BAR;
            PG8_LDA(At, 1, 1); PG8_STAGE(PG8_SA(1, 0), a3, voffA);
            PG8_BAR; PG8_WAIT_L(0); PG8_MMA(1, 0, At, B0); PG8_BAR; PG8_SCHED;
            PG8_STAGE(PG8_SB(1, 1), b3 + hstep, voffB);
            PG8_WAIT_V(6); PG8_BAR; PG8_MMA(1, 1, At, B1); PG8_BAR;
            }
        }
        if constexpr (ALIGN_EPI) { if (wr == 0) PG8_BAR; }
        if constexpr (!Epi::AFTER_DRAIN) { E(acc, cur, wr, wc, fr, fq); S.done(cur); }
        if (!has_next) break;
#pragma unroll
        for (int a = 0; a < 2; ++a)
#pragma unroll
            for (int b = 0; b < 2; ++b)
#pragma unroll
                for (int m = 0; m < 4; ++m)
#pragma unroll
                    for (int n = 0; n < 2; ++n) acc[a][b][m][n] = (f32x4){0.f, 0.f, 0.f, 0.f};
        cur = nxt; cA = nA; cB = nB; ++ui;
        if constexpr (ALIGN_EPI) { if (wr == 1) PG8_BAR; }
    }
    PG8_WAIT_V(0);
    if constexpr (!ALIGN_EPI) { if (wr == 0) PG8_BAR; }
    PG8_BAR;
    if constexpr (Epi::AFTER_DRAIN) { E.fused(acc, cur, wr, wc, fr, fq, lds, wid, lane); S.done(cur); }
#undef PG8_SA
#undef PG8_SB
#undef PG8_STAGE
#undef PG8_LDA
#undef PG8_LDB
#undef PG8_MMA
#undef PG8_WAIT_V
#undef PG8_WAIT_L
#undef PG8_BAR
#undef PG8_SCHED
}
}

constexpr int NWAVES = 8;
constexpr int NB = 4, SEQ = 4096, DM = 4096, M = NB * SEQ;
constexpr int INW = 15360, FF = 11008, NGU = 2 * FF, NMOD = 6 * DM;
constexpr float RMS_EPS = 1e-6f, LN_EPS = 1e-5f;

constexpr size_t MiB = 1u << 20;
constexpr size_t WS_CTL = 0, CTL_ZERO_BYTES = 1 * MiB;
constexpr size_t WS_MODP = 1 * MiB;
constexpr size_t WS_MOD = 25 * MiB;
constexpr size_t WS_ROPEC = 26 * MiB, WS_ROPES = 27 * MiB;
constexpr size_t WS_SGUW = 28 * MiB;
constexpr size_t WS_SVSTAT = 29 * MiB;
constexpr size_t WS_SSQ = 33 * MiB;
constexpr size_t WS_WIN = 64 * MiB, WS_WPS = 184 * MiB, WS_WPA = 200 * MiB, WS_WOUT = 216 * MiB, WS_WGU = 248 * MiB, WS_WDN = 420 * MiB;
constexpr size_t WS_Z = 512 * MiB;
constexpr size_t WS_A = 992 * MiB;
constexpr size_t WS_B = 1120 * MiB;
constexpr size_t WS_WQ = 1248 * MiB;
constexpr size_t WS_SBW = 37 * MiB;
constexpr size_t WS_SA = 38 * MiB;
constexpr size_t WS_HQ = 1334 * MiB;
constexpr size_t WS_WQIN = 1398 * MiB;
constexpr size_t WS_SA1 = 39 * MiB, WS_SBWIN = 40 * MiB;
constexpr size_t WS_WDQ = 1438 * MiB;
constexpr size_t WS_SBWD = 41 * MiB;
constexpr size_t WS_HIDQ = WS_A;
constexpr size_t WS_END = 1481 * MiB;
static_assert(WS_WQIN + (size_t)10240 * 4096 <= WS_WDQ && WS_WDQ + (size_t)4096 * 11008 <= WS_END && WS_HIDQ + (size_t)16384 * 11008 <= WS_WQ && WS_SBWIN + 10240 * 4 <= WS_SBWD && WS_SBWD + 4096 * 4 <= 64 * MiB, "d_ws map (down-proj int8)");
static_assert(WS_WIN + (size_t)INW * DM * 2 <= WS_WPS && WS_WPS + (size_t)DM * 2048 * 2 <= WS_WPA && WS_WPA + (size_t)DM * 2048 * 2 <= WS_WOUT && WS_WOUT + (size_t)DM * DM * 2 <= WS_WGU &&
              WS_WGU + (size_t)NGU * DM * 2 <= WS_WDN && WS_WDN + (size_t)DM * FF * 2 <= WS_Z && WS_Z + (size_t)M * INW * 2 <= WS_A && WS_A + (size_t)M * DM * 2 <= WS_B && WS_B + (size_t)M * DM * 2 <= WS_WQ && WS_WQ + (size_t)NGU * DM <= WS_HQ && WS_HQ + (size_t)M * DM <= WS_WQIN && WS_WQIN + (size_t)10240 * DM <= WS_END, "d_ws map");
static_assert(WS_MODP + (size_t)64 * 4 * NMOD * 4 <= WS_MOD && WS_SVSTAT + (size_t)M * 64 * 4 <= WS_SSQ && WS_SSQ + (size_t)M * 64 * 4 <= WS_WIN, "d_ws map (small)");
constexpr int CW_BAR = 4096;

constexpr int LDS_BYTES = 147456;
constexpr int LDSCTL_OFF = LDS_BYTES - 256;

#define GAS __attribute__((address_space(1)))
#define LAS __attribute__((address_space(3)))
typedef unsigned short bf16;
typedef unsigned v4u __attribute__((ext_vector_type(4)));
typedef unsigned v2u __attribute__((ext_vector_type(2)));
typedef float f32x4 __attribute__((ext_vector_type(4)));
typedef float f32x2 __attribute__((ext_vector_type(2)));
typedef float f32x16 __attribute__((ext_vector_type(16)));
typedef short bf16x8 __attribute__((ext_vector_type(8)));
typedef short s16x4 __attribute__((ext_vector_type(4)));
typedef GAS unsigned gu32;
#define RLX_AGENT __ATOMIC_RELAXED, __HIP_MEMORY_SCOPE_AGENT
#define LDS_WAIT() asm volatile("s_waitcnt lgkmcnt(0)" ::: "memory")
using pg8::pk_bf16; using pg8::bf_lo; using pg8::bf_hi;

__device__ __forceinline__ float wave_sum(float v) {
#pragma unroll
    for (int o = 1; o < 64; o <<= 1) v += __shfl_xor(v, o);
    return v;
}
#define XB_TMO      128
#define XB_XCNT(j)  (256  + 64 * (j))
#define XB_XSUB(j)  (1280 + 64 * (j))
#define XB_XGEN(j)  (2304 + 64 * (j))
#define XB_TOP      3328
#define XB_TOPGEN   3392
#define XCD_BAR_WORDS 3456
#define XB_SPIN_CAP (1u << 18)

__device__ __forceinline__ unsigned xb_ld(unsigned* p)              { return __hip_atomic_load(p, __ATOMIC_RELAXED, __HIP_MEMORY_SCOPE_AGENT); }
__device__ __forceinline__ unsigned xb_add(unsigned* p, unsigned v) { return __hip_atomic_fetch_add(p, v, __ATOMIC_RELAXED, __HIP_MEMORY_SCOPE_AGENT); }
__device__ __forceinline__ unsigned xb_xcc_id() { return (unsigned)__builtin_amdgcn_s_getreg((3 << 11) | 20) & 0xFu; }
#define XB_SPIN(cond, bar) do { unsigned _sp = 0; while (cond) { __builtin_amdgcn_s_sleep(1); \
    if ((++_sp & 255u) == 0u) { if (xb_ld(&(bar)[XB_TMO])) break; if (_sp > XB_SPIN_CAP) { atomicAdd(&(bar)[XB_TMO], 1u); break; } } } } while (0)

struct XcdBarrier {
    unsigned* bar; unsigned x;
    volatile LAS unsigned* st;
};

__device__ __forceinline__ XcdBarrier xcd_barrier_post(unsigned* bar, volatile LAS unsigned* st) {
    XcdBarrier b; b.bar = bar; b.x = xb_xcc_id(); b.st = st;
    if (threadIdx.x == 0) (void)xb_add(&bar[XB_XCNT(b.x)], 1u);
    return b;
}
__device__ __forceinline__ void xcd_barrier_complete(unsigned* bar, unsigned x, unsigned& nloc, unsigned& nx) {
    const unsigned G = gridDim.x * gridDim.y * gridDim.z;
    unsigned sum, cnt, mine, sp = 0u;
    for (;;) {
        sum = 0u; cnt = 0u; mine = 0u;
#pragma unroll
        for (unsigned j = 0; j < 16; ++j) { const unsigned c = xb_ld(&bar[XB_XCNT(j)]); sum += c; cnt += (c > 0u) ? 1u : 0u; mine = (j == x) ? c : mine; }
        if (sum == G) break;
        __builtin_amdgcn_s_sleep(1);
        if ((++sp & 255u) == 0u) { if (xb_ld(&bar[XB_TMO])) break; if (sp > XB_SPIN_CAP) { atomicAdd(&bar[XB_TMO], 1u); break; } }
    }
    nloc = mine > 0u ? mine : 1u; nx = cnt > 0u ? cnt : 1u;
}

__device__ __forceinline__ void xcd_barrier(const XcdBarrier& b) {
    asm volatile("s_waitcnt vmcnt(0)" ::: "memory");
    __syncthreads();
    if (threadIdx.x == 0) {
        unsigned* bar = b.bar;
        __builtin_amdgcn_s_waitcnt(0);
        unsigned nloc = b.st[0], nx = b.st[1];
        if (nloc == 0u) { xcd_barrier_complete(bar, b.x, nloc, nx); b.st[0] = nloc; b.st[1] = nx; }
        const unsigned old = xb_add(&bar[XB_XSUB(b.x)], 1u);
        const unsigned gen = old / nloc;
        if (old + 1u == (gen + 1u) * nloc) {
            __builtin_amdgcn_fence(__ATOMIC_RELEASE, "agent");
            asm volatile("s_waitcnt vmcnt(0)" ::: "memory");
            const unsigned og = xb_add(&bar[XB_TOP], 1u);
            const unsigned tg = og / nx;
            if (og + 1u == (tg + 1u) * nx) xb_add(&bar[XB_TOPGEN], 1u);
            else XB_SPIN(xb_ld(&bar[XB_TOPGEN]) == tg, bar);
            __builtin_amdgcn_fence(__ATOMIC_ACQUIRE, "agent");
            xb_add(&bar[XB_XGEN(b.x)], 1u);
            asm volatile("s_waitcnt vmcnt(0)" ::: "memory");
        } else {
            XB_SPIN(xb_ld(&bar[XB_XGEN(b.x)]) == gen, bar);
            __builtin_amdgcn_fence(__ATOMIC_ACQUIRE, "agent");
            asm volatile("s_waitcnt vmcnt(0)" ::: "memory");
        }
    }
    __syncthreads();
}

__device__ const float ROPE_INVF[16] = {1.0f, 0.44036659598350525f, 0.1939227432012558f, 0.08539710193872452f, 0.03760603070259094f, 0.016560440883040428f, 0.007292664609849453f, 0.0032114461064338684f,
                                        0.0014142135623842478f, 0.0006227724370546639f, 0.00027424818836152554f, 0.00012076973507646471f, 5.3182957344688475e-05f, 2.34199997066753e-05f, 1.0313385246263351e-05f, 4.541670477919979e-06f};

__device__ __forceinline__ void p0_transpose_item(const float* __restrict__ W, int K, int N, bf16* __restrict__ WT, int k0, int n0, int dst_row0, LAS float* scr, int lane, int dstK = 0, int dk0 = 0) {
    if (dstK == 0) dstK = K;
    const int sub = lane >> 4, c4 = lane & 15;
    f32x4 v[16];
#pragma unroll
    for (int i = 0; i < 16; ++i) v[i] = __builtin_nontemporal_load((const f32x4*)(W + (size_t)(k0 + 4 * i + sub) * N + n0 + 4 * c4));
#pragma unroll
    for (int i = 0; i < 16; ++i) { LAS float* p = scr + (4 * i + sub) * 65 + 4 * c4; p[0] = v[i][0]; p[1] = v[i][1]; p[2] = v[i][2]; p[3] = v[i][3]; }
    LDS_WAIT();
    const int c8 = lane & 7;
#pragma unroll
    for (int it = 0; it < 8; ++it) { const int nn = (lane >> 3) + 8 * it; const LAS float* s = scr + (8 * c8) * 65 + nn;
        v4u o; o.x = pk_bf16(s[0 * 65], s[1 * 65]); o.y = pk_bf16(s[2 * 65], s[3 * 65]); o.z = pk_bf16(s[4 * 65], s[5 * 65]); o.w = pk_bf16(s[6 * 65], s[7 * 65]);
        *(v4u*)(WT + (size_t)(dst_row0 + nn) * dstK + dk0 + k0 + 8 * c8) = o; }
    LDS_WAIT();
}
__device__ __forceinline__ void p0_gemv_item(const float* __restrict__ c, const float* __restrict__ w_ada, float* __restrict__ part, int cg, int kc, LAS float* scr, int lane) {
    const int k0 = kc * 64;
#pragma unroll
    for (int b = 0; b < 4; ++b) { const float cv = c[b * DM + k0 + lane]; scr[b * 64 + lane] = cv / (1.0f + __expf(-cv)); }
    LDS_WAIT();
    f32x4 a0 = {0.f, 0.f, 0.f, 0.f}, a1 = a0, a2 = a0, a3 = a0;
    const float* wp = w_ada + (size_t)k0 * NMOD + cg * 256 + 4 * lane;
#pragma unroll 16
    for (int kk = 0; kk < 64; ++kk) { const f32x4 w = __builtin_nontemporal_load((const f32x4*)(wp + (size_t)kk * NMOD));
        a0 += w * scr[kk]; a1 += w * scr[64 + kk]; a2 += w * scr[128 + kk]; a3 += w * scr[192 + kk]; }
    float* pp = part + (size_t)(kc * 4) * NMOD + cg * 256 + 4 * lane;
    *(f32x4*)(pp) = a0; *(f32x4*)(pp + NMOD) = a1; *(f32x4*)(pp + 2 * NMOD) = a2; *(f32x4*)(pp + 3 * NMOD) = a3;
    LDS_WAIT();
}
struct P0Args { const float *c, *w_ada, *w_in, *sgu_w, *w_ps, *w_pa, *w_out, *w_gate, *w_up, *w_down; const int* positions;
                float *modp, *ropeC, *ropeS; bf16 *sguw, *win_t, *wps_t, *wpa_t, *wout_t, *wgu_t, *wdn_t; };
__device__ __forceinline__ void p0_prologue(const P0Args& A, LAS unsigned char* lds, int gw, int NGW, int wave, int lane) {
    LAS float* scr = (LAS float*)(lds + wave * 16640);
    constexpr int I_GEMV = 96 * 64;
    constexpr int I_IN = (DM / 64) * (INW / 64), I_PS = (2048 / 64) * (DM / 64), I_OUT = (DM / 64) * (DM / 64), I_G = (DM / 64) * (FF / 64), I_DN = (FF / 64) * (DM / 64);
    constexpr int I_ROPE = M / 64, I_SW = 64;
    constexpr int NITEMS = I_GEMV + I_IN + 2 * I_PS + I_OUT + 2 * I_G + I_DN + I_ROPE + I_SW;
    for (int it = gw; it < NITEMS; it += NGW) {
        int r = it;
        if (r < I_GEMV) { p0_gemv_item(A.c, A.w_ada, A.modp, r % 96, r / 96, scr, lane); continue; } r -= I_GEMV;
        if (r < I_IN) { const int nnb = INW / 64, kb = r / nnb, nb = r % nnb; p0_transpose_item(A.w_in, DM, INW, A.win_t, 64 * kb, 64 * nb, 64 * nb, scr, lane); continue; } r -= I_IN;
        if (r < I_PS) { const int nnb = DM / 64, kb = r / nnb, nb = r % nnb; p0_transpose_item(A.w_ps, 2048, DM, A.wps_t, 64 * kb, 64 * nb, 64 * nb, scr, lane, 4096, 0); continue; } r -= I_PS;
        if (r < I_PS) { const int nnb = DM / 64, kb = r / nnb, nb = r % nnb; p0_transpose_item(A.w_pa, 2048, DM, A.wps_t, 64 * kb, 64 * nb, 64 * nb, scr, lane, 4096, 2048); continue; } r -= I_PS;
        if (r < I_OUT) { const int nnb = DM / 64, kb = r / nnb, nb = r % nnb; p0_transpose_item(A.w_out, DM, DM, A.wout_t, 64 * kb, 64 * nb, 64 * nb, scr, lane); continue; } r -= I_OUT;
        if (r < I_G) { const int nnb = FF / 64, kb = r / nnb, nb = r % nnb, n0 = 64 * nb;
            p0_transpose_item(A.w_gate, DM, FF, A.wgu_t, 64 * kb, n0, 256 * (n0 >> 7) + (n0 & 127), scr, lane); continue; } r -= I_G;
        if (r < I_G) { const int nnb = FF / 64, kb = r / nnb, nb = r % nnb, n0 = 64 * nb;
            p0_transpose_item(A.w_up, DM, FF, A.wgu_t, 64 * kb, n0, 256 * (n0 >> 7) + 128 + (n0 & 127), scr, lane); continue; } r -= I_G;
        if (r < I_DN) { const int nnb = DM / 64, kb = r / nnb, nb = r % nnb; p0_transpose_item(A.w_down, FF, DM, A.wdn_t, 64 * kb, 64 * nb, 64 * nb, scr, lane); continue; } r -= I_DN;
        if (r < I_ROPE) {
#pragma unroll 4
            for (int e = 0; e < 16; ++e) { const int idx = r * 1024 + e * 64 + lane, mrow = idx >> 4, i = idx & 15;
                const float ang = (float)A.positions[mrow] * ROPE_INVF[i];
                const double rev = (double)ang * 0.15915494309189535; const float fr = (float)(rev - __builtin_rint(rev));
                A.ropeC[idx] = __builtin_amdgcn_cosf(fr); A.ropeS[idx] = __builtin_amdgcn_sinf(fr); }
            continue; } r -= I_ROPE;
        {
#pragma unroll 4
            for (int e = 0; e < 64; ++e) { const int idx = r * 4096 + e * 64 + lane, t = (idx >> 7) & 127, s = idx & 127;
                const float w = (s <= t) ? A.sgu_w[idx] : 0.0f; A.sguw[idx] = (bf16)(pk_bf16(w, 0.f) & 0xffffu); }
        }
    }
}
__device__ __forceinline__ void p1_mod_reduce(const float* __restrict__ modp, const float* __restrict__ b_ada, const float* g_pre_mix, const float* g_post_mix, const float* g_pre_ffn, const float* g_post_ffn,
                                              float* __restrict__ mod, int gtid, int gthreads) {
    for (int idx = gtid; idx < 4 * (NMOD / 4); idx += gthreads) {
        const int b = idx / (NMOD / 4), j = 4 * (idx % (NMOD / 4));
        f32x4 s = *(const f32x4*)(b_ada + j);
#pragma unroll 32
        for (int kc = 0; kc < 64; ++kc) s += *(const f32x4*)(modp + (size_t)(kc * 4 + b) * NMOD + j);
        const int chunk = j >> 12, e = j & 4095;
        if (chunk == 1) s = *(const f32x4*)(g_pre_mix + e) * (s + 1.0f);
        else if (chunk == 2) s = s * *(const f32x4*)(g_post_mix + e);
        else if (chunk == 4) s = *(const f32x4*)(g_pre_ffn + e) * (s + 1.0f);
        else if (chunk == 5) s = s * *(const f32x4*)(g_post_ffn + e);
        *(f32x4*)(mod + (size_t)b * NMOD + j) = s;
    }
}
__device__ __forceinline__ void p1_quant_wrows(const bf16* __restrict__ W, signed char* __restrict__ WQ, float* __restrict__ sbw, int nrows, int gw, int NGW, int lane) {
    for (int r = gw; r < nrows; r += NGW) {
        const v4u* wr = (const v4u*)(W + (size_t)r * DM) + lane;
        v4u w[8]; float mx = 0.f;
#pragma unroll
        for (int j = 0; j < 8; ++j) { w[j] = __builtin_nontemporal_load(wr + 64 * j);
            mx = fmaxf(mx, fmaxf(fmaxf(fabsf(bf_lo(w[j].x)), fabsf(bf_hi(w[j].x))), fmaxf(fabsf(bf_lo(w[j].y)), fabsf(bf_hi(w[j].y)))));
            mx = fmaxf(mx, fmaxf(fmaxf(fabsf(bf_lo(w[j].z)), fabsf(bf_hi(w[j].z))), fmaxf(fabsf(bf_lo(w[j].w)), fabsf(bf_hi(w[j].w))))); }
#pragma unroll
        for (int o = 1; o < 64; o <<= 1) mx = fmaxf(mx, __shfl_xor(mx, o));
        const float inv = mx > 0.f ? 127.0f / mx : 0.f;
        if (lane == 0) sbw[r] = mx * (1.0f / 127.0f);
        v2u* qr = (v2u*)(WQ + (size_t)r * DM) + lane;
#pragma unroll
        for (int j = 0; j < 8; ++j) {
            const int q0 = (int)__builtin_rintf(bf_lo(w[j].x) * inv), q1 = (int)__builtin_rintf(bf_hi(w[j].x) * inv), q2 = (int)__builtin_rintf(bf_lo(w[j].y) * inv), q3 = (int)__builtin_rintf(bf_hi(w[j].y) * inv);
            const int q4 = (int)__builtin_rintf(bf_lo(w[j].z) * inv), q5 = (int)__builtin_rintf(bf_hi(w[j].z) * inv), q6 = (int)__builtin_rintf(bf_lo(w[j].w) * inv), q7 = (int)__builtin_rintf(bf_hi(w[j].w) * inv);
            v2u o; o.x = (unsigned)(q0 & 255) | ((unsigned)(q1 & 255) << 8) | ((unsigned)(q2 & 255) << 16) | ((unsigned)(q3 & 255) << 24);
            o.y = (unsigned)(q4 & 255) | ((unsigned)(q5 & 255) << 8) | ((unsigned)(q6 & 255) << 16) | ((unsigned)(q7 & 255) << 24);
            qr[64 * j] = o; }
    }
}
template <int CTRL> __device__ __forceinline__ float dpp_mov(float x) { return __builtin_bit_cast(float, __builtin_amdgcn_mov_dpp(__builtin_bit_cast(int, x), CTRL, 0xf, 0xf, true)); }
__device__ __forceinline__ f32x4 wht32_chunk(v2u w, float s1, float s2, float s4) {
    f32x4 a = {bf_lo(w.x), bf_hi(w.x), bf_lo(w.y), bf_hi(w.y)};
    { const f32x4 t = {a.x + a.y, a.x - a.y, a.z + a.w, a.z - a.w}; a = (f32x4){t.x + t.z, t.y + t.w, t.x - t.z, t.y - t.w}; }
    { f32x4 o; o.x = dpp_mov<0xB1>(a.x); o.y = dpp_mov<0xB1>(a.y); o.z = dpp_mov<0xB1>(a.z); o.w = dpp_mov<0xB1>(a.w); a = a * s1 + o; }
    { f32x4 o; o.x = dpp_mov<0x4E>(a.x); o.y = dpp_mov<0x4E>(a.y); o.z = dpp_mov<0x4E>(a.z); o.w = dpp_mov<0x4E>(a.w); a = a * s2 + o; }
    { f32x4 o; o.x = dpp_mov<0x1B>(dpp_mov<0x141>(a.x)); o.y = dpp_mov<0x1B>(dpp_mov<0x141>(a.y)); o.z = dpp_mov<0x1B>(dpp_mov<0x141>(a.z)); o.w = dpp_mov<0x1B>(dpp_mov<0x141>(a.w)); a = a * s4 + o; }
    return a * 0.17677669529663687f;
}
__device__ __forceinline__ void p1_quant_wdown_h32(const bf16* __restrict__ W, signed char* __restrict__ WQ, float* __restrict__ sbw, int gw, int NGW, int lane) {
    const float s1 = (lane & 1) ? -1.f : 1.f, s2 = (lane & 2) ? -1.f : 1.f, s4 = (lane & 4) ? -1.f : 1.f;
    for (int r = gw; r < DM; r += NGW) {
        const v2u* wr = (const v2u*)(W + (size_t)r * FF) + lane;
        float mx = 0.f;
#pragma unroll 1
        for (int i0 = 0; i0 < 43; i0 += 8) { v2u w[8];
#pragma unroll
            for (int k = 0; k < 8; ++k) { const int i = (i0 + k < 43) ? i0 + k : 42; w[k] = wr[64 * i]; }
#pragma unroll
            for (int k = 0; k < 8; ++k) { const f32x4 a = wht32_chunk(w[k], s1, s2, s4); mx = fmaxf(mx, fmaxf(fmaxf(fabsf(a.x), fabsf(a.y)), fmaxf(fabsf(a.z), fabsf(a.w)))); } }
#pragma unroll
        for (int o = 1; o < 64; o <<= 1) mx = fmaxf(mx, __shfl_xor(mx, o));
        const float inv = mx > 0.f ? 127.0f / mx : 0.f;
        if (lane == 0) sbw[r] = mx * (1.0f / 127.0f);
        unsigned* qr = (unsigned*)(WQ + (size_t)r * FF) + lane;
#pragma unroll 1
        for (int i0 = 0; i0 < 43; i0 += 8) { v2u w[8];
#pragma unroll
            for (int k = 0; k < 8; ++k) { const int i = (i0 + k < 43) ? i0 + k : 42; w[k] = wr[64 * i]; }
#pragma unroll
            for (int k = 0; k < 8; ++k) { const int i = (i0 + k < 43) ? i0 + k : 42; const f32x4 a = wht32_chunk(w[k], s1, s2, s4);
                const int q0 = (int)__builtin_rintf(a.x * inv), q1 = (int)__builtin_rintf(a.y * inv), q2 = (int)__builtin_rintf(a.z * inv), q3 = (int)__builtin_rintf(a.w * inv);
                qr[64 * i] = (unsigned)(q0 & 255) | ((unsigned)(q1 & 255) << 8) | ((unsigned)(q2 & 255) << 16) | ((unsigned)(q3 & 255) << 24); } }
    }
}
__device__ __forceinline__ void p8b_quant_hid_rows(const bf16* __restrict__ Hb, signed char* __restrict__ Hq, float* __restrict__ sa, int gw, int NGW, int lane) {
    for (int m = gw; m < M; m += NGW) {
        const v2u* hr = (const v2u*)(Hb + (size_t)m * FF) + lane;
        v2u w[43]; float mx = 0.f;
#pragma unroll
        for (int i = 0; i < 43; ++i) w[i] = __builtin_nontemporal_load(hr + 64 * i);
#pragma unroll
        for (int i = 0; i < 43; ++i) mx = fmaxf(mx, fmaxf(fmaxf(fabsf(bf_lo(w[i].x)), fabsf(bf_hi(w[i].x))), fmaxf(fabsf(bf_lo(w[i].y)), fabsf(bf_hi(w[i].y)))));
#pragma unroll
        for (int o = 1; o < 64; o <<= 1) mx = fmaxf(mx, __shfl_xor(mx, o));
        const float inv = mx > 0.f ? 127.0f / mx : 0.f;
        if (lane == 0) sa[m] = mx * (1.0f / 127.0f);
        unsigned* qr = (unsigned*)(Hq + (size_t)m * FF) + lane;
#pragma unroll
        for (int i = 0; i < 43; ++i) { const int q0 = (int)__builtin_rintf(bf_lo(w[i].x) * inv), q1 = (int)__builtin_rintf(bf_hi(w[i].x) * inv), q2 = (int)__builtin_rintf(bf_lo(w[i].y) * inv), q3 = (int)__builtin_rintf(bf_hi(w[i].y) * inv);
            qr[64 * i] = (unsigned)(q0 & 255) | ((unsigned)(q1 & 255) << 8) | ((unsigned)(q2 & 255) << 16) | ((unsigned)(q3 & 255) << 24); }
    }
}
__device__ __forceinline__ void p2_norm_rows(const float* __restrict__ x, const float* __restrict__ mod, bf16* __restrict__ h, signed char* __restrict__ hq, float* __restrict__ sa, int gw, int NGW, int lane) {
    f32x4 nx[16];
    if (gw < M) { const f32x4* xr = (const f32x4*)(x + (size_t)gw * DM) + lane;
#pragma unroll
        for (int j = 0; j < 16; ++j) nx[j] = __builtin_nontemporal_load(xr + 64 * j); }
    for (int m = gw; m < M; m += NGW) {
        f32x4 v[16]; float ss = 0.f;
#pragma unroll
        for (int j = 0; j < 16; ++j) { v[j] = nx[j]; ss += (v[j].x * v[j].x + v[j].y * v[j].y) + (v[j].z * v[j].z + v[j].w * v[j].w); }
        { const int mn = (m + NGW < M) ? m + NGW : m; const f32x4* xr = (const f32x4*)(x + (size_t)mn * DM) + lane;
#pragma unroll
            for (int j = 0; j < 16; ++j) nx[j] = __builtin_nontemporal_load(xr + 64 * j); }
        const float rstd = 1.0f / sqrtf(wave_sum(ss) * (1.0f / DM) + RMS_EPS);
        const int b = m >> 12;
        const f32x4* sh = (const f32x4*)(mod + (size_t)b * NMOD + 0 * DM) + lane; const f32x4* ga = (const f32x4*)(mod + (size_t)b * NMOD + 1 * DM) + lane;
        v2u* o8 = (v2u*)(h + (size_t)m * DM) + lane; float mx = 0.f;
#pragma unroll
        for (int j = 0; j < 16; ++j) { const f32x4 o = (v[j] * rstd) * ga[64 * j] + sh[64 * j]; o8[64 * j] = (v2u){pk_bf16(o.x, o.y), pk_bf16(o.z, o.w)}; v[j] = o;
            mx = fmaxf(mx, fmaxf(fmaxf(fabsf(o.x), fabsf(o.y)), fmaxf(fabsf(o.z), fabsf(o.w))));
            if ((j & 3) == 3) asm volatile("" ::: "memory"); }
#pragma unroll
        for (int o = 1; o < 64; o <<= 1) mx = fmaxf(mx, __shfl_xor(mx, o));
        const float inv = mx > 0.f ? 127.0f / mx : 0.f;
        if (lane == 0) sa[m] = mx * (1.0f / 127.0f);
        unsigned* o4 = (unsigned*)(hq + (size_t)m * DM) + lane;
#pragma unroll
        for (int j = 0; j < 16; ++j) { const int q0 = (int)__builtin_rintf(v[j].x * inv), q1 = (int)__builtin_rintf(v[j].y * inv), q2 = (int)__builtin_rintf(v[j].z * inv), q3 = (int)__builtin_rintf(v[j].w * inv);
            o4[64 * j] = (unsigned)(q0 & 255) | ((unsigned)(q1 & 255) << 8) | ((unsigned)(q2 & 255) << 16) | ((unsigned)(q3 & 255) << 24); }
    }
}
__device__ __forceinline__ void p7_mid_rows(const float* __restrict__ x, const bf16* __restrict__ y, const float* __restrict__ ssq, const float* __restrict__ mod, float* __restrict__ x1, signed char* __restrict__ h2q, float* __restrict__ sa, int gw, int NGW, int lane) {
    for (int m = gw; m < M; m += NGW) {
        const float rstd1 = 1.0f / sqrtf(wave_sum(ssq[(size_t)m * 64 + lane]) * (1.0f / DM) + RMS_EPS);
        const int b = m >> 12;
        const v2u* yr = (const v2u*)(y + (size_t)m * DM) + lane; const f32x4* xr = (const f32x4*)(x + (size_t)m * DM) + lane;
        const f32x4* gp = (const f32x4*)(mod + (size_t)b * NMOD + 2 * DM) + lane;
        f32x4* x1r = (f32x4*)(x1 + (size_t)m * DM) + lane;
        f32x4 v[16]; float ss = 0.f;
#pragma unroll
        for (int j = 0; j < 16; ++j) { const v2u yw = __builtin_nontemporal_load(yr + 64 * j); const f32x4 yv = {bf_lo(yw.x), bf_hi(yw.x), bf_lo(yw.y), bf_hi(yw.y)};
            v[j] = __builtin_nontemporal_load(xr + 64 * j) + (yv * rstd1) * gp[64 * j]; x1r[64 * j] = v[j];
            ss += (v[j].x * v[j].x + v[j].y * v[j].y) + (v[j].z * v[j].z + v[j].w * v[j].w);
            if ((j & 3) == 3) asm volatile("" ::: "memory"); }
        const float rstd2 = 1.0f / sqrtf(wave_sum(ss) * (1.0f / DM) + RMS_EPS);
        const f32x4* sh = (const f32x4*)(mod + (size_t)b * NMOD + 3 * DM) + lane; const f32x4* ga = (const f32x4*)(mod + (size_t)b * NMOD + 4 * DM) + lane;
        float mx = 0.f;
#pragma unroll
        for (int j = 0; j < 16; ++j) { v[j] = (v[j] * rstd2) * ga[64 * j] + sh[64 * j];
            mx = fmaxf(mx, fmaxf(fmaxf(fabsf(v[j].x), fabsf(v[j].y)), fmaxf(fabsf(v[j].z), fabsf(v[j].w))));
            if ((j & 3) == 3) asm volatile("" ::: "memory"); }
#pragma unroll
        for (int o = 1; o < 64; o <<= 1) mx = fmaxf(mx, __shfl_xor(mx, o));
        const float inv = mx > 0.f ? 127.0f / mx : 0.f;
        if (lane == 0) sa[m] = mx * (1.0f / 127.0f);
        unsigned* o4 = (unsigned*)(h2q + (size_t)m * DM) + lane;
#pragma unroll
        for (int j = 0; j < 16; ++j) { const int q0 = (int)__builtin_rintf(v[j].x * inv), q1 = (int)__builtin_rintf(v[j].y * inv), q2 = (int)__builtin_rintf(v[j].z * inv), q3 = (int)__builtin_rintf(v[j].w * inv);
            o4[64 * j] = (unsigned)(q0 & 255) | ((unsigned)(q1 & 255) << 8) | ((unsigned)(q2 & 255) << 16) | ((unsigned)(q3 & 255) << 24); }
    }
}
__device__ __forceinline__ void p10_final_rows(const bf16* __restrict__ f, const float* __restrict__ ssq, const float* __restrict__ mod, float* out, float* dst, int gw, int NGW, int lane) {
    v2u nf[16];
    if (gw < M) { const v2u* fr = (const v2u*)(f + (size_t)gw * DM) + lane;
#pragma unroll
        for (int j = 0; j < 16; ++j) nf[j] = __builtin_nontemporal_load(fr + 64 * j); }
    for (int m = gw; m < M; m += NGW) {
        const float rstd = 1.0f / sqrtf(wave_sum(ssq[(size_t)m * 64 + lane]) * (1.0f / DM) + RMS_EPS);
        const int b = m >> 12;
        const f32x4* gp = (const f32x4*)(mod + (size_t)b * NMOD + 5 * DM) + lane;
        const f32x4* orow = (const f32x4*)(out + (size_t)m * DM) + lane; f32x4* drow = (f32x4*)(dst + (size_t)m * DM) + lane;
        f32x4 v[16];
#pragma unroll
        for (int j = 0; j < 16; ++j) { const v2u fw = nf[j]; const f32x4 fv = {bf_lo(fw.x), bf_hi(fw.x), bf_lo(fw.y), bf_hi(fw.y)}; v[j] = orow[64 * j] + (fv * rstd) * gp[64 * j];
            if ((j & 3) == 3) asm volatile("" ::: "memory"); }
        { const size_t mn = (size_t)((m + NGW < M) ? m + NGW : m); const v2u* fr = (const v2u*)(f + mn * DM) + lane;
#pragma unroll
            for (int j = 0; j < 16; ++j) nf[j] = __builtin_nontemporal_load(fr + 64 * j); }
#pragma unroll
        for (int j = 0; j < 16; ++j) __builtin_nontemporal_store(v[j], drow + 64 * j);
    }
}

namespace att {
constexpr int KSTR = 272, VSTR = 520, K_OFF = 0, V_OFF = 256 * KSTR, END_OFF = V_OFF + 128 * VSTR;
static_assert(END_OFF <= LDSCTL_OFF, "attention LDS");
__device__ __forceinline__ void attn_unit(LAS unsigned char* lds, const bf16* __restrict__ Z, bf16* __restrict__ AO, const float* __restrict__ sinks, int unit, int tid) {
    const int b = unit >> 7, rem = unit & 127, n = rem >> 2, kvh = rem & 3;
    const int m0 = b * SEQ + n * 128;
#pragma unroll
    for (int it = 0; it < 8; ++it) { const int kk = (tid >> 4) + 32 * it, dc = tid & 15;
        v4u v = {0u, 0u, 0u, 0u};
        if (n > 0 || kk >= 128) v = *(const v4u*)(Z + (size_t)(m0 - 128 + kk) * INW + pg8::ZO_K + kvh * 128 + dc * 8);
        *(LAS v4u*)(lds + K_OFF + kk * KSTR + dc * 16) = v; }
#pragma unroll
    for (int it = 0; it < 8; ++it) { const int kk = tid & 255, dc = (tid >> 8) + 2 * it;
        v4u v = {0u, 0u, 0u, 0u};
        if (n > 0 || kk >= 128) v = *(const v4u*)(Z + (size_t)(m0 - 128 + kk) * INW + pg8::ZO_V + kvh * 128 + dc * 8);
        LAS unsigned char* vp = lds + V_OFF + (dc * 8) * VSTR + kk * 2;
        *(LAS unsigned short*)(vp + 0 * VSTR) = (unsigned short)(v.x & 0xffffu); *(LAS unsigned short*)(vp + 1 * VSTR) = (unsigned short)(v.x >> 16);
        *(LAS unsigned short*)(vp + 2 * VSTR) = (unsigned short)(v.y & 0xffffu); *(LAS unsigned short*)(vp + 3 * VSTR) = (unsigned short)(v.y >> 16);
        *(LAS unsigned short*)(vp + 4 * VSTR) = (unsigned short)(v.z & 0xffffu); *(LAS unsigned short*)(vp + 5 * VSTR) = (unsigned short)(v.z >> 16);
        *(LAS unsigned short*)(vp + 6 * VSTR) = (unsigned short)(v.w & 0xffffu); *(LAS unsigned short*)(vp + 7 * VSTR) = (unsigned short)(v.w >> 16); }
    __syncthreads();
    const int wid = tid >> 6, lane = tid & 63, r = lane & 31, h = lane >> 5;
    const int hf = wid & 1, head = kvh * 4 + (wid >> 1);
    const float sink = sinks[head];
    constexpr float SCALE = 0.08838834764831845f, LOG2E = 1.4426950408889634f;
#pragma unroll 1
    for (int qt = 0; qt < 2; ++qt) {
        const int ql0 = hf * 64 + qt * 32;
        const size_t mq = (size_t)(m0 + ql0 + r);
        bf16x8 qf[8];
#pragma unroll
        for (int ks = 0; ks < 8; ++ks) qf[ks] = *(const bf16x8*)(Z + mq * INW + pg8::ZO_Q + head * 128 + ks * 16 + 8 * h);
        f32x16 S[5];
#pragma unroll
        for (int kt = 0; kt < 5; ++kt) {
#pragma unroll
            for (int i = 0; i < 16; ++i) S[kt][i] = 0.f;
#pragma unroll
            for (int ks = 0; ks < 8; ++ks) { const bf16x8 kf = *(const LAS bf16x8*)(lds + K_OFF + (ql0 + 32 * kt + r) * KSTR + (ks * 16 + 8 * h) * 2);
                S[kt] = __builtin_amdgcn_mfma_f32_32x32x16_bf16(kf, qf[ks], S[kt], 0, 0, 0); } }
        float mx = sink;
#pragma unroll
        for (int kt = 0; kt < 5; ++kt)
#pragma unroll
            for (int i = 0; i < 16; ++i) { const int cr = (i & 3) + 8 * (i >> 2) + 4 * h;
                const int diff = 128 + r - 32 * kt - cr;
                const bool valid = ((unsigned)diff < 128u) && (n > 0 || (ql0 + 32 * kt + cr) >= 128);
                const float s = valid ? S[kt][i] * SCALE : -__builtin_inff();
                S[kt][i] = s; mx = fmaxf(mx, s); }
        mx = fmaxf(mx, __shfl_xor(mx, 32));
        float sum = 0.f;
#pragma unroll
        for (int kt = 0; kt < 5; ++kt)
#pragma unroll
            for (int i = 0; i < 16; ++i) { const float p = __builtin_amdgcn_exp2f((S[kt][i] - mx) * LOG2E); S[kt][i] = p; sum += p; }
        sum += __shfl_xor(sum, 32);
        const float inv = 1.0f / (sum + __builtin_amdgcn_exp2f((sink - mx) * LOG2E));
        f32x16 O[4];
#pragma unroll
        for (int dt = 0; dt < 4; ++dt)
#pragma unroll
            for (int i = 0; i < 16; ++i) O[dt][i] = 0.f;
#pragma unroll
        for (int kt = 0; kt < 5; ++kt)
#pragma unroll
            for (int s = 0; s < 2; ++s) {
                v4u pw; pw.x = pk_bf16(S[kt][8 * s + 0], S[kt][8 * s + 1]); pw.y = pk_bf16(S[kt][8 * s + 2], S[kt][8 * s + 3]);
                pw.z = pk_bf16(S[kt][8 * s + 4], S[kt][8 * s + 5]); pw.w = pk_bf16(S[kt][8 * s + 6], S[kt][8 * s + 7]);
                const bf16x8 pf = __builtin_bit_cast(bf16x8, pw);
#pragma unroll
                for (int dt = 0; dt < 4; ++dt) { const LAS unsigned char* vp = lds + V_OFF + (dt * 32 + r) * VSTR + (ql0 + 32 * kt + 16 * s + 4 * h) * 2;
                    const s16x4 lo = *(const LAS s16x4*)vp, hi = *(const LAS s16x4*)(vp + 16);
                    const bf16x8 vf = __builtin_shufflevector(lo, hi, 0, 1, 2, 3, 4, 5, 6, 7);
                    O[dt] = __builtin_amdgcn_mfma_f32_32x32x16_bf16(vf, pf, O[dt], 0, 0, 0); } }
        bf16* op = AO + mq * 4096 + 2048 + head * 128 + 4 * h;
#pragma unroll
        for (int dt = 0; dt < 4; ++dt)
#pragma unroll
            for (int gq = 0; gq < 4; ++gq)
                *(v2u*)(op + dt * 32 + 8 * gq) = (v2u){pk_bf16(O[dt][4 * gq] * inv, O[dt][4 * gq + 1] * inv), pk_bf16(O[dt][4 * gq + 2] * inv, O[dt][4 * gq + 3] * inv)};
    }
    __syncthreads();
}
}

namespace sgu {
constexpr int VN_STR = 272, IMG = 128 * VN_STR, NU = 4, STAT_OFF = NU * IMG;
static_assert(STAT_OFF + 1024 <= LDSCTL_OFF, "sgu LDS");
__device__ __forceinline__ void sgu_batch(LAS unsigned char* lds, const bf16* __restrict__ Z, const float* __restrict__ svstat, const float* __restrict__ ln_g, const float* __restrict__ ln_b,
                                          const bf16* __restrict__ Wb, const float* __restrict__ bs, bf16* __restrict__ SO, int chunk, int g0, int tid) {
    const int m0 = chunk * 128;
    LAS float* st = (LAS float*)(lds + STAT_OFF);
    const int s = tid & 127, cq = tid >> 7;
    v4u sv[NU][4];
#pragma unroll
    for (int u = 0; u < NU; ++u)
#pragma unroll
        for (int it = 0; it < 4; ++it) sv[u][it] = *(const v4u*)(Z + (size_t)(m0 + s) * INW + pg8::ZO_SV + (g0 + u) * 128 + (cq + 4 * it) * 8);
    {
        const int row = tid >> 2, q = tid & 3; const f32x4* p = (const f32x4*)(svstat + (size_t)(m0 + row) * 64) + 4 * q; float s1 = 0.f, s2 = 0.f;
#pragma unroll
        for (int i = 0; i < 4; ++i) { const f32x4 v = p[i]; s1 += v.x + v.z; s2 += v.y + v.w; }
        s1 += __shfl_xor(s1, 1); s2 += __shfl_xor(s2, 1); s1 += __shfl_xor(s1, 2); s2 += __shfl_xor(s2, 2);
        const float mu = s1 * (1.0f / 2048.0f), var = fmaxf(s2 * (1.0f / 2048.0f) - mu * mu, 0.f);
        if (q == 0) { st[row] = mu; st[128 + row] = 1.0f / sqrtf(var + LN_EPS); }
    }
    __syncthreads();
    const float mu = st[s], rs = st[128 + s];
#pragma unroll
    for (int u = 0; u < NU; ++u)
#pragma unroll
        for (int it = 0; it < 4; ++it) { const int cc = cq + 4 * it; const v4u v = sv[u][it];
            const float* gp = ln_g + (g0 + u) * 128 + cc * 8; const float* bp = ln_b + (g0 + u) * 128 + cc * 8;
            LAS unsigned char* vp = lds + u * IMG + (cc * 8) * VN_STR + s * 2;
            const float x0 = bf_lo(v.x), x1 = bf_hi(v.x), x2 = bf_lo(v.y), x3 = bf_hi(v.y), x4 = bf_lo(v.z), x5 = bf_hi(v.z), x6 = bf_lo(v.w), x7 = bf_hi(v.w);
            *(LAS unsigned short*)(vp + 0 * VN_STR) = (unsigned short)(pk_bf16((x0 - mu) * rs * gp[0] + bp[0], 0.f) & 0xffffu);
            *(LAS unsigned short*)(vp + 1 * VN_STR) = (unsigned short)(pk_bf16((x1 - mu) * rs * gp[1] + bp[1], 0.f) & 0xffffu);
            *(LAS unsigned short*)(vp + 2 * VN_STR) = (unsigned short)(pk_bf16((x2 - mu) * rs * gp[2] + bp[2], 0.f) & 0xffffu);
            *(LAS unsigned short*)(vp + 3 * VN_STR) = (unsigned short)(pk_bf16((x3 - mu) * rs * gp[3] + bp[3], 0.f) & 0xffffu);
            *(LAS unsigned short*)(vp + 4 * VN_STR) = (unsigned short)(pk_bf16((x4 - mu) * rs * gp[4] + bp[4], 0.f) & 0xffffu);
            *(LAS unsigned short*)(vp + 5 * VN_STR) = (unsigned short)(pk_bf16((x5 - mu) * rs * gp[5] + bp[5], 0.f) & 0xffffu);
            *(LAS unsigned short*)(vp + 6 * VN_STR) = (unsigned short)(pk_bf16((x6 - mu) * rs * gp[6] + bp[6], 0.f) & 0xffffu);
            *(LAS unsigned short*)(vp + 7 * VN_STR) = (unsigned short)(pk_bf16((x7 - mu) * rs * gp[7] + bp[7], 0.f) & 0xffffu); }
    __syncthreads();
    const int wid = tid >> 6, lane = tid & 63, i = lane & 15, quad = lane >> 4, tb = 16 * wid;
    const int t = tb + i; const size_t row = (size_t)(m0 + t);
#pragma unroll 1
    for (int u = 0; u < NU; ++u) { const int g = g0 + u;
        v2u sw[8];
#pragma unroll
        for (int ct = 0; ct < 8; ++ct) sw[ct] = *(const v2u*)(Z + row * INW + pg8::ZO_SU + g * 128 + ct * 16 + quad * 4);
        const float bias = bs[g * 128 + t];
        f32x4 acc[8];
#pragma unroll
        for (int ct = 0; ct < 8; ++ct) acc[ct] = (f32x4){0.f, 0.f, 0.f, 0.f};
#pragma unroll
        for (int ks = 0; ks < 4; ++ks) {
            if (32 * ks <= tb + 15) {
                const bf16x8 wf = *(const bf16x8*)(Wb + (size_t)(g * 128 + tb + i) * 128 + ks * 32 + quad * 8);
#pragma unroll
                for (int ct = 0; ct < 8; ++ct) { const bf16x8 vf = *(const LAS bf16x8*)(lds + u * IMG + (ct * 16 + i) * VN_STR + (ks * 32 + quad * 8) * 2);
                    acc[ct] = __builtin_amdgcn_mfma_f32_16x16x32_bf16(vf, wf, acc[ct], 0, 0, 0); } } }
#pragma unroll
        for (int ct = 0; ct < 8; ++ct) { const int c = g * 128 + ct * 16 + quad * 4;
            const float o0 = bf_lo(sw[ct].x) * (acc[ct][0] + bias), o1 = bf_hi(sw[ct].x) * (acc[ct][1] + bias), o2 = bf_lo(sw[ct].y) * (acc[ct][2] + bias), o3 = bf_hi(sw[ct].y) * (acc[ct][3] + bias);
            *(v2u*)(SO + row * 4096 + c) = (v2u){pk_bf16(o0, o1), pk_bf16(o2, o3)}; }
    }
    __syncthreads();
}
}

#ifndef MK_N_LAUNCHES
#define MK_N_LAUNCHES 1
#endif
constexpr int N_PHASES = 11, N_LAUNCHES = MK_N_LAUNCHES;
struct Args { const void* in[21]; float* out; unsigned char* ws; int ph_lo, ph_hi; };
static_assert(sizeof(Args) == 21 * 8 + 8 + 8 + 8, "Args has no holes");

typedef const __attribute__((address_space(4))) unsigned char* kargp_t;
#define KP_REFRESH() kargp_t kp = C.kbase; asm volatile("" : "+s"(kp))
#define KIN(T, i) (*(T* const __attribute__((address_space(4)))*)(kp + 8 * (i)))
#define KOUT() (*(float* const __attribute__((address_space(4)))*)(kp + 8 * 21))
#define KWS() (*(unsigned char* const __attribute__((address_space(4)))*)(kp + 8 * 22))
struct Ctx { kargp_t kbase; LAS unsigned char* lds; int wave, G, bx, gw, NGW; };
#define TID_HERE() int lane_; asm volatile("v_mbcnt_lo_u32_b32 %0, -1, 0\n\tv_mbcnt_hi_u32_b32 %0, -1, %0" : "=v"(lane_)); const int tid_ = C.wave * 64 + lane_
__device__ __forceinline__ void phase0(const Ctx& C) { KP_REFRESH(); unsigned char* ws = KWS();
    P0Args A; A.c = KIN(const float, 1); A.w_ada = KIN(const float, 3); A.w_in = KIN(const float, 6); A.sgu_w = KIN(const float, 10); A.w_ps = KIN(const float, 12); A.w_pa = KIN(const float, 13);
    A.w_out = KIN(const float, 14); A.w_gate = KIN(const float, 17); A.w_up = KIN(const float, 18); A.w_down = KIN(const float, 19); A.positions = KIN(const int, 2);
    A.modp = (float*)(ws + WS_MODP); A.ropeC = (float*)(ws + WS_ROPEC); A.ropeS = (float*)(ws + WS_ROPES); A.sguw = (bf16*)(ws + WS_SGUW);
    A.win_t = (bf16*)(ws + WS_WIN); A.wps_t = (bf16*)(ws + WS_WPS); A.wpa_t = (bf16*)(ws + WS_WPA); A.wout_t = (bf16*)(ws + WS_WOUT); A.wgu_t = (bf16*)(ws + WS_WGU); A.wdn_t = (bf16*)(ws + WS_WDN);
    TID_HERE(); (void)tid_; p0_prologue(A, C.lds, C.gw, C.NGW, C.wave, lane_); }
__device__ __forceinline__ void phase1(const Ctx& C) { KP_REFRESH(); unsigned char* ws = KWS(); TID_HERE();
    p1_mod_reduce((const float*)(ws + WS_MODP), KIN(const float, 4), KIN(const float, 5), KIN(const float, 15), KIN(const float, 16), KIN(const float, 20), (float*)(ws + WS_MOD), C.bx * (NWAVES * 64) + tid_, C.G * NWAVES * 64);
    p1_quant_wrows((const bf16*)(ws + WS_WGU), (signed char*)(ws + WS_WQ), (float*)(ws + WS_SBW), NGU, C.gw, C.NGW, lane_);
    p1_quant_wrows((const bf16*)(ws + WS_WIN) + (size_t)5120 * DM, (signed char*)(ws + WS_WQIN), (float*)(ws + WS_SBWIN), 10240, C.gw, C.NGW, lane_);
    p1_quant_wdown_h32((const bf16*)(ws + WS_WDN), (signed char*)(ws + WS_WDQ), (float*)(ws + WS_SBWD), C.gw, C.NGW, lane_); }
__device__ __forceinline__ void phase2(const Ctx& C) { KP_REFRESH(); unsigned char* ws = KWS(); TID_HERE(); (void)tid_; p2_norm_rows(KIN(const float, 0), (const float*)(ws + WS_MOD), (bf16*)(ws + WS_A), (signed char*)(ws + WS_HQ), (float*)(ws + WS_SA1), C.gw, C.NGW, lane_); }
__device__ __forceinline__ void phase3(const Ctx& C) {
    { KP_REFRESH(); unsigned char* ws = KWS();
      pg8::Gemm g{(const bf16*)(ws + WS_A), (const bf16*)(ws + WS_WIN), M, 5120, DM}; pg8::StaticOrder S; S.init(M, 5120, C.G, C.bx);
      pg8::EpiZ E{(bf16*)(ws + WS_Z), (const float*)(ws + WS_ROPEC), (const float*)(ws + WS_ROPES), (float*)(ws + WS_SVSTAT)};
      TID_HERE(); pg8::gemm_phase<pg8::EpiZ, pg8::StaticOrder, true, true>(C.lds, g, S, E, tid_); }
    { KP_REFRESH(); unsigned char* ws = KWS();
      pg8::Gemm g{(const bf16*)(ws + WS_HQ), (const bf16*)(ws + WS_WQIN), M, 10240, DM / 2}; pg8::StaticOrder S; S.init(M, 10240, C.G, C.bx);
      pg8::EpiSvGateI8 E{(bf16*)(ws + WS_Z), (const float*)(ws + WS_SA1), (const float*)(ws + WS_SBWIN), (float*)(ws + WS_SVSTAT)};
      TID_HERE(); pg8::gemm_phase<pg8::EpiSvGateI8, pg8::StaticOrder, true, true, true>(C.lds, g, S, E, tid_); } }
__device__ __forceinline__ void phase4(const Ctx& C) { KP_REFRESH(); unsigned char* ws = KWS(); TID_HERE();
    { const bf16* Zb = (const bf16*)(ws + WS_Z); bf16* AO = (bf16*)(ws + WS_B); const float* sinks = KIN(const float, 7);
      for (int u = C.bx; u < 512; u += C.G) att::attn_unit(C.lds, Zb, AO, sinks, u, tid_); }
    { const bf16* Zb = (const bf16*)(ws + WS_Z); bf16* SO = (bf16*)(ws + WS_B);
      const float* svstat = (const float*)(ws + WS_SVSTAT); const float* ln_g = KIN(const float, 8); const float* ln_b = KIN(const float, 9); const float* sb = KIN(const float, 11); const bf16* sguw = (const bf16*)(ws + WS_SGUW);
      for (int bt = C.bx; bt < 512; bt += C.G) sgu::sgu_batch(C.lds, Zb, svstat, ln_g, ln_b, sguw, sb, SO, bt >> 2, 4 * (bt & 3), tid_); } }
__device__ __forceinline__ void phase5(const Ctx& C) { KP_REFRESH(); unsigned char* ws = KWS();
    pg8::Gemm g{(const bf16*)(ws + WS_B), (const bf16*)(ws + WS_WPS), M, DM, DM}; pg8::StaticOrder S; S.init(M, DM, C.G, C.bx); pg8::EpiMerge E{(bf16*)(ws + WS_A), (const bf16*)(ws + WS_Z)};
    TID_HERE(); pg8::gemm_phase<pg8::EpiMerge, pg8::StaticOrder, true, true>(C.lds, g, S, E, tid_); }
__device__ __forceinline__ void phase6(const Ctx& C) { KP_REFRESH(); unsigned char* ws = KWS();
    pg8::Gemm g{(const bf16*)(ws + WS_A), (const bf16*)(ws + WS_WOUT), M, DM, DM}; pg8::StaticOrder S; S.init(M, DM, C.G, C.bx); pg8::EpiStats E{(bf16*)(ws + WS_B), (float*)(ws + WS_SSQ)};
    TID_HERE(); pg8::gemm_phase<pg8::EpiStats, pg8::StaticOrder, true, true>(C.lds, g, S, E, tid_); }
__device__ __forceinline__ void phase7(const Ctx& C) { KP_REFRESH(); unsigned char* ws = KWS(); TID_HERE(); (void)tid_;
    p7_mid_rows(KIN(const float, 0), (const bf16*)(ws + WS_B), (const float*)(ws + WS_SSQ), (const float*)(ws + WS_MOD), KOUT(), (signed char*)(ws + WS_A), (float*)(ws + WS_SA), C.gw, C.NGW, lane_); }
__device__ __forceinline__ void phase8(const Ctx& C) { KP_REFRESH(); unsigned char* ws = KWS();
    pg8::Gemm g{(const bf16*)(ws + WS_A), (const bf16*)(ws + WS_WQ), M, NGU, DM / 2}; pg8::StaticOrder S; S.init(M, NGU, C.G, C.bx);
    pg8::EpiSwiGLU_I8H E{(bf16*)(ws + WS_Z), (const float*)(ws + WS_SA), (const float*)(ws + WS_SBW)};
    TID_HERE(); pg8::gemm_phase<pg8::EpiSwiGLU_I8H, pg8::StaticOrder, true, true, true>(C.lds, g, S, E, tid_); }
__device__ __forceinline__ void phase8b(const Ctx& C) { KP_REFRESH(); unsigned char* ws = KWS(); TID_HERE(); (void)tid_;
    p8b_quant_hid_rows((const bf16*)(ws + WS_Z), (signed char*)(ws + WS_HIDQ), (float*)(ws + WS_SA), C.gw, C.NGW, lane_); }
#ifndef PROBE_DELAY
#define PROBE_DELAY 0
#endif
__device__ __forceinline__ void phase9(const Ctx& C, unsigned long long& dcyc, unsigned long long& dreal) { KP_REFRESH(); unsigned char* ws = KWS();
    pg8::Gemm g{(const bf16*)(ws + WS_HIDQ), (const bf16*)(ws + WS_WDQ), M, DM, FF / 2}; pg8::StaticOrder S; S.init(M, DM, C.G, C.bx);
    pg8::EpiStatsI8 E{(bf16*)(ws + WS_Z), (float*)(ws + WS_SSQ), (const float*)(ws + WS_SA), (const float*)(ws + WS_SBWD)};
    const unsigned long long t0 = PROBE_DELAY ? __builtin_amdgcn_s_memtime() : 0ull, r0 = PROBE_DELAY ? __builtin_amdgcn_s_memrealtime() : 0ull;
    TID_HERE(); pg8::gemm_phase<pg8::EpiStatsI8, pg8::StaticOrder, true, true, true>(C.lds, g, S, E, tid_);
    if (PROBE_DELAY) { dcyc = __builtin_amdgcn_s_memtime() - t0; dreal = __builtin_amdgcn_s_memrealtime() - r0; } }
__device__ __forceinline__ void phase10(const Ctx& C) { KP_REFRESH(); unsigned char* ws = KWS(); TID_HERE(); (void)tid_;
    p10_final_rows((const bf16*)(ws + WS_Z), (const float*)(ws + WS_SSQ), (const float*)(ws + WS_MOD), KOUT(), KOUT(), C.gw, C.NGW, lane_); }
__device__ __forceinline__ void phase10_dry(const Ctx& C) { KP_REFRESH(); unsigned char* ws = KWS(); TID_HERE(); (void)tid_;
    p10_final_rows((const bf16*)(ws + WS_Z), (const float*)(ws + WS_SSQ), (const float*)(ws + WS_MOD), KOUT(), (float*)(ws + WS_Z) + (size_t)M * DM, C.gw, C.NGW, lane_); }
#ifndef PROBE_EXTRA
#define PROBE_EXTRA 0
#endif

#ifndef PROBE_REPEAT_MASK
#define PROBE_REPEAT_MASK 0u
#endif
__global__ void __launch_bounds__(NWAVES * 64, 2) fwd(Args args) {
    extern __shared__ __attribute__((aligned(16))) unsigned char lds_raw[];
    Ctx C; C.lds = (LAS unsigned char*)lds_raw; C.kbase = (kargp_t)__builtin_amdgcn_kernarg_segment_ptr();
    const int tid0 = threadIdx.x; C.wave = __builtin_amdgcn_readfirstlane(tid0 >> 6);
    C.G = gridDim.x; C.bx = blockIdx.x;
    const int vcu = (C.G % 8 == 0) ? (C.bx % 8) * (C.G / 8) + C.bx / 8 : C.bx;
    C.gw = vcu * NWAVES + C.wave; C.NGW = C.G * NWAVES;
    const unsigned long long rt_start = PROBE_DELAY ? __builtin_amdgcn_s_memrealtime() : 0ull; unsigned long long rt_p0 = 0ull;
    for (int u = tid0; u < (LDS_BYTES - LDSCTL_OFF) / 4; u += NWAVES * 64) ((LAS unsigned*)(C.lds + LDSCTL_OFF))[u] = 0u;
    __syncthreads();
    XcdBarrier bar; bar.bar = (unsigned*)(args.ws + WS_CTL) + CW_BAR; bar.x = 0; bar.st = nullptr;
    if (N_LAUNCHES == 1) bar = xcd_barrier_post((unsigned*)(args.ws + WS_CTL) + CW_BAR, (volatile LAS unsigned*)(C.lds + LDSCTL_OFF));
    const int lo = (N_LAUNCHES == 1) ? 0 : args.ph_lo, hi = (N_LAUNCHES == 1) ? N_PHASES : args.ph_hi;
#define IN(k) (lo <= (k) && (k) < hi)
#define RUN(k, call) do { if (IN(k)) { call; if (N_LAUNCHES == 1 && ((PROBE_REPEAT_MASK >> (k)) & 1u)) { xcd_barrier(bar); call; } } if (IN(k) && IN((k) + 1)) xcd_barrier(bar); } while (0)
#define STAMP(k) do { if (PROBE_DELAY == 10 + (k)) rt_p0 = __builtin_amdgcn_s_memrealtime() - rt_start; } while (0)
    RUN(0, phase0(C)); if (PROBE_DELAY == 4) rt_p0 = __builtin_amdgcn_s_memrealtime() - rt_start; STAMP(0);
    RUN(1, phase1(C)); STAMP(1); RUN(2, phase2(C)); STAMP(2); RUN(3, phase3(C)); STAMP(3); RUN(4, phase4(C)); STAMP(4); RUN(5, phase5(C)); STAMP(5);
    RUN(6, phase6(C)); STAMP(6); RUN(7, phase7(C)); STAMP(7);
    if (PROBE_EXTRA == 3) { const unsigned long long r0 = __builtin_amdgcn_s_memrealtime(); while (__builtin_amdgcn_s_memrealtime() - r0 < 40000ull) __builtin_amdgcn_s_sleep(32); }
    RUN(8, phase8(C)); STAMP(8); if (N_LAUNCHES == 1) { phase8b(C); xcd_barrier(bar); } unsigned long long dcyc = 0, dreal = 1; RUN(9, phase9(C, dcyc, dreal)); STAMP(9);
    if (PROBE_EXTRA == 1) { phase10_dry(C); xcd_barrier(bar); }
    if (PROBE_EXTRA == 2) { for (int i = 0; i < 10; ++i) xcd_barrier(bar); }
    RUN(10, phase10(C));
    if (PROBE_DELAY) {
        const unsigned long long r0 = __builtin_amdgcn_s_memrealtime();
        const unsigned long long ticks = (PROBE_DELAY == 1) ? (dcyc / 688ull) * 100ull : (PROBE_DELAY == 2) ? ((dcyc * 100ull) / dreal) * 100ull : (PROBE_DELAY == 3) ? (r0 - rt_start) : rt_p0;
        while (__builtin_amdgcn_s_memrealtime() - r0 < ticks && __builtin_amdgcn_s_memrealtime() - r0 < 2000000ull) __builtin_amdgcn_s_sleep(32);
    }
#undef IN
#undef RUN
}

extern "C" void kernel_launch(void* const* d_in, const int* in_sizes, int n_in, void* d_out, int out_size, void* d_ws, size_t ws_size, hipStream_t stream) {
    static int grid = 0;
    if (grid == 0) {
        if (n_in != 21 || in_sizes[0] != M * DM || out_size != M * DM || ws_size < WS_END) {
            fprintf(stderr, "kernel_launch: built for 21 inputs, x/out of %d floats, >= %zu bytes of workspace; got n_in %d, in0 %d, out %d, ws %zu; nothing launched\n", M * DM, (size_t)WS_END, n_in, n_in > 0 ? in_sizes[0] : -1, out_size, ws_size);
            grid = -1; return; }
        int dev = 0, cus = 0, per_cu = 0;
        if (hipGetDevice(&dev) != hipSuccess || hipDeviceGetAttribute(&cus, hipDeviceAttributeMultiprocessorCount, dev) != hipSuccess) { fprintf(stderr, "kernel_launch: device query failed\n"); grid = -1; return; }
        if (hipFuncSetAttribute((const void*)fwd, hipFuncAttributeMaxDynamicSharedMemorySize, LDS_BYTES) != hipSuccess) { fprintf(stderr, "kernel_launch: hipFuncSetAttribute failed\n"); grid = -1; return; }
        if (hipOccupancyMaxActiveBlocksPerMultiprocessor(&per_cu, (const void*)fwd, NWAVES * 64, LDS_BYTES) != hipSuccess || per_cu < 1)
            fprintf(stderr, "kernel_launch: note: occupancy query reports %d workgroups per CU\n", per_cu);
        (void)hipGetLastError();
        grid = cus;
    }
    if (grid < 0) return;
    if (hipMemsetAsync((char*)d_ws + WS_CTL, 0, CTL_ZERO_BYTES, stream) != hipSuccess) { fprintf(stderr, "kernel_launch: hipMemsetAsync failed\n"); return; }
    Args a{};
    for (int i = 0; i < 21; ++i) a.in[i] = d_in[i];
    a.out = (float*)d_out; a.ws = (unsigned char*)d_ws;
    if (N_LAUNCHES == 1) {
        a.ph_lo = 0; a.ph_hi = N_PHASES;
        hipLaunchKernelGGL(fwd, dim3(grid), dim3(NWAVES * 64), LDS_BYTES, stream, a);
    } else {
        for (int li = 0; li < N_PHASES; ++li) { a.ph_lo = li; a.ph_hi = li + 1; hipLaunchKernelGGL(fwd, dim3(grid), dim3(NWAVES * 64), LDS_BYTES, stream, a); }
    }
    const hipError_t le = hipPeekAtLastError();
    if (le != hipSuccess) fprintf(stderr, "kernel_launch: launch failed: %s (grid %d)\n", hipGetErrorName(le), grid);
}
```
